# Optimizing an MI355X kernel written in HIP

```python
import math, functools
import jax, jax.numpy as jnp
from jax import lax
import numpy as np

D_MODEL = 1024
BATCH = 2
SEQ = 8192
DEPTH = 1
DEC_BATCH = 128
DEC_SEQ = 8
PAST_LEN = 2048
PAGE_SIZE = 128

D_MIX = D_MODEL
D_CONV = D_MIX // 2
CONV_W = 3
N_HEADS = 8
HEAD_DIM = (D_MIX - D_CONV) // N_HEADS
N_IDX_HEADS = 8
IDX_DIM = 64
TOPK_MAX = 256
Q_BLOCK = 128
ROPE_THETA = 10000.0
N_MEM = 256
MEM_HEADS = 4
MEM_HEAD_DIM = D_MODEL // MEM_HEADS
D_FF = 2816
EPS = 1e-6
ATTN_SCALE = HEAD_DIM ** -0.5
MEM_SCALE = MEM_HEAD_DIM ** -0.5
IDX_SCALE = (N_IDX_HEADS * IDX_DIM) ** -0.5
PROJ_SIZES = (D_CONV, D_CONV, D_CONV, N_HEADS * HEAD_DIM, N_HEADS * HEAD_DIM, N_HEADS * HEAD_DIM, N_IDX_HEADS * IDX_DIM, IDX_DIM, N_IDX_HEADS)
D_IN = 3 * D_CONV + 3 * N_HEADS * HEAD_DIM + N_IDX_HEADS * IDX_DIM + IDX_DIM + N_IDX_HEADS

kernel_name = 'hybrid_conv_dsa_memory_convffn_step'


def rms_norm(x, g):
    xf = x.astype(jnp.float32)
    y = xf * lax.rsqrt(jnp.mean(xf * xf, axis=-1, keepdims=True) + EPS)
    return (y * g.astype(jnp.float32)).astype(x.dtype)


def rope(x, pos):
    d = x.shape[-1]
    half = d // 2
    inv = jnp.exp(jnp.arange(half, dtype=jnp.float32) * (-2.0 * math.log(ROPE_THETA) / d))
    ang = pos.astype(jnp.float32)[:, None] * inv[None, :]
    shape = (ang.shape[0],) + (1,) * (x.ndim - 3) + (half,)
    cos = jnp.cos(ang).reshape(shape)
    sin = jnp.sin(ang).reshape(shape)
    xf = x.astype(jnp.float32)
    x1, x2 = xf[..., :half], xf[..., half:]
    return jnp.concatenate([x1 * cos - x2 * sin, x2 * cos + x1 * sin], axis=-1).astype(x.dtype)


def causal_dwconv3(u, prev, w):
    t = u.shape[1]
    ext = jnp.concatenate([prev.astype(u.dtype), u], axis=1)
    y = sum(ext[:, j:j + t] * w[j] for j in range(CONV_W))
    return y, ext[:, t:]


def split_projection(z, pos, q_g, k_g):
    b, t = z.shape[:2]
    cuts = np.cumsum(PROJ_SIZES)[:-1].tolist()
    cb, cc, ch, q, k, v, qi, ki, iw = jnp.split(z, cuts, axis=-1)
    q = rope(rms_norm(q.reshape(b, t, N_HEADS, HEAD_DIM), q_g), pos)
    k = rope(rms_norm(k.reshape(b, t, N_HEADS, HEAD_DIM), k_g), pos)
    v = v.reshape(b, t, N_HEADS, HEAD_DIM)
    qi = rope(qi.reshape(b, t, N_IDX_HEADS, IDX_DIM), pos)
    ki = rope(ki, pos)
    return cb, cc, ch, q, k, v, qi, ki, iw


def indexer_scores(qi, iw, ki):
    dots = jnp.einsum('bthd,bsd->bths', qi, ki, preferred_element_type=jnp.float32)
    return jnp.einsum('bths,bth->bts', jax.nn.relu(dots), iw.astype(jnp.float32)) * IDX_SCALE


def prompt_sparse_attention(q, k, v, qi, ki, iw):
    b, s = q.shape[:2]
    topk = min(TOPK_MAX, s // 4)
    key_pos = jnp.arange(s)
    gather_rows = jax.vmap(lambda rows, idx: rows[idx])

    def block(i):
        t0 = i * Q_BLOCK
        qb = lax.dynamic_slice_in_dim(q, t0, Q_BLOCK, axis=1)
        qib = lax.dynamic_slice_in_dim(qi, t0, Q_BLOCK, axis=1)
        iwb = lax.dynamic_slice_in_dim(iw, t0, Q_BLOCK, axis=1)
        q_pos = t0 + jnp.arange(Q_BLOCK)
        sc = indexer_scores(qib, iwb, ki)
        sc = jnp.where(key_pos[None, None, :] <= q_pos[None, :, None], sc, -jnp.inf)
        _, sel = lax.top_k(sc, topk)
        valid = sel <= q_pos[None, :, None]
        ks = gather_rows(k, sel)
        vs = gather_rows(v, sel)
        logits = jnp.einsum('bthd,btkhd->bthk', qb, ks, preferred_element_type=jnp.float32) * ATTN_SCALE
        p = jax.nn.softmax(jnp.where(valid[:, :, None, :], logits, -jnp.inf), axis=-1)
        o = jnp.einsum('bthk,btkhd->bthd', p.astype(vs.dtype), vs)
        return o.reshape(b, Q_BLOCK, N_HEADS * HEAD_DIM)

    out = lax.map(block, jnp.arange(s // Q_BLOCK))
    return out.transpose(1, 0, 2, 3).reshape(b, s, N_HEADS * HEAD_DIM)


def sample_sparse_attention(q, k, v, qi, ki, iw, pool_k, pool_v, pool_idx_k, page_table):
    b, t = q.shape[:2]
    past = page_table.shape[1] * PAGE_SIZE
    topk = min(TOPK_MAX, (past + t) // 4)
    ki_past = pool_idx_k[page_table].reshape(b, past, IDX_DIM).astype(ki.dtype)
    ki_all = jnp.concatenate([ki_past, ki], axis=1)
    q_pos = past + jnp.arange(t)
    key_pos = jnp.arange(past + t)
    sc = indexer_scores(qi, iw, ki_all)
    sc = jnp.where(key_pos[None, None, :] <= q_pos[None, :, None], sc, -jnp.inf)
    _, sel = lax.top_k(sc, topk)
    in_past = sel < past
    logical = jnp.minimum(sel, past - 1)
    phys = jax.vmap(lambda pt, idx: pt[idx])(page_table, logical // PAGE_SIZE)
    off = logical % PAGE_SIZE
    kp = pool_k[phys, off]
    vp = pool_v[phys, off]
    new_pos = past + jnp.arange(t)
    sel_new = jnp.any(sel[..., None] == new_pos, axis=2)
    sel_new = sel_new & (new_pos[None, None, :] <= q_pos[None, :, None])
    lp = jnp.einsum('bthd,btkhd->bthk', q, kp, preferred_element_type=jnp.float32)
    ln = jnp.einsum('bthd,bjhd->bthj', q, k, preferred_element_type=jnp.float32)
    logits = jnp.concatenate([lp, ln], axis=-1) * ATTN_SCALE
    mask = jnp.concatenate([in_past, sel_new], axis=-1)[:, :, None, :]
    p = jax.nn.softmax(jnp.where(mask, logits, -jnp.inf), axis=-1).astype(v.dtype)
    o = (jnp.einsum('bthk,btkhd->bthd', p[..., :topk], vp.astype(v.dtype))
         + jnp.einsum('bthj,bjhd->bthd', p[..., topk:], v))
    return o.reshape(b, t, N_HEADS * HEAD_DIM)


def mixer_sublayer(h, pos, conv_prev, attend, g, w_in, conv_w, q_g, k_g, w_out):
    xn = rms_norm(h, g)
    cb, cc, ch, q, k, v, qi, ki, iw = split_projection(xn @ w_in, pos, q_g, k_g)
    conv_out, conv_state = causal_dwconv3(cc * ch, conv_prev, conv_w)
    att = attend(q, k, v, qi, ki, iw)
    y = jnp.concatenate([cb * conv_out, att.astype(h.dtype)], axis=-1) @ w_out
    return h + y, conv_state, k, v, ki


def memory_kv(mem, g_src, w_kv, k_g):
    b, m, _ = mem.shape
    mk, mv = jnp.split(rms_norm(mem, g_src) @ w_kv, 2, axis=-1)
    mk = rms_norm(mk.reshape(b, m, MEM_HEADS, MEM_HEAD_DIM), k_g)
    return mk, mv.reshape(b, m, MEM_HEADS, MEM_HEAD_DIM)


def memory_sublayer(h, mk, mv, g, w_q, q_g, w_o):
    b, t, _ = h.shape
    q = rms_norm((rms_norm(h, g) @ w_q).reshape(b, t, MEM_HEADS, MEM_HEAD_DIM), q_g)
    logits = jnp.einsum('bthd,bmhd->bhtm', q, mk, preferred_element_type=jnp.float32) * MEM_SCALE
    p = jax.nn.softmax(logits, axis=-1).astype(mv.dtype)
    o = jnp.einsum('bhtm,bmhd->bthd', p, mv).reshape(b, t, MEM_HEADS * MEM_HEAD_DIM)
    return h + (o @ w_o).astype(h.dtype)


def ffn_sublayer(h, prev, g, w_gu, conv_w, conv_b, w_down):
    gate, up = jnp.split(rms_norm(h, g) @ w_gu, 2, axis=-1)
    gate_c, state = causal_dwconv3(gate, prev, conv_w)
    return h + (jax.nn.silu(gate_c + conv_b) * up) @ w_down, state


def setup_inputs(seed: int = 0) -> dict:
    key = jax.random.key(seed)
    ks = jax.random.split(key, 32)

    def nrm(i, shape, scale):
        return jax.random.normal(ks[i], shape, jnp.float32) * scale

    def gain(i, n):
        return 1.0 + 0.1 * jax.random.normal(ks[i], (DEPTH, n), jnp.float32)

    n_pages = PAST_LEN // PAGE_SIZE
    n_used = DEC_BATCH * n_pages
    n_pool = n_used + n_used // 4
    page_table = jax.random.permutation(ks[0], n_pool)[:n_used].reshape(DEC_BATCH, n_pages).astype(jnp.int32)
    return {
        'x_prompt': nrm(1, (BATCH, SEQ, D_MODEL), 1.0),
        'x_sample': nrm(2, (DEC_BATCH, DEC_SEQ, D_MODEL), 1.0),
        'cache_k': nrm(3, (DEPTH, n_pool, PAGE_SIZE, N_HEADS, HEAD_DIM), 1.0),
        'cache_v': nrm(4, (DEPTH, n_pool, PAGE_SIZE, N_HEADS, HEAD_DIM), 1.0),
        'cache_idx_k': nrm(5, (DEPTH, n_pool, PAGE_SIZE, IDX_DIM), 1.0),
        'state_conv_mix': nrm(6, (DEPTH, DEC_BATCH, CONV_W - 1, D_CONV), 1.0),
        'state_conv_ffn': nrm(7, (DEPTH, DEC_BATCH, CONV_W - 1, D_FF), 1.0),
        'cache_mem_k': nrm(8, (DEPTH, DEC_BATCH, N_MEM, MEM_HEADS, MEM_HEAD_DIM), 1.0),
        'cache_mem_v': nrm(9, (DEPTH, DEC_BATCH, N_MEM, MEM_HEADS, MEM_HEAD_DIM), 1.0),
        'page_table': page_table,
        'mem_prompt': nrm(10, (BATCH, N_MEM, D_MODEL), 1.0),
        'g_mix': gain(11, D_MODEL),
        'w_in': nrm(12, (DEPTH, D_MODEL, D_IN), D_MODEL ** -0.5),
        'conv_mix_w': nrm(13, (DEPTH, CONV_W, D_CONV), CONV_W ** -0.5),
        'q_norm_g': gain(14, HEAD_DIM),
        'k_norm_g': gain(15, HEAD_DIM),
        'w_out': nrm(16, (DEPTH, D_MIX, D_MODEL), D_MIX ** -0.5),
        'g_mem': gain(17, D_MODEL),
        'g_mem_src': gain(18, D_MODEL),
        'w_q_mem': nrm(19, (DEPTH, D_MODEL, MEM_HEADS * MEM_HEAD_DIM), D_MODEL ** -0.5),
        'w_kv_mem': nrm(20, (DEPTH, D_MODEL, 2 * MEM_HEADS * MEM_HEAD_DIM), D_MODEL ** -0.5),
        'mq_norm_g': gain(21, MEM_HEAD_DIM),
        'mk_norm_g': gain(22, MEM_HEAD_DIM),
        'w_o_mem': nrm(23, (DEPTH, MEM_HEADS * MEM_HEAD_DIM, D_MODEL), (MEM_HEADS * MEM_HEAD_DIM) ** -0.5),
        'g_ffn': gain(24, D_MODEL),
        'w_gu': nrm(25, (DEPTH, D_MODEL, 2 * D_FF), D_MODEL ** -0.5),
        'conv_ffn_w': nrm(26, (DEPTH, CONV_W, D_FF), CONV_W ** -0.5),
        'conv_ffn_b': nrm(27, (DEPTH, D_FF), 0.02),
        'w_down': nrm(28, (DEPTH, D_FF, D_MODEL), D_FF ** -0.5),
    }


def reference(x_prompt, x_sample, cache_k, cache_v, cache_idx_k, state_conv_mix, state_conv_ffn,
              cache_mem_k, cache_mem_v, page_table, mem_prompt,
              g_mix, w_in, conv_mix_w, q_norm_g, k_norm_g, w_out,
              g_mem, g_mem_src, w_q_mem, w_kv_mem, mq_norm_g, mk_norm_g, w_o_mem,
              g_ffn, w_gu, conv_ffn_w, conv_ffn_b, w_down):
    b, s, _ = x_prompt.shape
    past = page_table.shape[1] * PAGE_SIZE
    pos_p = jnp.arange(s)
    pos_s = past + jnp.arange(x_sample.shape[1])
    zero_mix = jnp.zeros((b, CONV_W - 1, D_CONV), x_prompt.dtype)
    zero_ffn = jnp.zeros((b, CONV_W - 1, D_FF), x_prompt.dtype)
    hp, hs = x_prompt, x_sample
    kp_l, vp_l, ikp_l, cmp_l, cfp_l, mkp_l, mvp_l = [], [], [], [], [], [], []
    ks_l, vs_l, iks_l, cms_l, cfs_l = [], [], [], [], []
    for l in range(DEPTH):
        hp, c_mix, k_new, v_new, ik_new = mixer_sublayer(
            hp, pos_p, zero_mix, prompt_sparse_attention,
            g_mix[l], w_in[l], conv_mix_w[l], q_norm_g[l], k_norm_g[l], w_out[l])
        mk, mv = memory_kv(mem_prompt, g_mem_src[l], w_kv_mem[l], mk_norm_g[l])
        hp = memory_sublayer(hp, mk, mv, g_mem[l], w_q_mem[l], mq_norm_g[l], w_o_mem[l])
        hp, c_ffn = ffn_sublayer(hp, zero_ffn, g_ffn[l], w_gu[l], conv_ffn_w[l], conv_ffn_b[l], w_down[l])
        kp_l.append(k_new); vp_l.append(v_new); ikp_l.append(ik_new)
        cmp_l.append(c_mix); cfp_l.append(c_ffn); mkp_l.append(mk); mvp_l.append(mv)

        attend_s = functools.partial(sample_sparse_attention, pool_k=cache_k[l], pool_v=cache_v[l],
                                     pool_idx_k=cache_idx_k[l], page_table=page_table)
        hs, c_mix_s, k_s, v_s, ik_s = mixer_sublayer(
            hs, pos_s, state_conv_mix[l], attend_s,
            g_mix[l], w_in[l], conv_mix_w[l], q_norm_g[l], k_norm_g[l], w_out[l])
        hs = memory_sublayer(hs, cache_mem_k[l], cache_mem_v[l], g_mem[l], w_q_mem[l], mq_norm_g[l], w_o_mem[l])
        hs, c_ffn_s = ffn_sublayer(hs, state_conv_ffn[l], g_ffn[l], w_gu[l], conv_ffn_w[l], conv_ffn_b[l], w_down[l])
        ks_l.append(k_s); vs_l.append(v_s); iks_l.append(ik_s); cms_l.append(c_mix_s); cfs_l.append(c_ffn_s)

    return (hp, hs,
            jnp.stack(kp_l), jnp.stack(vp_l), jnp.stack(ikp_l), jnp.stack(cmp_l), jnp.stack(cfp_l),
            jnp.stack(mkp_l), jnp.stack(mvp_l),
            jnp.stack(ks_l), jnp.stack(vs_l), jnp.stack(iks_l), jnp.stack(cms_l), jnp.stack(cfs_l))
```

```cpp
#include <hip/hip_runtime.h>
#include <cstdio>
#include <cstdint>

#ifndef MK_N_LAUNCHES
#define MK_N_LAUNCHES 12
#endif

namespace pg8 {
#define PG8_LAS __attribute__((address_space(3)))
typedef unsigned short bf16_t;
typedef short bf16x8 __attribute__((ext_vector_type(8)));
typedef float f32x4 __attribute__((ext_vector_type(4)));
typedef unsigned u32x4 __attribute__((ext_vector_type(4)));
constexpr int BM = 256, BK = 64, HALF = 128, HTB = HALF * BK * 2  , STAGE_BYTES = 8 * HTB, NXCD = 8, WGM = 8;

__host__ __device__ __forceinline__ int lds_byte(int r, int c) { const int st = (r >> 4) * 2 + (c >> 5), rr = r & 15, cc = c & 31, ob = rr * 64 + cc * 2; return st * 1024 + (ob ^ (((ob >> 9) & 1) << 5)); }
__host__ __device__ __forceinline__ void stage_rc(int b, int& R, int& C) { const int st = b / 1024, sb = b % 1024, swz = sb ^ (((sb >> 9) & 1) << 5); R = (st >> 1) * 16 + swz / 64; C = (st & 1) * 32 + (swz % 64) / 2; }
__host__ __device__ __forceinline__ int perm32(int rho) { const int n = rho >> 4, i = rho & 15; return 8 * (i >> 2) + 4 * n + (i & 3); }

struct Unit { int pm, pn; };
struct Gemm { const bf16_t* A; const bf16_t* Bt; int M, N, K; };

struct StaticOrder {
    int nM, nN, nwg, G, c;
    __host__ __device__ void init(int M, int N, int G_, int c_) { nM = M / BM; nN = N / BM; nwg = nM * nN; G = G_; c = c_; }
    __host__ __device__ bool next(int i, Unit& u) const {
        const long L = (long)i * G + c; if (L >= nwg) return false;
        int wgid = (int)L; { const int q = nwg / NXCD, r = nwg % NXCD, xcd = wgid % NXCD, off = wgid / NXCD; wgid = (xcd < r ? xcd * (q + 1) : r * (q + 1) + (xcd - r) * q) + off; }
        const int nig = WGM * nN, gid = wgid / nig, fm = gid * WGM, gsz = (nM - fm) < WGM ? (nM - fm) : WGM;
        u.pm = fm + ((wgid % nig) % gsz); u.pn = (wgid % nig) / gsz; return true;
    }
    __device__ __forceinline__ void a_ready(const Unit&) const {}
    __device__ __forceinline__ void done(const Unit&) const {}
};

__device__ __forceinline__ unsigned cvt_pk_bf16(float lo, float hi) { unsigned r; asm volatile("v_cvt_pk_bf16_f32 %0, %1, %2" : "=v"(r) : "v"(lo), "v"(hi)); return r; }
typedef float f32x2 __attribute__((ext_vector_type(2)));
template <class Epi, class Sched, bool ALIGN_EPI = false, bool SP2 = false>
__device__ __forceinline__ void gemm_phase(PG8_LAS unsigned char* lds, const Gemm g, const Sched& S, const Epi& E) {
    const int tid = threadIdx.x, wid = __builtin_amdgcn_readfirstlane(tid >> 6), lane = tid & 63, wr = wid >> 2, wc = wid & 3, fr = lane & 15, fq = lane >> 4;
    const int K = g.K, nt = K / BK;
    unsigned voffA[2], voffB[2];
#pragma unroll
    for (int i = 0; i < 2; ++i) { int R, C; stage_rc(tid * 16 + i * 8192, R, C); const int Rb = Epi::PERM ? ((R & ~31) + perm32(R & 31)) : R;
        voffA[i] = (unsigned)(R * K + C) * 2u; voffB[i] = (unsigned)(Rb * K + C) * 2u; }
    const size_t kstep = (size_t)(BK * 2);
    const size_t hstep = (size_t)HALF * K * 2;
    const size_t tstep = 2 * hstep;
    const unsigned ldsw = (unsigned)wid * 1024u;
    const int aoff = lds_byte(wr * 64 + fr, fq * 8), boff = lds_byte(wc * 32 + fr, fq * 8);
#define PG8_SA(b, h) (((b) * 2 + (h)) * HTB)
#define PG8_SB(b, h) ((4 + (b) * 2 + (h)) * HTB)
#define PG8_STAGE(bufoff, gbase, voff) do { _Pragma("unroll") for (int _i = 0; _i < 2; ++_i) \
        __builtin_amdgcn_global_load_lds((const unsigned*)((const char*)(gbase) + (voff)[_i]), (PG8_LAS unsigned*)(lds + (bufoff) + ldsw + _i * 8192), 16, 0, 0); } while (0)
#define PG8_LDA(dst, b, h) do { _Pragma("unroll") for (int m = 0; m < 4; ++m) _Pragma("unroll") for (int k = 0; k < 2; ++k) dst[m][k] = *(const PG8_LAS bf16x8*)(lds + PG8_SA(b, h) + aoff + m * 2048 + k * 1024); } while (0)
#define PG8_LDB(dst, b, h) do { _Pragma("unroll") for (int n = 0; n < 2; ++n) _Pragma("unroll") for (int k = 0; k < 2; ++k) dst[n][k] = *(const PG8_LAS bf16x8*)(lds + PG8_SB(b, h) + boff + n * 2048 + k * 1024); } while (0)
#define PG8_MMA(ai, bj, At, Bt) do { __builtin_amdgcn_s_setprio(1); _Pragma("unroll") for (int m = 0; m < 4; ++m) _Pragma("unroll") for (int n = 0; n < 2; ++n) _Pragma("unroll") for (int k = 0; k < 2; ++k) \
        acc[ai][bj][m][n] = __builtin_amdgcn_mfma_f32_16x16x32_bf16(Bt[n][k], At[m][k], acc[ai][bj][m][n], 0, 0, 0); __builtin_amdgcn_s_setprio(0); } while (0)
#define PG8_WAIT_V(n) asm volatile("s_waitcnt vmcnt(" #n ")" ::: "memory")
#define PG8_WAIT_L(n) asm volatile("s_waitcnt lgkmcnt(" #n ")" ::: "memory")
#define PG8_BAR __builtin_amdgcn_s_barrier()
#define PG8_SCHED __builtin_amdgcn_sched_barrier(0)
    Unit cur, nxt; int ui = 0;
    if (!S.next(0, cur)) return;
    f32x4 acc[2][2][4][2];
#pragma unroll
    for (int a = 0; a < 2; ++a)
#pragma unroll
        for (int b = 0; b < 2; ++b)
#pragma unroll
            for (int m = 0; m < 4; ++m)
#pragma unroll
                for (int n = 0; n < 2; ++n) acc[a][b][m][n] = (f32x4){0.f, 0.f, 0.f, 0.f};
    bf16x8 At[4][2], B0[2][2], B1[2][2];
    const char* cA = (const char*)g.A + (size_t)cur.pm * tstep; const char* cB = (const char*)g.Bt + (size_t)cur.pn * tstep;
    S.a_ready(cur);
    if constexpr (SP2) {
        PG8_STAGE(PG8_SB(0, 0), cB, voffB); PG8_STAGE(PG8_SB(0, 1), cB + hstep, voffB); PG8_STAGE(PG8_SA(0, 0), cA, voffA); PG8_STAGE(PG8_SA(0, 1), cA + hstep, voffA);
        if (wr == 1) PG8_BAR;
        PG8_WAIT_V(2); PG8_BAR;
        PG8_STAGE(PG8_SB(1, 0), cB + kstep, voffB); PG8_STAGE(PG8_SA(1, 0), cA + kstep, voffA); PG8_STAGE(PG8_SB(1, 1), cB + hstep + kstep, voffB);
        PG8_WAIT_V(6); PG8_BAR;
    } else {
        PG8_STAGE(PG8_SB(0, 0), cB, voffB); PG8_STAGE(PG8_SA(0, 0), cA, voffA); PG8_STAGE(PG8_SB(0, 1), cB + hstep, voffB); PG8_STAGE(PG8_SA(0, 1), cA + hstep, voffA);
        if (wr == 1) PG8_BAR;
        PG8_WAIT_V(4); PG8_BAR;
        PG8_STAGE(PG8_SB(1, 0), cB + kstep, voffB); PG8_STAGE(PG8_SA(1, 0), cA + kstep, voffA); PG8_STAGE(PG8_SB(1, 1), cB + hstep + kstep, voffB);
        PG8_WAIT_V(6); PG8_BAR;
    }
    for (;;) {
        const bool has_next = S.next(ui + 1, nxt);
        const char* nA = has_next ? (const char*)g.A + (size_t)nxt.pm * tstep : cA; const char* nB = has_next ? (const char*)g.Bt + (size_t)nxt.pn * tstep : cB;
        for (int t = 0; t < nt; t += 2) {
            const bool last = (t == nt - 2);
            const char* a1 = cA + (size_t)(t + 1) * kstep;
            const char* a2 = last ? nA : cA + (size_t)(t + 2) * kstep; const char* b2 = last ? nB : cB + (size_t)(t + 2) * kstep;
            const char* a3 = a2 + kstep; const char* b3 = b2 + kstep;
            if (last && has_next) S.a_ready(nxt);
            if constexpr (SP2) {
            PG8_LDB(B0, 0, 0); PG8_LDB(B1, 0, 1); PG8_SCHED; PG8_LDA(At, 0, 0); PG8_STAGE(PG8_SA(1, 1), a1 + hstep, voffA);
            PG8_WAIT_V(8); PG8_WAIT_L(0); PG8_BAR; PG8_MMA(0, 0, At, B0); PG8_MMA(0, 1, At, B1); PG8_BAR; PG8_SCHED;
            PG8_LDA(At, 0, 1); PG8_STAGE(PG8_SB(0, 0), b2, voffB); PG8_STAGE(PG8_SB(0, 1), b2 + hstep, voffB); PG8_STAGE(PG8_SA(0, 0), a2, voffA);
            PG8_WAIT_V(8); PG8_WAIT_L(0); PG8_BAR; PG8_MMA(1, 0, At, B0); PG8_MMA(1, 1, At, B1); PG8_BAR; PG8_SCHED;
            PG8_LDB(B0, 1, 0); PG8_LDB(B1, 1, 1); PG8_SCHED; PG8_LDA(At, 1, 0); PG8_STAGE(PG8_SA(0, 1), a2 + hstep, voffA);
            PG8_WAIT_V(8); PG8_WAIT_L(0); PG8_BAR; PG8_MMA(0, 0, At, B0); PG8_MMA(0, 1, At, B1); PG8_BAR; PG8_SCHED;
            PG8_LDA(At, 1, 1); PG8_STAGE(PG8_SB(1, 0), b3, voffB); PG8_STAGE(PG8_SB(1, 1), b3 + hstep, voffB); PG8_STAGE(PG8_SA(1, 0), a3, voffA);
            PG8_WAIT_V(8); PG8_WAIT_L(0); PG8_BAR; PG8_MMA(1, 0, At, B0); PG8_MMA(1, 1, At, B1); PG8_BAR; PG8_SCHED;
            } else {
            PG8_LDB(B0, 0, 0); PG8_SCHED; PG8_LDA(At, 0, 0); PG8_STAGE(PG8_SA(1, 1), a1 + hstep, voffA);
            PG8_WAIT_L(8); PG8_BAR; PG8_WAIT_L(0); PG8_MMA(0, 0, At, B0); PG8_BAR; PG8_SCHED;
            PG8_LDB(B1, 0, 1); PG8_STAGE(PG8_SB(0, 0), b2, voffB);
            PG8_BAR; PG8_WAIT_L(0); PG8_MMA(0, 1, At, B1); PG8_BAR;
            PG8_LDA(At, 0, 1); PG8_STAGE(PG8_SA(0, 0), a2, voffA);
            PG8_BAR; PG8_WAIT_L(0); PG8_MMA(1, 0, At, B0); PG8_BAR; PG8_SCHED;
            PG8_STAGE(PG8_SB(0, 1), b2 + hstep, voffB);
            PG8_WAIT_V(6); PG8_BAR; PG8_MMA(1, 1, At, B1); PG8_BAR;
            PG8_LDB(B0, 1, 0); PG8_SCHED; PG8_LDA(At, 1, 0); PG8_STAGE(PG8_SA(0, 1), a2 + hstep, voffA);
            PG8_WAIT_L(8); PG8_BAR; PG8_WAIT_L(0); PG8_MMA(0, 0, At, B0); PG8_BAR; PG8_SCHED;
            PG8_LDB(B1, 1, 1); PG8_STAGE(PG8_SB(1, 0), b3, voffB);
            PG8_BAR; PG8_WAIT_L(0); PG8_MMA(0, 1, At, B1); PG8_BAR;
            PG8_LDA(At, 1, 1); PG8_STAGE(PG8_SA(1, 0), a3, voffA);
            PG8_BAR; PG8_WAIT_L(0); PG8_MMA(1, 0, At, B0); PG8_BAR; PG8_SCHED;
            PG8_STAGE(PG8_SB(1, 1), b3 + hstep, voffB);
            PG8_WAIT_V(6); PG8_BAR; PG8_MMA(1, 1, At, B1); PG8_BAR;
            }
        }
        if constexpr (ALIGN_EPI) { if (wr == 0) PG8_BAR; }
        if constexpr (!Epi::AFTER_DRAIN) { E(acc, cur, wr, wc, fr, fq); S.done(cur); }
        if (!has_next) break;
#pragma unroll
        for (int a = 0; a < 2; ++a)
#pragma unroll
            for (int b = 0; b < 2; ++b)
#pragma unroll
                for (int m = 0; m < 4; ++m)
#pragma unroll
                    for (int n = 0; n < 2; ++n) acc[a][b][m][n] = (f32x4){0.f, 0.f, 0.f, 0.f};
        cur = nxt; cA = nA; cB = nB; ++ui;
        if constexpr (ALIGN_EPI) { if (wr == 1) PG8_BAR; }
    }
    PG8_WAIT_V(0);
    if constexpr (!ALIGN_EPI) { if (wr == 0) PG8_BAR; }
    PG8_BAR;
    if constexpr (Epi::AFTER_DRAIN) { E.fused(acc, cur, wr, wc, fr, fq, lds, wid, lane); S.done(cur); }
#undef PG8_SA
#undef PG8_SB
#undef PG8_STAGE
#undef PG8_LDA
#undef PG8_LDB
#undef PG8_MMA
#undef PG8_WAIT_V
#undef PG8_WAIT_L
#undef PG8_BAR
#undef PG8_SCHED
}
}
#define GAS __attribute__((address_space(1)))
#define LAS __attribute__((address_space(3)))
#define RLX_AGENT __ATOMIC_RELAXED, __HIP_MEMORY_SCOPE_AGENT
#define XB_TMO      128
#define XB_XCNT(j)  (256  + 64 * (j))
#define XB_XSUB(j)  (1280 + 64 * (j))
#define XB_XGEN(j)  (2304 + 64 * (j))
#define XB_TOP      3328
#define XB_TOPGEN   3392
#define XCD_BAR_WORDS 3456
#define XB_SPIN_CAP (1u << 18)

__device__ __forceinline__ unsigned xb_ld(unsigned* p)              { return __hip_atomic_load(p, __ATOMIC_RELAXED, __HIP_MEMORY_SCOPE_AGENT); }
__device__ __forceinline__ unsigned xb_add(unsigned* p, unsigned v) { return __hip_atomic_fetch_add(p, v, __ATOMIC_RELAXED, __HIP_MEMORY_SCOPE_AGENT); }
__device__ __forceinline__ unsigned xb_xcc_id() { return (unsigned)__builtin_amdgcn_s_getreg((3 << 11) | 20) & 0xFu; }
#define XB_SPIN(cond, bar) do { unsigned _sp = 0; while (cond) { __builtin_amdgcn_s_sleep(1); \
    if ((++_sp & 255u) == 0u) { if (xb_ld(&(bar)[XB_TMO])) break; if (_sp > XB_SPIN_CAP) { atomicAdd(&(bar)[XB_TMO], 1u); break; } } } } while (0)

struct XcdBarrier {
    unsigned* bar; unsigned x;
    volatile LAS unsigned* st;
};

__device__ __forceinline__ XcdBarrier xcd_barrier_post(unsigned* bar, volatile LAS unsigned* st) {
    XcdBarrier b; b.bar = bar; b.x = xb_xcc_id(); b.st = st;
    if (threadIdx.x == 0) (void)xb_add(&bar[XB_XCNT(b.x)], 1u);
    return b;
}
__device__ __forceinline__ void xcd_barrier_complete(unsigned* bar, unsigned x, unsigned& nloc, unsigned& nx) {
    const unsigned G = gridDim.x * gridDim.y * gridDim.z;
    unsigned sum, cnt, mine, sp = 0u;
    for (;;) {
        sum = 0u; cnt = 0u; mine = 0u;
#pragma unroll
        for (unsigned j = 0; j < 16; ++j) { const unsigned c = xb_ld(&bar[XB_XCNT(j)]); sum += c; cnt += (c > 0u) ? 1u : 0u; mine = (j == x) ? c : mine; }
        if (sum == G) break;
        __builtin_amdgcn_s_sleep(1);
        if ((++sp & 255u) == 0u) { if (xb_ld(&bar[XB_TMO])) break; if (sp > XB_SPIN_CAP) { atomicAdd(&bar[XB_TMO], 1u); break; } }
    }
    nloc = mine > 0u ? mine : 1u; nx = cnt > 0u ? cnt : 1u;
}

__device__ __forceinline__ void xcd_barrier(const XcdBarrier& b) {
    asm volatile("s_waitcnt vmcnt(0)" ::: "memory");
    __syncthreads();
    if (threadIdx.x == 0) {
        unsigned* bar = b.bar;
        __builtin_amdgcn_s_waitcnt(0);
        unsigned nloc = b.st[0], nx = b.st[1];
        if (nloc == 0u) { xcd_barrier_complete(bar, b.x, nloc, nx); b.st[0] = nloc; b.st[1] = nx; }
        const unsigned old = xb_add(&bar[XB_XSUB(b.x)], 1u);
        const unsigned gen = old / nloc;
        if (old + 1u == (gen + 1u) * nloc) {
            __builtin_amdgcn_fence(__ATOMIC_RELEASE, "agent");
            asm volatile("s_waitcnt vmcnt(0)" ::: "memory");
            const unsigned og = xb_add(&bar[XB_TOP], 1u);
            const unsigned tg = og / nx;
            if (og + 1u == (tg + 1u) * nx) xb_add(&bar[XB_TOPGEN], 1u);
            else XB_SPIN(xb_ld(&bar[XB_TOPGEN]) == tg, bar);
            __builtin_amdgcn_fence(__ATOMIC_ACQUIRE, "agent");
            xb_add(&bar[XB_XGEN(b.x)], 1u);
            asm volatile("s_waitcnt vmcnt(0)" ::: "memory");
        } else {
            XB_SPIN(xb_ld(&bar[XB_XGEN(b.x)]) == gen, bar);
            __builtin_amdgcn_fence(__ATOMIC_ACQUIRE, "agent");
            asm volatile("s_waitcnt vmcnt(0)" ::: "memory");
        }
    }
    __syncthreads();
}
using pg8::bf16_t; using pg8::f32x4; using pg8::u32x4; using pg8::Unit; using pg8::cvt_pk_bf16;
typedef unsigned long long u64;
constexpr int DM = 1024, SEQ = 8192, NB = 2, MP = NB * SEQ, DB = 128, DS = 8, MS = DB * DS, MT = MP + MS;
constexpr int PAST = 2048, PAGE = 128, NPAGES = 16;
constexpr int DCONV = 512, NH = 8, HD = 64, TOPK = 256;
constexpr int NMEM = 256, MH = 4, MHD = 256, DFF = 2816;
constexpr int DIN = 3656, DINP = 3840;
constexpr float EPS = 1e-6f;
constexpr int SPITCH = 2112;
constexpr int NWAVES = 8, NTHREADS = 512;
constexpr int NPHASE = 12;
constexpr int N_LAUNCHES = MK_N_LAUNCHES;

constexpr size_t OFF_Y_P = 0, OFF_Y_S = 16777216, OFF_K_P = 17825792, OFF_V_P = 26214400, OFF_IK_P = 34603008, OFF_CM_P = 35651584, OFF_CF_P = 35653632,
                 OFF_MK_P = 35664896, OFF_MV_P = 36189184, OFF_K_S = 36713472, OFF_V_S = 37237760, OFF_IK_S = 37762048, OFF_CM_S = 37827584, OFF_CF_S = 37958656, OUT_TOTAL = 38679552;

constexpr size_t MiB = 1u << 20;
constexpr size_t WS_CTL = 0, CTL_ZERO_BYTES = 1 * MiB;
constexpr size_t ACC_SS1 = 65536, ACC_SS2 = 139264, ACC_SSQ = 212992, ACC_SSK = 491520;
constexpr size_t WS_WIN = 1 * MiB, WS_WOUT = 9 * MiB, WS_WQ = 11 * MiB, WS_WKV = 13 * MiB, WS_WO = 17 * MiB, WS_WGU = 19 * MiB, WS_WDOWN = 30 * MiB;
constexpr size_t WS_COS = 36 * MiB, WS_SIN = 37 * MiB, WS_RSTD = 38 * MiB, WS_IW = 39 * MiB;
constexpr size_t WS_XB = 40 * MiB, WS_MEMB = 74 * MiB, WS_QIF = 75 * MiB  , WS_CB = 78 * MiB, WS_U = 95 * MiB;
constexpr size_t WS_Q = 112 * MiB, WS_K = 129 * MiB, WS_V = 146 * MiB, WS_QI = 163 * MiB, WS_KI = 180 * MiB, WS_AMIX = 183 * MiB;
constexpr size_t WS_H1 = 217 * MiB, WS_H1B = 285 * MiB, WS_QMEM = 319 * MiB, WS_OMEM = 353 * MiB, WS_H2 = 387 * MiB, WS_H2B = 455 * MiB;
constexpr size_t WS_G = 489 * MiB, WS_UP = 676 * MiB, WS_AFF = 770 * MiB, WS_SC = 864 * MiB, WS_SCS = 1376 * MiB, WS_SEL = 1385 * MiB, WS_CNT = 1403 * MiB, WS_END = 1404 * MiB;

constexpr int CW_BAR = 4096;
constexpr int RING_BYTES = 131072, MISC_OFF = RING_BYTES + 320, LDS_BYTES = 147456;

#define GAS __attribute__((address_space(1)))
#define LAS __attribute__((address_space(3)))
#define LDS_WAIT() asm volatile("s_waitcnt lgkmcnt(0)" ::: "memory")
typedef short bf16x8 __attribute__((ext_vector_type(8)));
typedef float f32x16 __attribute__((ext_vector_type(16)));

__device__ __forceinline__ float bf2f(unsigned b) { return __uint_as_float(b << 16); }
__device__ __forceinline__ float wave_sum(float v) {
#pragma unroll
    for (int o = 1; o < 64; o <<= 1) v += __shfl_xor(v, o);
    return v;
}
__device__ __forceinline__ float wave_max(float v) {
#pragma unroll
    for (int o = 1; o < 64; o <<= 1) v = fmaxf(v, __shfl_xor(v, o));
    return v;
}
__device__ __forceinline__ void store8_bf16(bf16_t* p, const float* v) {
    u32x4 w; w.x = cvt_pk_bf16(v[0], v[1]); w.y = cvt_pk_bf16(v[2], v[3]); w.z = cvt_pk_bf16(v[4], v[5]); w.w = cvt_pk_bf16(v[6], v[7]);
    *(u32x4*)p = w;
}
__device__ __forceinline__ void store8_f32(float* p, const float* v) {
    *(f32x4*)p = (f32x4){v[0], v[1], v[2], v[3]}; *(f32x4*)(p + 4) = (f32x4){v[4], v[5], v[6], v[7]};
}
__device__ __forceinline__ void load8_f32(const float* p, float* v) {
    const f32x4 a = *(const f32x4*)p, b = *(const f32x4*)(p + 4);
    v[0] = a.x; v[1] = a.y; v[2] = a.z; v[3] = a.w; v[4] = b.x; v[5] = b.y; v[6] = b.z; v[7] = b.w;
}
__device__ __forceinline__ void load8_bf16(const bf16_t* p, float* v) {
    const u32x4 w = *(const u32x4*)p;
    v[0] = bf2f(w.x & 0xffffu); v[1] = bf2f(w.x >> 16); v[2] = bf2f(w.y & 0xffffu); v[3] = bf2f(w.y >> 16);
    v[4] = bf2f(w.z & 0xffffu); v[5] = bf2f(w.z >> 16); v[6] = bf2f(w.w & 0xffffu); v[7] = bf2f(w.w >> 16);
}

struct Args { const void* in[29]; float* out; unsigned char* ws; int ph_lo, ph_hi; };
struct Ctx {
    const float *x_p, *x_s, *cache_k, *cache_v, *cache_ik, *st_mix, *st_ffn, *cmem_k, *cmem_v; const int* page_table; const float* mem_p;
    const float *g_mix, *w_in, *conv_mix_w, *q_g, *k_g, *w_out, *g_mem, *g_mem_src, *w_q, *w_kv, *mq_g, *mk_g, *w_o, *g_ffn, *w_gu, *conv_ffn_w, *conv_ffn_b, *w_down;
    float* out; unsigned char* ws;
    int tid, lane, wave, G, bid;
};

#define EPI_ROWS(ai, m) (u.pm * 256 + (ai) * 128 + wr * 64 + (m) * 16 + fr)
#define EPI_GET(dst, ai, bj, m, s) do { _Pragma("unroll") for (int e_ = 0; e_ < 4; ++e_) { (dst)[e_] = acc[ai][bj][m][0][e_] * (s); (dst)[4 + e_] = acc[ai][bj][m][1][e_] * (s); } } while (0)

struct EpiIn {
    static constexpr bool PERM = true, AFTER_DRAIN = false;
    const float* rstd; const float* cosT; const float* sinT; const float* qg; const float* kg;
    bf16_t *cbb, *ub, *qb, *kb, *vb, *qib, *kib; float* iwf; float* qif; float* out;
    __device__ __forceinline__ void operator()(const f32x4 (&acc)[2][2][4][2], const Unit& u, int wr, int wc, int fr, int fq) const {
        const int pn = u.pn; const int c8 = wc * 32 + 8 * fq; const bool samp = (u.pm >= 64);
#pragma unroll
        for (int ai = 0; ai < 2; ++ai)
#pragma unroll
            for (int m = 0; m < 4; ++m) {
                const int r = EPI_ROWS(ai, m); const float rs = rstd[r];
                float lo[8], hi[8]; EPI_GET(lo, ai, 0, m, rs); EPI_GET(hi, ai, 1, m, rs);
                const int rl = samp ? r - MP : r; const int pos = samp ? PAST + (rl & 7) : (rl & (SEQ - 1));
                if (pn < 2) {
                    store8_bf16(cbb + (size_t)r * 512 + pn * 256 + c8, lo); store8_bf16(cbb + (size_t)r * 512 + pn * 256 + 128 + c8, hi);
                } else if (pn < 6) {
                    const int ch = 128 * (pn - 2) + c8; float uu[8];
#pragma unroll
                    for (int e = 0; e < 8; ++e) uu[e] = lo[e] * hi[e];
                    store8_bf16(ub + (size_t)r * 512 + ch, uu);
                    if (!samp) { const int t = rl & (SEQ - 1); if (t >= SEQ - 2) store8_f32(out + OFF_CM_P + (size_t)((rl >> 13) * 2 + (t - (SEQ - 2))) * 512 + ch, uu); }
                    else { const int tt = rl & 7; if (tt >= 6) store8_f32(out + OFF_CM_S + (size_t)((rl >> 3) * 2 + (tt - 6)) * 512 + ch, uu); }
                } else if (pn < 10 || pn == 12 || pn == 13) {
                    const int head = 4 * (pn & 1) + wc; const int d0 = 8 * fq;
                    if (pn < 10) {
                        float ss = 0.f;
#pragma unroll
                        for (int e = 0; e < 8; ++e) ss += lo[e] * lo[e] + hi[e] * hi[e];
                        ss += __shfl_xor(ss, 16); ss += __shfl_xor(ss, 32);
                        const float rn = 1.0f / sqrtf(ss * (1.f / 64.f) + EPS);
                        const float* g = (pn < 8) ? qg : kg; float gl[8], gh[8]; load8_f32(g + d0, gl); load8_f32(g + 32 + d0, gh);
#pragma unroll
                        for (int e = 0; e < 8; ++e) { lo[e] *= rn * gl[e]; hi[e] *= rn * gh[e]; }
                    }
                    float cs[8], sn[8]; load8_f32(cosT + (size_t)pos * 32 + d0, cs); load8_f32(sinT + (size_t)pos * 32 + d0, sn);
                    float ol[8], oh[8];
#pragma unroll
                    for (int e = 0; e < 8; ++e) { ol[e] = lo[e] * cs[e] - hi[e] * sn[e]; oh[e] = hi[e] * cs[e] + lo[e] * sn[e]; }
                    const size_t o512 = (size_t)r * 512 + head * 64 + d0;
                    if (pn < 8) {
#pragma unroll
                        for (int e = 0; e < 8; ++e) { ol[e] *= 0.125f; oh[e] *= 0.125f; }
                        store8_bf16(qb + o512, ol); store8_bf16(qb + o512 + 32, oh);
                    } else if (pn < 10) {
                        store8_bf16(kb + o512, ol); store8_bf16(kb + o512 + 32, oh);
                        float* ko = out + (samp ? OFF_K_S : OFF_K_P) + (size_t)rl * 512 + head * 64 + d0; store8_f32(ko, ol); store8_f32(ko + 32, oh);
                    } else {
                        store8_bf16(qib + o512, ol); store8_bf16(qib + o512 + 32, oh);
                        if (samp) { float* qo = qif + (size_t)rl * 512 + head * 64 + d0; store8_f32(qo, ol); store8_f32(qo + 32, oh); }
                    }
                } else if (pn < 12) {
                    const int c = 256 * (pn - 10) + c8;
                    store8_bf16(vb + (size_t)r * 512 + c, lo); store8_bf16(vb + (size_t)r * 512 + c + 128, hi);
                    float* vo = out + (samp ? OFF_V_S : OFF_V_P) + (size_t)rl * 512 + c; store8_f32(vo, lo); store8_f32(vo + 128, hi);
                } else {
                    if (wc == 0) {
                        const int d0 = 8 * fq; float cs[8], sn[8]; load8_f32(cosT + (size_t)pos * 32 + d0, cs); load8_f32(sinT + (size_t)pos * 32 + d0, sn);
                        float ol[8], oh[8];
#pragma unroll
                        for (int e = 0; e < 8; ++e) { ol[e] = lo[e] * cs[e] - hi[e] * sn[e]; oh[e] = hi[e] * cs[e] + lo[e] * sn[e]; }
                        store8_bf16(kib + (size_t)r * 64 + d0, ol); store8_bf16(kib + (size_t)r * 64 + 32 + d0, oh);
                        float* io = out + (samp ? OFF_IK_S : OFF_IK_P) + (size_t)rl * 64 + d0; store8_f32(io, ol); store8_f32(io + 32, oh);
                    } else if (wc == 1 && fq == 0) {
                        store8_f32(iwf + (size_t)r * 8, lo);
                    }
                }
            }
    }
};

struct EpiKv {
    static constexpr bool PERM = true, AFTER_DRAIN = false;
    const float* rstd; float* ssk; float* out;
    __device__ __forceinline__ void operator()(const f32x4 (&acc)[2][2][4][2], const Unit& u, int wr, int wc, int fr, int fq) const {
        const int pn = u.pn; const int c8 = wc * 32 + 8 * fq;
#pragma unroll
        for (int ai = 0; ai < 2; ++ai)
#pragma unroll
            for (int m = 0; m < 4; ++m) {
                const int r = EPI_ROWS(ai, m); const float rs = rstd[r];
                float lo[8], hi[8]; EPI_GET(lo, ai, 0, m, rs); EPI_GET(hi, ai, 1, m, rs);
                if (pn < 4) {
                    float* o = out + OFF_MK_P + (size_t)r * 1024 + pn * 256 + c8; store8_f32(o, lo); store8_f32(o + 128, hi);
                    float ss = 0.f;
#pragma unroll
                    for (int e = 0; e < 8; ++e) ss += lo[e] * lo[e] + hi[e] * hi[e];
                    ss += __shfl_xor(ss, 16); ss += __shfl_xor(ss, 32);
                    if (fq == 0) atomicAdd(ssk + r * 4 + pn, ss);
                } else {
                    float* o = out + OFF_MV_P + (size_t)r * 1024 + (pn - 4) * 256 + c8; store8_f32(o, lo); store8_f32(o + 128, hi);
                }
            }
    }
};

struct EpiRes {
    static constexpr bool PERM = true, AFTER_DRAIN = false;
    const float* resP; const float* resS; float* dstP; float* dstS; bf16_t* dstB; float* ss;
    __device__ __forceinline__ void operator()(const f32x4 (&acc)[2][2][4][2], const Unit& u, int wr, int wc, int fr, int fq) const {
        const bool samp = (u.pm >= 64); const int c8 = u.pn * 256 + wc * 32 + 8 * fq;
#pragma unroll
        for (int ai = 0; ai < 2; ++ai)
#pragma unroll
            for (int m = 0; m < 4; ++m) {
                const int r = EPI_ROWS(ai, m); const int rl = samp ? r - MP : r;
                const float* rp = (samp ? resS : resP) + (size_t)rl * 1024 + c8; float* dp = (samp ? dstS : dstP) + (size_t)rl * 1024 + c8;
                float lo[8], hi[8], a[8], b[8]; EPI_GET(lo, ai, 0, m, 1.f); EPI_GET(hi, ai, 1, m, 1.f); load8_f32(rp, a); load8_f32(rp + 128, b);
                float s2 = 0.f;
#pragma unroll
                for (int e = 0; e < 8; ++e) { lo[e] += a[e]; hi[e] += b[e]; s2 += lo[e] * lo[e] + hi[e] * hi[e]; }
                store8_f32(dp, lo); store8_f32(dp + 128, hi);
                if (dstB) { store8_bf16(dstB + (size_t)r * 1024 + c8, lo); store8_bf16(dstB + (size_t)r * 1024 + c8 + 128, hi); }
                if (ss) { s2 += __shfl_xor(s2, 16); s2 += __shfl_xor(s2, 32); if (fq == 0) atomicAdd(ss + r, s2); }
            }
    }
};

struct EpiQm {
    static constexpr bool PERM = true, AFTER_DRAIN = false;
    const float* ss1; const float* mqg; bf16_t* qmem; float* ssq;
    __device__ __forceinline__ void operator()(const f32x4 (&acc)[2][2][4][2], const Unit& u, int wr, int wc, int fr, int fq) const {
        const int c8 = wc * 32 + 8 * fq; float gl[8], gh[8]; load8_f32(mqg + c8, gl); load8_f32(mqg + 128 + c8, gh);
#pragma unroll
        for (int ai = 0; ai < 2; ++ai)
#pragma unroll
            for (int m = 0; m < 4; ++m) {
                const int r = EPI_ROWS(ai, m); const float rs = 1.0f / sqrtf(ss1[r] * (1.f / 1024.f) + EPS);
                float lo[8], hi[8]; EPI_GET(lo, ai, 0, m, rs); EPI_GET(hi, ai, 1, m, rs);
                float s2 = 0.f;
#pragma unroll
                for (int e = 0; e < 8; ++e) { s2 += lo[e] * lo[e] + hi[e] * hi[e]; lo[e] *= gl[e]; hi[e] *= gh[e]; }
                s2 += __shfl_xor(s2, 16); s2 += __shfl_xor(s2, 32); if (fq == 0) atomicAdd(ssq + r * 4 + u.pn, s2);
                bf16_t* o = qmem + (size_t)r * 1024 + u.pn * 256 + c8; store8_bf16(o, lo); store8_bf16(o + 128, hi);
            }
    }
};

struct EpiGu {
    static constexpr bool PERM = true, AFTER_DRAIN = false;
    const float* ss2; float* G; bf16_t* UP;
    __device__ __forceinline__ void operator()(const f32x4 (&acc)[2][2][4][2], const Unit& u, int wr, int wc, int fr, int fq) const {
        const int ch = 128 * u.pn + wc * 32 + 8 * fq;
#pragma unroll
        for (int ai = 0; ai < 2; ++ai)
#pragma unroll
            for (int m = 0; m < 4; ++m) {
                const int r = EPI_ROWS(ai, m); const float rs = 1.0f / sqrtf(ss2[r] * (1.f / 1024.f) + EPS);
                float lo[8], hi[8]; EPI_GET(lo, ai, 0, m, rs); EPI_GET(hi, ai, 1, m, rs);
                store8_f32(G + (size_t)r * DFF + ch, lo); store8_bf16(UP + (size_t)r * DFF + ch, hi);
            }
    }
};

__device__ __forceinline__ int orig_win(int np) {
    const int T = np >> 8, cl = np & 255, bj = cl >> 7, wc = (cl >> 5) & 3, i = cl & 31;
    if (T < 2) return np;
    if (T < 6) return (bj ? 1024 : 512) + 128 * (T - 2) + (cl & 127);
    if (T < 8) return 1536 + (4 * (T - 6) + wc) * 64 + 32 * bj + i;
    if (T < 10) return 2048 + (4 * (T - 8) + wc) * 64 + 32 * bj + i;
    if (T < 12) return 2560 + 256 * (T - 10) + cl;
    if (T < 14) return 3072 + (4 * (T - 12) + wc) * 64 + 32 * bj + i;
    if (wc == 0) return 3584 + 32 * bj + i;
    if (wc == 1 && bj == 0 && i < 8) return 3648 + i;
    return -1;
}
__device__ __forceinline__ int orig_wgu(int np) { const int T = np >> 8, cl = np & 255; return ((cl >> 7) ? DFF : 0) + 128 * T + (cl & 127); }

template <int MODE> __device__ __forceinline__ void wt_item(const float* W, int K, int N, const float* gain, bf16_t* WT, int item, float* scr, int tid) {
    const int nkb = K >> 6; const int nb = item / nkb, kb = item - nb * nkb; const int n0 = nb * 64, k0 = kb * 64;
    const int j = tid & 63, i0 = tid >> 6; const int np = n0 + j;
    const int o = (MODE == 1) ? orig_win(np) : (MODE == 2) ? orig_wgu(np) : np;
#pragma unroll
    for (int rr = 0; rr < 8; ++rr) { const int k = k0 + i0 + 8 * rr; float v = 0.f; if (o >= 0) { v = W[(size_t)k * N + o]; if (gain) v *= gain[k]; } scr[j * 65 + i0 + 8 * rr] = v; }
    __syncthreads();
    const int kk2 = (tid & 31) * 2, j0 = tid >> 5;
#pragma unroll
    for (int rr = 0; rr < 4; ++rr) { const int jj = j0 + 16 * rr; *(unsigned*)(WT + (size_t)(n0 + jj) * K + k0 + kk2) = cvt_pk_bf16(scr[jj * 65 + kk2], scr[jj * 65 + kk2 + 1]); }
    __syncthreads();
}
__device__ __forceinline__ void row_to_bf16(const float* xrow, bf16_t* orow, float* rstd_out, int lane) {
    const f32x4* xr = (const f32x4*)xrow + lane; f32x4 v[4]; float s = 0.f;
#pragma unroll
    for (int j = 0; j < 4; ++j) { v[j] = xr[64 * j]; s += (v[j].x * v[j].x + v[j].y * v[j].y) + (v[j].z * v[j].z + v[j].w * v[j].w); }
    s = wave_sum(s); if (lane == 0) *rstd_out = 1.0f / sqrtf(s * (1.f / 1024.f) + EPS);
    u64* o8 = (u64*)orow + lane;
#pragma unroll
    for (int j = 0; j < 4; ++j) o8[64 * j] = (u64)cvt_pk_bf16(v[j].x, v[j].y) | ((u64)cvt_pk_bf16(v[j].z, v[j].w) << 32);
}
__device__ __forceinline__ void sincos_d(double a, float& sn, float& cs) {
    const double n = __builtin_rint(a * 0.63661977236758134308); const int q = ((int)n) & 3;
    double r = __builtin_fma(-n, 1.57079632679489655800e+00, a); r = __builtin_fma(-n, 6.12323399573676603587e-17, r);
    const double r2 = r * r;
    double ps = 1.0 / 6227020800.0; ps = ps * r2 - 1.0 / 39916800.0; ps = ps * r2 + 1.0 / 362880.0; ps = ps * r2 - 1.0 / 5040.0; ps = ps * r2 + 1.0 / 120.0; ps = ps * r2 - 1.0 / 6.0; ps = ps * r2 * r + r;
    double pc = -1.0 / 87178291200.0; pc = pc * r2 + 1.0 / 479001600.0; pc = pc * r2 - 1.0 / 3628800.0; pc = pc * r2 + 1.0 / 40320.0; pc = pc * r2 - 1.0 / 720.0; pc = pc * r2 + 1.0 / 24.0; pc = pc * r2 - 0.5; pc = pc * r2 + 1.0;
    const double s = (q == 0) ? ps : (q == 1) ? pc : (q == 2) ? -ps : -pc;
    const double c = (q == 0) ? pc : (q == 1) ? -ps : (q == 2) ? -pc : ps;
    sn = (float)s; cs = (float)c;
}
__device__ __forceinline__ void ph0_prologue(const Ctx& C, unsigned char* lds) {
    float* scr = (float*)lds;
    constexpr int I_IN = (DINP / 64) * 16, I_OUT = 256, I_Q = 256, I_KV = 512, I_O = 256, I_GU = (2 * DFF / 64) * 16, I_DN = 16 * (DFF / 64);
    constexpr int NIT = I_IN + I_OUT + I_Q + I_KV + I_O + I_GU + I_DN;
    for (int it = C.bid; it < NIT; it += C.G) {
        int r = it;
        if (r < I_IN) { wt_item<1>(C.w_in, DM, DIN, C.g_mix, (bf16_t*)(C.ws + WS_WIN), r, scr, C.tid); continue; } r -= I_IN;
        if (r < I_OUT) { wt_item<0>(C.w_out, DM, DM, nullptr, (bf16_t*)(C.ws + WS_WOUT), r, scr, C.tid); continue; } r -= I_OUT;
        if (r < I_Q) { wt_item<0>(C.w_q, DM, DM, C.g_mem, (bf16_t*)(C.ws + WS_WQ), r, scr, C.tid); continue; } r -= I_Q;
        if (r < I_KV) { wt_item<0>(C.w_kv, DM, 2 * DM, C.g_mem_src, (bf16_t*)(C.ws + WS_WKV), r, scr, C.tid); continue; } r -= I_KV;
        if (r < I_O) { wt_item<0>(C.w_o, DM, DM, nullptr, (bf16_t*)(C.ws + WS_WO), r, scr, C.tid); continue; } r -= I_O;
        if (r < I_GU) { wt_item<2>(C.w_gu, DM, 2 * DFF, C.g_ffn, (bf16_t*)(C.ws + WS_WGU), r, scr, C.tid); continue; } r -= I_GU;
        wt_item<0>(C.w_down, DFF, DM, nullptr, (bf16_t*)(C.ws + WS_WDOWN), r, scr, C.tid);
    }
    const int gw = C.bid * NWAVES + C.wave, NGW = C.G * NWAVES;
    float* rstd = (float*)(C.ws + WS_RSTD);
    for (int m = gw; m < MT + 512; m += NGW) {
        if (m < MP) row_to_bf16(C.x_p + (size_t)m * DM, (bf16_t*)(C.ws + WS_XB) + (size_t)m * DM, rstd + m, C.lane);
        else if (m < MT) row_to_bf16(C.x_s + (size_t)(m - MP) * DM, (bf16_t*)(C.ws + WS_XB) + (size_t)m * DM, rstd + m, C.lane);
        else row_to_bf16(C.mem_p + (size_t)(m - MT) * DM, (bf16_t*)(C.ws + WS_MEMB) + (size_t)(m - MT) * DM, rstd + m, C.lane);
    }
    const int gt = C.bid * NTHREADS + C.tid, NGT = C.G * NTHREADS;
    float* cosT = (float*)(C.ws + WS_COS); float* sinT = (float*)(C.ws + WS_SIN);
    for (int i = gt; i < SEQ * 32; i += NGT) {
        const int pos = i >> 5, d = i & 31;
        const float inv = expf((float)d * (float)(-2.0 * 9.210340371976184 / 64.0));
        const float ang = (float)pos * inv;
        float sn, cs; sincos_d((double)ang, sn, cs); cosT[i] = cs; sinT[i] = sn;
    }
}

__device__ __forceinline__ void ph2_memprep(const Ctx& C) {
    const int gt = C.bid * NTHREADS + C.tid, NGT = C.G * NTHREADS;
    const float* ssk = (const float*)(C.ws + ACC_SSK); float* mk = C.out + OFF_MK_P;
    for (int i = gt; i < 512 * 1024; i += NGT) {
        const int r = i >> 10, c = i & 1023, h = c >> 8, d = c & 255;
        const float rn = 1.0f / sqrtf(ssk[r * 4 + h] * (1.f / 256.f) + EPS);
        mk[i] = mk[i] * rn * C.mk_g[d];
    }
}
__device__ __forceinline__ void score_unit_prompt(const Ctx& C, int b, int g, unsigned char* lds) {
    const int lane = C.lane, r32 = lane & 31, hi = lane >> 5;
    const bf16_t* qib = (const bf16_t*)(C.ws + WS_QI); const bf16_t* kib = (const bf16_t*)(C.ws + WS_KI);
#pragma unroll
    for (int j = 0; j < 4; ++j) { const int id = C.tid + 512 * j, c = id >> 5, r = id & 31;
        *(u32x4*)(lds + id * 16) = *(const u32x4*)(qib + (size_t)(b * SEQ + 32 * g + r) * 512 + c * 8); }
    __syncthreads();
    const int qrow = b * SEQ + 32 * g + r32;
    float w[8]; load8_f32((const float*)(C.ws + WS_IW) + (size_t)qrow * 8, w);
    float* srow = (float*)(C.ws + WS_SC) + (size_t)qrow * SEQ;
    const int nt = (g >> 1) + 1;
    const unsigned char* qbase = lds + hi * 512 + r32 * 16;
    for (int kt = C.wave; kt < nt; kt += NWAVES) {
        const bf16_t* kp = kib + (size_t)(b * SEQ + kt * 64 + r32) * 64 + hi * 8;
        bf16x8 kf[4][2];
#pragma unroll
        for (int d0 = 0; d0 < 4; ++d0) { kf[d0][0] = *(const bf16x8*)(kp + d0 * 16); kf[d0][1] = *(const bf16x8*)(kp + 32 * 64 + d0 * 16); }
        float a0[16], a1[16];
#pragma unroll
        for (int r = 0; r < 16; ++r) { a0[r] = 0.f; a1[r] = 0.f; }
#pragma unroll
        for (int h = 0; h < 8; ++h) {
            bf16x8 qf[4];
#pragma unroll
            for (int d0 = 0; d0 < 4; ++d0) qf[d0] = *(const bf16x8*)(qbase + (h * 8 + d0 * 2) * 512);
            f32x16 p = {};
#pragma unroll
            for (int d0 = 0; d0 < 4; ++d0) p = __builtin_amdgcn_mfma_f32_32x32x16_bf16(kf[d0][0], qf[d0], p, 0, 0, 0);
#pragma unroll
            for (int r = 0; r < 16; ++r) a0[r] = __builtin_fmaf(w[h], __builtin_amdgcn_fmed3f(p[r], 0.f, __builtin_inff()), a0[r]);
            f32x16 p2 = {};
#pragma unroll
            for (int d0 = 0; d0 < 4; ++d0) p2 = __builtin_amdgcn_mfma_f32_32x32x16_bf16(kf[d0][1], qf[d0], p2, 0, 0, 0);
#pragma unroll
            for (int r = 0; r < 16; ++r) a1[r] = __builtin_fmaf(w[h], __builtin_amdgcn_fmed3f(p2[r], 0.f, __builtin_inff()), a1[r]);
#pragma unroll
            for (int r = 0; r < 16; ++r) { asm volatile("" : "+v"(a0[r])); asm volatile("" : "+v"(a1[r])); }
        }
#pragma unroll
        for (int rq = 0; rq < 4; ++rq) {
            *(f32x4*)(srow + kt * 64 + 8 * rq + 4 * hi) = (f32x4){a0[4 * rq], a0[4 * rq + 1], a0[4 * rq + 2], a0[4 * rq + 3]};
            *(f32x4*)(srow + kt * 64 + 32 + 8 * rq + 4 * hi) = (f32x4){a1[4 * rq], a1[4 * rq + 1], a1[4 * rq + 2], a1[4 * rq + 3]};
        }
    }
    __syncthreads();
}
__device__ __forceinline__ void score_unit_sample(const Ctx& C, int b, int c) {
    const int lane = C.lane; const int s = 64 * c + lane; const bool valid = s < PAST + DS;
    const float* kp;
    if (s < PAST) { const int page = C.page_table[b * NPAGES + (s >> 7)]; kp = C.cache_ik + ((size_t)page * PAGE + (s & (PAGE - 1))) * 64; }
    else kp = C.out + OFF_IK_S + (size_t)(b * DS + (valid ? s - PAST : 0)) * 64;
    float k[64];
#pragma unroll
    for (int j = 0; j < 16; ++j) { const f32x4 t = *(const f32x4*)(kp + 4 * j); k[4 * j] = t.x; k[4 * j + 1] = t.y; k[4 * j + 2] = t.z; k[4 * j + 3] = t.w; }
    const float* __restrict__ qf = (const float*)(C.ws + WS_QIF) + (size_t)(b * DS) * 512;
    const float* __restrict__ wf = (const float*)(C.ws + WS_IW) + (size_t)(MP + b * DS) * 8;
    float* scs = (float*)(C.ws + WS_SCS) + (size_t)(b * DS) * SPITCH + s;
    for (int tt = 0; tt < DS; ++tt) {
        float sc = 0.f;
        for (int h = 0; h < 8; ++h) {
            float d = 0.f;
#pragma unroll
            for (int dd = 0; dd < 64; ++dd) d = fmaf(qf[tt * 512 + h * 64 + dd], k[dd], d);
            sc += wf[tt * 8 + h] * fmaxf(d, 0.f);
        }
        if (valid) scs[(size_t)tt * SPITCH] = sc;
    }
}
__device__ __forceinline__ void ph2_scores(const Ctx& C, unsigned char* lds) {
    for (int u = C.bid; u < 256; u += C.G) {
        const int b = u >> 7, gp = u & 127;
        score_unit_prompt(C, b, gp, lds); score_unit_prompt(C, b, 255 - gp, lds);
    }
    const int gw = C.bid * NWAVES + C.wave, NGW = C.G * NWAVES;
    for (int it = gw; it < DB * 33; it += NGW) {
        const int itu = __builtin_amdgcn_readfirstlane(it);
        score_unit_sample(C, itu / 33, itu % 33);
    }
}

template <int NI, int SHIFT, int BITS, int PSHIFT>
__device__ __forceinline__ void radix_pass(const unsigned (&v)[NI], int n, unsigned prefix, unsigned* hist, int lane, unsigned& bin_out, int& k) {
    constexpr int NBINS = 1 << BITS, BPL = NBINS / 64;
    asm volatile("" : "+v"(lane));
#pragma unroll
    for (int j = 0; j < BPL; ++j) hist[j * 64 + lane] = 0u;
    LDS_WAIT();
#pragma unroll
    for (int i = 0; i < NI; ++i) if (i * 64 < n) {
        const bool match = (PSHIFT >= 32) ? true : ((v[i] >> (PSHIFT & 31)) == prefix);
        if (match && (lane < n - i * 64)) atomicAdd(&hist[(v[i] >> SHIFT) & (NBINS - 1)], 1u);
    }
    LDS_WAIT();
    unsigned cnt = 0u;
#pragma unroll
    for (int j = 0; j < BPL; ++j) cnt += hist[BPL * lane + j];
    unsigned S = cnt;
#pragma unroll
    for (int off = 1; off < 64; off <<= 1) { const unsigned t = __shfl_down(S, off); if (lane + off < 64) S += t; }
    const u64 bal = __ballot(S >= (unsigned)k);
    const int Ls = bal ? (63 - __clzll(bal)) : 0;
    const unsigned Sn = __shfl(S, (Ls + 1) & 63); const unsigned above = (Ls < 63) ? Sn : 0u;
    unsigned c = above, bin = (unsigned)(BPL * Ls); int knew = k; bool found = false;
#pragma unroll
    for (int j = BPL - 1; j >= 0; --j) { const unsigned h = hist[BPL * Ls + j]; if (!found) { if (c + h >= (unsigned)k) { bin = (unsigned)(BPL * Ls + j); knew = k - (int)c; found = true; } else c += h; } }
    LDS_WAIT();
    bin_out = bin; k = knew;
}
template <int NI> __device__ __forceinline__ void select_row(const float* sc, int n, int* list, unsigned* hist, int lane) {
    if (n <= TOPK) {
#pragma unroll
        for (int i = 0; i < 4; ++i) { const int s = i * 64 + lane; if (s < n) list[s] = s; }
        return;
    }
    unsigned v[NI];
    asm volatile("" : "+v"(lane));
    const float* scl = sc + lane;
#pragma unroll
    for (int i = 0; i < NI; ++i) { v[i] = 0u; if (i * 64 < n) { if (lane < n - i * 64) { const unsigned u = __float_as_uint(scl[i * 64]); v[i] = (u & 0x80000000u) ? ~u : (u | 0x80000000u); } } }
    int k = TOPK; unsigned b1, b2, b3;
    radix_pass<NI, 21, 11, 32>(v, n, 0u, hist, lane, b1, k);
    radix_pass<NI, 10, 11, 21>(v, n, b1, hist, lane, b2, k);
    radix_pass<NI, 0, 10, 10>(v, n, (b1 << 11) | b2, hist, lane, b3, k);
    const unsigned tau = (b1 << 21) | (b2 << 10) | b3;
    asm volatile("" : "+v"(lane));
    int base = 0, eqc = 0; const u64 ltmask = (1ull << lane) - 1ull;
#pragma unroll
    for (int i = 0; i < NI; ++i) if (i * 64 < n) {
        const bool inb = (lane < n - i * 64); const bool gt = inb && (v[i] > tau), eq = inb && (v[i] == tau);
        const u64 eqb = __ballot(eq); const int erank = eqc + __popcll(eqb & ltmask);
        const bool take = gt || (eq && erank < k); eqc += __popcll(eqb);
        const u64 tb = __ballot(take); const int pos = base + __popcll(tb & ltmask);
        if (take && pos < TOPK) list[pos] = i * 64 + lane;
        base += __popcll(tb);
    }
}
__device__ __forceinline__ void ph3_select(const Ctx& C, unsigned char* lds) {
    const int gw = C.bid * NWAVES + C.wave, NGW = C.G * NWAVES;
    unsigned* hist = (unsigned*)lds + C.wave * 2048;
    int* sel = (int*)(C.ws + WS_SEL);
    for (int r = gw; r < MT; r += NGW) {
        const int ru = __builtin_amdgcn_readfirstlane(r);
        if (ru < MP) { const int t = ru & (SEQ - 1); select_row<128>((const float*)(C.ws + WS_SC) + (size_t)ru * SEQ, t + 1, sel + (size_t)ru * TOPK, hist, C.lane); }
        else { const int rl = ru - MP; select_row<40>((const float*)(C.ws + WS_SCS) + (size_t)rl * SPITCH, PAST + (rl & 7) + 1, sel + (size_t)ru * TOPK, hist, C.lane); }
    }
}

template <bool SAMP> __device__ __forceinline__ void attn_gather_row(const Ctx& C, int r, int lane) {
    const int rl = SAMP ? r - MP : r; const int b = SAMP ? (rl >> 3) : (rl >> 13);
    const int n = SAMP ? PAST + (rl & 7) + 1 : (rl & (SEQ - 1)) + 1; const int cnt = n < TOPK ? n : TOPK;
    const int* __restrict__ list = (const int*)(C.ws + WS_SEL) + (size_t)r * TOPK;
    float q[8]; load8_bf16((const bf16_t*)(C.ws + WS_Q) + (size_t)r * 512 + lane * 8, q);
    float mrun = -INFINITY, l = 0.f, o[8];
#pragma unroll
    for (int e = 0; e < 8; ++e) o[e] = 0.f;
    for (int j0 = 0; j0 < cnt; j0 += 4) {
        float kk[4][8], vv[4][8];
#pragma unroll
        for (int u = 0; u < 4; ++u) {
            const int j = (j0 + u < cnt) ? j0 + u : j0; const int s = list[j];
            if (SAMP) {
                const float *kp, *vp;
                if (s < PAST) { const size_t ro = ((size_t)C.page_table[b * NPAGES + (s >> 7)] * PAGE + (s & (PAGE - 1))) * 512 + lane * 8; kp = C.cache_k + ro; vp = C.cache_v + ro; }
                else { const size_t ro = (size_t)(b * DS + (s - PAST)) * 512 + lane * 8; kp = C.out + OFF_K_S + ro; vp = C.out + OFF_V_S + ro; }
                load8_f32(kp, kk[u]); load8_f32(vp, vv[u]);
            } else {
                const size_t ro = (size_t)(b * SEQ + s) * 512 + lane * 8;
                load8_bf16((const bf16_t*)(C.ws + WS_K) + ro, kk[u]); load8_bf16((const bf16_t*)(C.ws + WS_V) + ro, vv[u]);
            }
        }
#pragma unroll
        for (int u = 0; u < 4; ++u) if (j0 + u < cnt) {
            float d = 0.f;
#pragma unroll
            for (int e = 0; e < 8; ++e) d = fmaf(q[e], kk[u][e], d);
            d += __shfl_xor(d, 1); d += __shfl_xor(d, 2); d += __shfl_xor(d, 4);
            const float mn = fmaxf(mrun, d); const float corr = __expf(mrun - mn), p = __expf(d - mn);
            l = l * corr + p;
#pragma unroll
            for (int e = 0; e < 8; ++e) o[e] = o[e] * corr + p * vv[u][e];
            mrun = mn;
        }
    }
    const float il = 1.0f / l;
#pragma unroll
    for (int e = 0; e < 8; ++e) o[e] *= il;
    store8_bf16((bf16_t*)(C.ws + WS_AMIX) + (size_t)r * 1024 + 512 + lane * 8, o);
}
__device__ __forceinline__ void ph4_attn_conv(const Ctx& C) {
    const int gw = C.bid * NWAVES + C.wave, NGW = C.G * NWAVES;
    for (int r = gw; r < MT; r += NGW) {
        const int ru = __builtin_amdgcn_readfirstlane(r);
        if (ru < MP) attn_gather_row<false>(C, ru, C.lane); else attn_gather_row<true>(C, ru, C.lane);
    }
    const int gt = C.bid * NTHREADS + C.tid, NGT = C.G * NTHREADS;
    const bf16_t* ub = (const bf16_t*)(C.ws + WS_U); const bf16_t* cbb = (const bf16_t*)(C.ws + WS_CB); bf16_t* amix = (bf16_t*)(C.ws + WS_AMIX);
    for (int it = gt; it < MT * 64; it += NGT) {
        const int r = it >> 6, c = (it & 63) * 8;
        float u0[8], p1[8], p2[8], cb[8], w0[8], w1[8], w2[8], y[8];
        load8_bf16(ub + (size_t)r * 512 + c, u0); load8_bf16(cbb + (size_t)r * 512 + c, cb);
        load8_f32(C.conv_mix_w + c, w0); load8_f32(C.conv_mix_w + 512 + c, w1); load8_f32(C.conv_mix_w + 1024 + c, w2);
        if (r < MP) {
            const int t = r & (SEQ - 1);
            if (t >= 1) load8_bf16(ub + (size_t)(r - 1) * 512 + c, p1); else { for (int e = 0; e < 8; ++e) p1[e] = 0.f; }
            if (t >= 2) load8_bf16(ub + (size_t)(r - 2) * 512 + c, p2); else { for (int e = 0; e < 8; ++e) p2[e] = 0.f; }
        } else {
            const int rl = r - MP, b = rl >> 3, tt = rl & 7;
            if (tt >= 1) load8_bf16(ub + (size_t)(r - 1) * 512 + c, p1); else load8_f32(C.st_mix + (size_t)(b * 2 + 1) * 512 + c, p1);
            if (tt >= 2) load8_bf16(ub + (size_t)(r - 2) * 512 + c, p2); else load8_f32(C.st_mix + (size_t)(b * 2 + tt) * 512 + c, p2);
        }
#pragma unroll
        for (int e = 0; e < 8; ++e) y[e] = cb[e] * (w0[e] * p2[e] + w1[e] * p1[e] + w2[e] * u0[e]);
        store8_bf16(amix + (size_t)r * 1024 + c, y);
    }
}

__device__ __forceinline__ void memattn_unit(const Ctx& C, int r0, const float* kp0, const float* vp0, unsigned char* lds) {
    const int lane = C.lane, w = C.wave, h = lane >> 4;
    float* logits = (float*)lds; float* oacc = (float*)(lds + 32768);
    const bf16_t* qmem = (const bf16_t*)(C.ws + WS_QMEM); const float* ssq = (const float*)(C.ws + ACC_SSQ);
    {
        float q[8][16], rsq[8];
#pragma unroll
        for (int qi = 0; qi < 8; ++qi) { load8_bf16(qmem + (size_t)(r0 + qi) * 1024 + lane * 16, q[qi]); load8_bf16(qmem + (size_t)(r0 + qi) * 1024 + lane * 16 + 8, q[qi] + 8);
            rsq[qi] = (1.0f / sqrtf(ssq[(r0 + qi) * 4 + h] * (1.f / 256.f) + EPS)) * 0.0625f; }
        for (int mi = 0; mi < 32; ++mi) {
            const int m = 32 * w + mi; float kr[16]; load8_f32(kp0 + (size_t)m * 1024 + lane * 16, kr); load8_f32(kp0 + (size_t)m * 1024 + lane * 16 + 8, kr + 8);
#pragma unroll
            for (int qi = 0; qi < 8; ++qi) {
                float p = 0.f;
#pragma unroll
                for (int e = 0; e < 16; ++e) p = fmaf(q[qi][e], kr[e], p);
                p += __shfl_xor(p, 1); p += __shfl_xor(p, 2); p += __shfl_xor(p, 4); p += __shfl_xor(p, 8);
                if ((lane & 15) == 0) logits[(qi * 4 + h) * 256 + m] = p * rsq[qi];
            }
        }
    }
#pragma unroll
    for (int e = 0; e < 16; ++e) oacc[C.tid * 16 + e] = 0.f;
    __syncthreads();
#pragma unroll
    for (int rr = 0; rr < 4; ++rr) {
        float* row = logits + (4 * w + rr) * 256; float x[4]; float mx = -INFINITY;
#pragma unroll
        for (int j = 0; j < 4; ++j) { x[j] = row[lane + 64 * j]; mx = fmaxf(mx, x[j]); }
        mx = wave_max(mx); float s = 0.f;
#pragma unroll
        for (int j = 0; j < 4; ++j) { x[j] = __expf(x[j] - mx); s += x[j]; }
        s = wave_sum(s); const float is = 1.0f / s;
#pragma unroll
        for (int j = 0; j < 4; ++j) row[lane + 64 * j] = x[j] * is;
    }
    __syncthreads();
    {
        float acc[8][16];
#pragma unroll
        for (int qi = 0; qi < 8; ++qi)
#pragma unroll
            for (int e = 0; e < 16; ++e) acc[qi][e] = 0.f;
        for (int mi = 0; mi < 32; ++mi) {
            const int m = 32 * w + mi; float vr[16]; load8_f32(vp0 + (size_t)m * 1024 + lane * 16, vr); load8_f32(vp0 + (size_t)m * 1024 + lane * 16 + 8, vr + 8);
#pragma unroll
            for (int qi = 0; qi < 8; ++qi) { const float p = logits[(qi * 4 + h) * 256 + m];
#pragma unroll
                for (int e = 0; e < 16; ++e) acc[qi][e] = fmaf(p, vr[e], acc[qi][e]); }
        }
#pragma unroll
        for (int qi = 0; qi < 8; ++qi)
#pragma unroll
            for (int e = 0; e < 16; ++e) atomicAdd(&oacc[qi * 1024 + lane * 16 + e], acc[qi][e]);
    }
    __syncthreads();
    {
        const int row = C.tid >> 6, col = (C.tid & 63) * 16; float o[16];
#pragma unroll
        for (int e = 0; e < 16; ++e) o[e] = oacc[row * 1024 + col + e];
        bf16_t* op = (bf16_t*)(C.ws + WS_OMEM) + (size_t)(r0 + row) * 1024 + col; store8_bf16(op, o); store8_bf16(op + 8, o + 8);
    }
    __syncthreads();
}
__device__ __forceinline__ void ph7_memattn(const Ctx& C, unsigned char* lds) {
    for (int u = C.bid; u < MT / 8; u += C.G) {
        const int r0 = u * 8;
        const float *kp, *vp;
        if (r0 < MP) { const int b = r0 >> 13; kp = C.out + OFF_MK_P + (size_t)b * 262144; vp = C.out + OFF_MV_P + (size_t)b * 262144; }
        else { const int b = (r0 - MP) >> 3; kp = C.cmem_k + (size_t)b * 262144; vp = C.cmem_v + (size_t)b * 262144; }
        memattn_unit(C, r0, kp, vp, lds);
    }
}

__device__ __forceinline__ void ph10_ffn_act(const Ctx& C) {
    const int gt = C.bid * NTHREADS + C.tid, NGT = C.G * NTHREADS;
    const float* G = (const float*)(C.ws + WS_G); const bf16_t* UP = (const bf16_t*)(C.ws + WS_UP); bf16_t* aff = (bf16_t*)(C.ws + WS_AFF);
    constexpr int CG = DFF / 8;
    for (int it = gt; it < MT * CG; it += NGT) {
        const int r = it / CG, c = (it - r * CG) * 8;
        float g0[8], p1[8], p2[8], up[8], w0[8], w1[8], w2[8], bb[8], y[8];
        load8_f32(G + (size_t)r * DFF + c, g0); load8_bf16(UP + (size_t)r * DFF + c, up);
        load8_f32(C.conv_ffn_w + c, w0); load8_f32(C.conv_ffn_w + DFF + c, w1); load8_f32(C.conv_ffn_w + 2 * DFF + c, w2); load8_f32(C.conv_ffn_b + c, bb);
        if (r < MP) {
            const int t = r & (SEQ - 1), b = r >> 13;
            if (t >= 1) load8_f32(G + (size_t)(r - 1) * DFF + c, p1); else { for (int e = 0; e < 8; ++e) p1[e] = 0.f; }
            if (t >= 2) load8_f32(G + (size_t)(r - 2) * DFF + c, p2); else { for (int e = 0; e < 8; ++e) p2[e] = 0.f; }
            if (t >= SEQ - 2) store8_f32(C.out + OFF_CF_P + (size_t)(b * 2 + (t - (SEQ - 2))) * DFF + c, g0);
        } else {
            const int rl = r - MP, b = rl >> 3, tt = rl & 7;
            if (tt >= 1) load8_f32(G + (size_t)(r - 1) * DFF + c, p1); else load8_f32(C.st_ffn + (size_t)(b * 2 + 1) * DFF + c, p1);
            if (tt >= 2) load8_f32(G + (size_t)(r - 2) * DFF + c, p2); else load8_f32(C.st_ffn + (size_t)(b * 2 + tt) * DFF + c, p2);
            if (tt >= 6) store8_f32(C.out + OFF_CF_S + (size_t)(b * 2 + (tt - 6)) * DFF + c, g0);
        }
#pragma unroll
        for (int e = 0; e < 8; ++e) { const float z = w0[e] * p2[e] + w1[e] * p1[e] + w2[e] * g0[e] + bb[e]; y[e] = (z / (1.0f + __expf(-z))) * up[e]; }
        store8_bf16(aff + (size_t)r * DFF + c, y);
    }
}

__global__ void __launch_bounds__(NTHREADS, 2) fwd(Args args) {
    extern __shared__ __attribute__((aligned(16))) unsigned char lds[];
    Ctx C;
    C.x_p = (const float*)args.in[0]; C.x_s = (const float*)args.in[1]; C.cache_k = (const float*)args.in[2]; C.cache_v = (const float*)args.in[3]; C.cache_ik = (const float*)args.in[4];
    C.st_mix = (const float*)args.in[5]; C.st_ffn = (const float*)args.in[6]; C.cmem_k = (const float*)args.in[7]; C.cmem_v = (const float*)args.in[8]; C.page_table = (const int*)args.in[9];
    C.mem_p = (const float*)args.in[10]; C.g_mix = (const float*)args.in[11]; C.w_in = (const float*)args.in[12]; C.conv_mix_w = (const float*)args.in[13]; C.q_g = (const float*)args.in[14];
    C.k_g = (const float*)args.in[15]; C.w_out = (const float*)args.in[16]; C.g_mem = (const float*)args.in[17]; C.g_mem_src = (const float*)args.in[18]; C.w_q = (const float*)args.in[19];
    C.w_kv = (const float*)args.in[20]; C.mq_g = (const float*)args.in[21]; C.mk_g = (const float*)args.in[22]; C.w_o = (const float*)args.in[23]; C.g_ffn = (const float*)args.in[24];
    C.w_gu = (const float*)args.in[25]; C.conv_ffn_w = (const float*)args.in[26]; C.conv_ffn_b = (const float*)args.in[27]; C.w_down = (const float*)args.in[28];
    C.out = args.out; C.ws = args.ws;
    C.tid = threadIdx.x; C.lane = C.tid & 63; C.wave = __builtin_amdgcn_readfirstlane(C.tid >> 6); C.G = gridDim.x; C.bid = blockIdx.x;
    unsigned char* ws = args.ws;
    LAS unsigned char* ldsl = (LAS unsigned char*)lds;
    volatile LAS unsigned* MISC = (volatile LAS unsigned*)(ldsl + MISC_OFF);
    for (int u = C.tid; u < (LDS_BYTES - RING_BYTES) / 4; u += NTHREADS) ((LAS unsigned*)(ldsl + RING_BYTES))[u] = 0u;
    __syncthreads();
    XcdBarrier bar; bar.bar = (unsigned*)(ws + WS_CTL) + CW_BAR; bar.x = 0; bar.st = nullptr;
    if (N_LAUNCHES == 1) bar = xcd_barrier_post((unsigned*)(ws + WS_CTL) + CW_BAR, MISC + 8);
    const int lo = args.ph_lo, hi = args.ph_hi;
#ifndef PHMASK
#define PHMASK 0xFFFF
#endif
#define IN(k) (((PHMASK >> (k)) & 1) && lo <= (k) && (k) < hi)
#define SEAM(k) do { if (IN(k) && IN((k) + 1)) xcd_barrier(bar); } while (0)
    float* ss1 = (float*)(ws + ACC_SS1); float* ss2 = (float*)(ws + ACC_SS2); float* ssq = (float*)(ws + ACC_SSQ); float* ssk = (float*)(ws + ACC_SSK);
    float* rstd = (float*)(ws + WS_RSTD);

    if (IN(0)) { ph0_prologue(C, lds); } SEAM(0);
    if (IN(1)) {
        { pg8::Gemm g{(const bf16_t*)(ws + WS_XB), (const bf16_t*)(ws + WS_WIN), MT, DINP, DM}; pg8::StaticOrder S; S.init(MT, DINP, C.G, C.bid);
          EpiIn E{rstd, (const float*)(ws + WS_COS), (const float*)(ws + WS_SIN), C.q_g, C.k_g, (bf16_t*)(ws + WS_CB), (bf16_t*)(ws + WS_U), (bf16_t*)(ws + WS_Q), (bf16_t*)(ws + WS_K), (bf16_t*)(ws + WS_V),
                  (bf16_t*)(ws + WS_QI), (bf16_t*)(ws + WS_KI), (float*)(ws + WS_IW), (float*)(ws + WS_QIF), C.out};
          pg8::gemm_phase<EpiIn, pg8::StaticOrder, true, true>(ldsl, g, S, E); }
        { pg8::Gemm g{(const bf16_t*)(ws + WS_MEMB), (const bf16_t*)(ws + WS_WKV), 512, 2 * DM, DM}; pg8::StaticOrder S; S.init(512, 2 * DM, C.G, C.bid);
          EpiKv E{rstd + MT, ssk, C.out};
          pg8::gemm_phase<EpiKv, pg8::StaticOrder, true, true>(ldsl, g, S, E); }
    } SEAM(1);
    if (IN(2)) { ph2_memprep(C); ph2_scores(C, lds); } SEAM(2);
    if (IN(3)) { ph3_select(C, lds); } SEAM(3);
    if (IN(4)) { ph4_attn_conv(C); } SEAM(4);
    if (IN(5)) {
        pg8::Gemm g{(const bf16_t*)(ws + WS_AMIX), (const bf16_t*)(ws + WS_WOUT), MT, DM, DM}; pg8::StaticOrder S; S.init(MT, DM, C.G, C.bid);
        EpiRes E{C.x_p, C.x_s, (float*)(ws + WS_H1), (float*)(ws + WS_H1) + (size_t)MP * DM, (bf16_t*)(ws + WS_H1B), ss1};
        pg8::gemm_phase<EpiRes, pg8::StaticOrder, true, true>(ldsl, g, S, E);
    } SEAM(5);
    if (IN(6)) {
        pg8::Gemm g{(const bf16_t*)(ws + WS_H1B), (const bf16_t*)(ws + WS_WQ), MT, DM, DM}; pg8::StaticOrder S; S.init(MT, DM, C.G, C.bid);
        EpiQm E{ss1, C.mq_g, (bf16_t*)(ws + WS_QMEM), ssq};
        pg8::gemm_phase<EpiQm, pg8::StaticOrder, true, true>(ldsl, g, S, E);
    } SEAM(6);
    if (IN(7)) { ph7_memattn(C, lds); } SEAM(7);
    if (IN(8)) {
        pg8::Gemm g{(const bf16_t*)(ws + WS_OMEM), (const bf16_t*)(ws + WS_WO), MT, DM, DM}; pg8::StaticOrder S; S.init(MT, DM, C.G, C.bid);
        EpiRes E{(const float*)(ws + WS_H1), (const float*)(ws + WS_H1) + (size_t)MP * DM, (float*)(ws + WS_H2), (float*)(ws + WS_H2) + (size_t)MP * DM, (bf16_t*)(ws + WS_H2B), ss2};
        pg8::gemm_phase<EpiRes, pg8::StaticOrder, true, true>(ldsl, g, S, E);
    } SEAM(8);
    if (IN(9)) {
        pg8::Gemm g{(const bf16_t*)(ws + WS_H2B), (const bf16_t*)(ws + WS_WGU), MT, 2 * DFF, DM}; pg8::StaticOrder S; S.init(MT, 2 * DFF, C.G, C.bid);
        EpiGu E{ss2, (float*)(ws + WS_G), (bf16_t*)(ws + WS_UP)};
        pg8::gemm_phase<EpiGu, pg8::StaticOrder, true, true>(ldsl, g, S, E);
    } SEAM(9);
    if (IN(10)) { ph10_ffn_act(C); } SEAM(10);
    if (IN(11)) {
        pg8::Gemm g{(const bf16_t*)(ws + WS_AFF), (const bf16_t*)(ws + WS_WDOWN), MT, DM, DFF}; pg8::StaticOrder S; S.init(MT, DM, C.G, C.bid);
        EpiRes E{(const float*)(ws + WS_H2), (const float*)(ws + WS_H2) + (size_t)MP * DM, C.out + OFF_Y_P, C.out + OFF_Y_S, nullptr, nullptr};
        pg8::gemm_phase<EpiRes, pg8::StaticOrder, true, true>(ldsl, g, S, E);
    }
#undef IN
#undef SEAM
}

extern "C" void kernel_launch(void* const* d_in, const int* in_sizes, int n_in, void* d_out, int out_size, void* d_ws, size_t ws_size, hipStream_t stream) {
    static int grid = 0;
    if (grid == 0) {
        if (n_in != 29 || (size_t)out_size != OUT_TOTAL || ws_size < WS_END) { fprintf(stderr, "kernel_launch: unexpected problem (n_in %d, out %d, ws %zu); nothing launched\n", n_in, out_size, ws_size); grid = -1; return; }
        int dev = 0, cus = 0;
        if (hipGetDevice(&dev) != hipSuccess || hipDeviceGetAttribute(&cus, hipDeviceAttributeMultiprocessorCount, dev) != hipSuccess) { grid = -1; return; }
        if (hipFuncSetAttribute((const void*)fwd, hipFuncAttributeMaxDynamicSharedMemorySize, LDS_BYTES) != hipSuccess) { fprintf(stderr, "kernel_launch: hipFuncSetAttribute failed\n"); grid = -1; return; }
        (void)hipGetLastError();
        grid = cus;
    }
    if (grid < 0) return;
    (void)hipMemsetAsync((char*)d_ws + WS_CTL, 0, CTL_ZERO_BYTES, stream);
    Args a{};
    for (int i = 0; i < 29; ++i) a.in[i] = d_in[i];
    a.out = (float*)d_out; a.ws = (unsigned char*)d_ws;
    if (N_LAUNCHES == 1) { a.ph_lo = 0; a.ph_hi = NPHASE; hipLaunchKernelGGL(fwd, dim3(grid), dim3(NTHREADS), LDS_BYTES, stream, a); }
    else for (int p = 0; p < NPHASE; ++p) { a.ph_lo = p; a.ph_hi = p + 1; hipLaunchKernelGGL(fwd, dim3(grid), dim3(NTHREADS), LDS_BYTES, stream, a); }
}
```

```cpp
#include <hip/hip_runtime.h>
#include <cstdio>
#include <cstdint>

#ifndef MK_N_LAUNCHES
#define MK_N_LAUNCHES 1
#endif

__device__ __forceinline__ int fresh_lane() { int l; asm volatile("v_mbcnt_lo_u32_b32 %0, -1, 0\n\tv_mbcnt_hi_u32_b32 %0, -1, %0" : "=v"(l)); return l; }

#include <hip/hip_bf16.h>
#include <cmath>
namespace attn_body {
using bf16=__hip_bfloat16;
using bf16x8=__attribute__((ext_vector_type(8)))short;
using s16x4=__attribute__((ext_vector_type(4)))short;
using f32x16=__attribute__((ext_vector_type(16)))float;
using u32x4=__attribute__((ext_vector_type(4)))unsigned;
constexpr int BATCH=2,NHEAD=8,SEQ=8192,D=64,DM=NHEAD*D,OPITCH=1024;
constexpr int NW=8,QBLK=32,QB=QBLK*NW,KVBLK=64,NQB=SEQ/QB;
constexpr int ATTN_PITCH=DM, ATTN_UNIT_ROWS=QB;
__device__ __forceinline__ int crow(int r,int hi){return (r&3)+8*(r>>2)+4*hi;}
#define SBAR() __builtin_amdgcn_sched_barrier(0)
__device__ __forceinline__ void cmask(f32x16&p0,f32x16&p1,int jb,int qrel,int hi){
  const float NEG=-INFINITY; int kb=64*jb+4*hi;
  #pragma unroll
  for(int r=0;r<16;++r){int kv=kb+(r&3)+8*(r>>2); if(kv>qrel)p0[r]=NEG; if(kv+32>qrel)p1[r]=NEG;}
}

constexpr int NSLOT=3, SLOTB=8192;
constexpr int LDS_K=0, LDS_V=NSLOT*SLOTB, LDS_WS=2*NSLOT*SLOTB, LDS_OST=LDS_WS+NW*64*4, LDS_BYTES=LDS_OST+NW*4096;
constexpr float C2=0.125f*1.4426950408889634f;
__device__ __forceinline__ void glds16(const void*gsrc,unsigned lds_dst){unsigned keep;
  asm volatile("s_mov_b32 %0, m0\n\ts_mov_b32 m0, %2\n\ts_nop 0\n\tglobal_load_lds_dwordx4 %1, off\n\ts_mov_b32 m0, %0":"=&s"(keep):"v"(gsrc),"s"(lds_dst):"memory");}
__device__ __forceinline__ float max3f(float a,float b,float c){float r;asm("v_max3_f32 %0, %1, %2, %3":"=v"(r):"v"(a),"v"(b),"v"(c));return r;}
__device__ __forceinline__ float max2f(float a,float b){float r;asm("v_max_f32_e32 %0, %1, %2":"=v"(r):"v"(a),"v"(b));return r;}
__device__ __forceinline__ float fadd_s(float a,float b){float r;asm("v_add_f32_e32 %0, %1, %2":"=v"(r):"v"(a),"v"(b));return r;}
__device__ __forceinline__ float fsub_s(float a,float b){float r;asm("v_sub_f32_e32 %0, %1, %2":"=v"(r):"v"(a),"v"(b));return r;}
typedef float f32x2_t __attribute__((ext_vector_type(2))); typedef __bf16 bf16x2_t __attribute__((ext_vector_type(2)));
__device__ __forceinline__ unsigned cvtpk_s(float lo,float hi){f32x2_t v={lo,hi};bf16x2_t b=__builtin_convertvector(v,bf16x2_t);return __builtin_bit_cast(unsigned,b);}
#define WAIT_BAR(N) asm volatile("s_waitcnt vmcnt(" #N ") lgkmcnt(0)\n\ts_barrier":::"memory")

__device__ __forceinline__ void qkt(f32x16&p0,f32x16&p1,const char*Kslot,const bf16x8*qr,const f32x16&negm,int r32,int hi){
  const char*kb=Kslot+hi*1024+r32*16;
  #pragma unroll
  for(int d0=0;d0<4;++d0){
    const bf16x8 b0=*reinterpret_cast<const bf16x8*>(kb+d0*2048);
    const bf16x8 b1=*reinterpret_cast<const bf16x8*>(kb+d0*2048+512);
    if(d0==0){p0=__builtin_amdgcn_mfma_f32_32x32x16_bf16(b0,qr[0],negm,0,0,0);p1=__builtin_amdgcn_mfma_f32_32x32x16_bf16(b1,qr[0],negm,0,0,0);}
    else{p0=__builtin_amdgcn_mfma_f32_32x32x16_bf16(b0,qr[d0],p0,0,0,0);p1=__builtin_amdgcn_mfma_f32_32x32x16_bf16(b1,qr[d0],p1,0,0,0);}}
}
typedef __attribute__((address_space(3))) const char* lds_cptr;
typedef short v4i16_t __attribute__((ext_vector_type(4)));
__device__ __forceinline__ void kload8(bf16x8*kf,lds_cptr kp){
  kf[0]=*(const __attribute__((address_space(3))) bf16x8*)(kp);      kf[1]=*(const __attribute__((address_space(3))) bf16x8*)(kp+512);
  kf[2]=*(const __attribute__((address_space(3))) bf16x8*)(kp+2048); kf[3]=*(const __attribute__((address_space(3))) bf16x8*)(kp+2560);
  kf[4]=*(const __attribute__((address_space(3))) bf16x8*)(kp+4096); kf[5]=*(const __attribute__((address_space(3))) bf16x8*)(kp+4608);
  kf[6]=*(const __attribute__((address_space(3))) bf16x8*)(kp+6144); kf[7]=*(const __attribute__((address_space(3))) bf16x8*)(kp+6656);
}
__device__ __forceinline__ void kload2(bf16x8*kf,lds_cptr kp,int j){ kf[2*j]=*(const __attribute__((address_space(3))) bf16x8*)(kp+j*2048); kf[2*j+1]=*(const __attribute__((address_space(3))) bf16x8*)(kp+j*2048+512); }
__device__ __forceinline__ s16x4 vtr(lds_cptr p){ return __builtin_bit_cast(s16x4,__builtin_amdgcn_ds_read_tr16_b64_v4i16((__attribute__((address_space(3))) v4i16_t*)p)); }
__device__ __forceinline__ float rowmax(const f32x16&p0,const f32x16&p1){
  float a=max3f(p0[0],p0[1],p1[0]),b=max3f(p0[2],p0[3],p1[1]);a=max3f(a,p1[2],p1[3]);
  #pragma unroll
  for(int r=4;r<16;r+=4){a=max3f(a,p0[r],p0[r+1]);b=max3f(b,p0[r+2],p0[r+3]);a=max3f(a,p1[r],p1[r+1]);b=max3f(b,p1[r+2],p1[r+3]);}
  const float m=max2f(a,b);
  auto rr=__builtin_amdgcn_permlane32_swap(__float_as_uint(m),__float_as_uint(m),false,false);
  return max2f(__uint_as_float(rr[0]),__uint_as_float(rr[1]));
}
__device__ __forceinline__ void pv(f32x16*o,int vb,bf16x8 pa0,bf16x8 pa1,bf16x8 pa2,bf16x8 pa3){
  #pragma unroll
  for(int d0=0;d0<2;++d0){s16x4 lo[4],hi[4];
    #pragma unroll
    for(int ks=0;ks<4;++ks){
      asm volatile("ds_read_b64_tr_b16 %0,%1 offset:%c2":"=&v"(lo[ks]):"v"(vb),"i"(d0*4096+ks*1024):"memory");
      asm volatile("ds_read_b64_tr_b16 %0,%1 offset:%c2":"=&v"(hi[ks]):"v"(vb),"i"(d0*4096+ks*1024+512):"memory");}
    asm volatile("s_waitcnt lgkmcnt(0)":::"memory");SBAR();
    #define PK(k) (bf16x8){lo[k][0],lo[k][1],lo[k][2],lo[k][3],hi[k][0],hi[k][1],hi[k][2],hi[k][3]}
    o[d0]=__builtin_amdgcn_mfma_f32_32x32x16_bf16(pa0,PK(0),o[d0],0,0,0);
    o[d0]=__builtin_amdgcn_mfma_f32_32x32x16_bf16(pa1,PK(1),o[d0],0,0,0);
    o[d0]=__builtin_amdgcn_mfma_f32_32x32x16_bf16(pa2,PK(2),o[d0],0,0,0);
    o[d0]=__builtin_amdgcn_mfma_f32_32x32x16_bf16(pa3,PK(3),o[d0],0,0,0);
    #undef PK
  }
}

#ifndef ATTN_STORE16
#define ATTN_STORE16(p,v) (*(u32x4*)(p)=(v))
#endif
typedef unsigned long long v16i __attribute__((ext_vector_type(8)));
#define MLOAD_P0(t_) do{ const unsigned long long* mp_=mbase+(size_t)(t_)*32; \
  asm volatile("s_load_dwordx16 %0, %1, 0x0":"=s"(mwA):"s"(mp_)); asm volatile("s_load_dwordx16 %0, %1, 0x40":"=s"(mwB):"s"(mp_)); }while(0)
#define MLOAD_P1(t_) do{ const unsigned long long* mp_=mbase+(size_t)(t_)*32; \
  asm volatile("s_load_dwordx16 %0, %1, 0x80":"=s"(mwA):"s"(mp_)); asm volatile("s_load_dwordx16 %0, %1, 0xc0":"=s"(mwB):"s"(mp_)); }while(0)
#define MAP1(X,r,W) do{ float t_=X[r]; asm volatile("v_cndmask_b32_e64 %0, 0, %0, %1":"+v"(t_):"s"(W)); X[r]=t_; }while(0)
#define MAPPLY1(P) do{ _Pragma("unroll") for(int r_=0;r_<8;++r_){ MAP1(P,r_,mwA[r_]); MAP1(P,8+r_,mwB[r_]); } }while(0)
#define MWAIT() asm volatile("s_waitcnt lgkmcnt(0)":::"memory")
template<int THRL> __device__ __forceinline__ void attn_unit(int b,int h,int qb,const bf16*Q,const bf16*__restrict__ K,const bf16*__restrict__ V,bf16*O,const unsigned long long*M,char*shm,int wid_in){
  const int lane=fresh_lane(),r32=lane&31,hi=lane>>5; const int wid=wid_in;
  const long rowbase=(long)b*SEQ; const int q0=qb*QB;
  const bf16*Qw=Q+(rowbase+q0+wid*QBLK)*DM+h*D;
  const bf16*Kh=K+rowbase*DM+h*D,*Vh=V+rowbase*DM+h*D;
  const unsigned long long*mbase=M+((size_t)(b*256+qb*8+wid))*(128*32); v16i mwA,mwB;
  const unsigned lds0=(unsigned)(uintptr_t)shm;
  float*wsf=(float*)(shm+LDS_WS)+wid*64;
  const bf16*ksrc=Kh+(long)lane*DM+wid*8;
  const bf16*vsrc=Vh+(long)(16*(wid&3)+(lane>>2))*DM+(wid>>2)*32+(lane&3)*8;
  const unsigned kdst=lds0+LDS_K+wid*1024, vdst=lds0+LDS_V+wid*1024;
  #define DMA_K(t,slot) glds16(ksrc+(long)(t)*KVBLK*DM,(unsigned)__builtin_amdgcn_readfirstlane(kdst+(slot)))
  #define DMA_V(t,slot) glds16(vsrc+(long)(t)*KVBLK*DM,(unsigned)__builtin_amdgcn_readfirstlane(vdst+(slot)))
  const int vb0=(int)(lds0+LDS_V)+((lane>>4)&1)*32+(lane&3)*8+(4*hi+((lane&15)>>2))*64;
  const char*Kbase=shm+LDS_K; bf16x8 kf[8];
  const lds_cptr shm3=(lds_cptr)shm; const lds_cptr kp0=shm3+LDS_K+hi*1024+r32*16; const lds_cptr vp0=shm3+LDS_V+((lane>>4)&1)*32+(lane&3)*8+(4*hi+((lane&15)>>2))*64;
  const int NT=(q0+QB)/KVBLK;
  DMA_K(0,0);DMA_V(0,0);DMA_K(1,SLOTB);
  bf16x8 qr[4];
  #pragma unroll
  for(int d0=0;d0<4;++d0)qr[d0]=*reinterpret_cast<const bf16x8*>(&Qw[(long)r32*DM+d0*16+hi*8]);
  float l_reg=0.f;f32x16 o[2];o[0]=f32x16{};o[1]=f32x16{};
  const int qrel=wid*QBLK+r32;
  #define CMASK(P0,P1,t) do{int jb_=(t)-(NT-4); if(jb_>=0)cmask(P0,P1,jb_,qrel,hi);}while(0)
  bool resc=false;
  #define START(P0,P1) do{ resc=false; \
    _Pragma("unroll") for(int r=0;r<16;++r)P0[r]=__builtin_amdgcn_exp2f(P0[r]); }while(0)
  #define RESC() do{}while(0)
  f32x16 pA0,pA1,pB0,pB1;
  int sl_prev=0,sl_cur=0,sl_next=SLOTB;
  #define ROT() do{sl_prev=sl_cur;sl_cur=sl_next;sl_next=(sl_next==(NSLOT-1)*SLOTB)?0:sl_next+SLOTB;}while(0)
  MLOAD_P0(0);
  DMA_K(2,2*SLOTB);
  WAIT_BAR(3);
  qkt(pA0,pA1,Kbase,qr,f32x16{},r32,hi);asm volatile("s_nop 15\n\ts_nop 7":"+v"(pA0),"+v"(pA1));CMASK(pA0,pA1,0);
  START(pA0,pA1);
  _Pragma("unroll") for(int r=0;r<16;++r)pA1[r]=__builtin_amdgcn_exp2f(pA1[r]);
  WAIT_BAR(0);
  DMA_K(3,0);DMA_V(1,SLOTB);
  ROT();
  kload8(kf,kp0+sl_cur);
  WAIT_BAR(2);
  s16x4 vlo[8],vhi[8]; u32x4 pw0,pw1,pw2,pw3;
  #define PKW(P,B) cvtpk_s(P[B],P[B+1])
  #define PAF(k) __builtin_bit_cast(bf16x8,pw##k)
  #define VFR(i) (bf16x8){vlo[i][0],vlo[i][1],vlo[i][2],vlo[i][3],vhi[i][0],vhi[i][1],vhi[i][2],vhi[i][3]}
  #define PIN(x) asm volatile("":"+v"(x))
  #define MX3(a,b,c) __builtin_fmaxf(__builtin_fmaxf((a),(b)),(c))
  #define GAPA(MF,A0,A1,A2,A3,W0,W1,PW) do{ MF; sacc+=A0; sacc+=A1; sacc+=A2; sacc+=A3; PIN(sacc); W0; W1; PIN(PW); SBAR(); }while(0)
  #define EX(v) __builtin_amdgcn_exp2f(v)
  #define GAPB(MF,X,B) do{ MF; X[B]=EX(X[B]); X[B+1]=EX(X[B+1]); X[B+2]=EX(X[B+2]); X[B+3]=EX(X[B+3]); PIN(X); SBAR(); }while(0)
  #define VRD(i) do{ vlo[i]=vtr(vp_+(((i)>>2)*4096+((i)&3)*1024)); vhi[i]=vtr(vp_+(((i)>>2)*4096+((i)&3)*1024+512)); }while(0)
  #define KRD(G,j) do{ if(G){ kload2(kf,kp0+sl_next,j); SBAR(); } }while(0)
  #define STEP(C0,C1,P0,P1,t,GK,GV,GL) do{ SBAR(); MAPPLY1(P0); MLOAD_P1((t)-1); SBAR(); \
    const lds_cptr vp_=vp0+sl_prev; \
    VRD(0); SBAR(); float sacc=(P0[0]+P0[1]); \
    GAPA(C0=__builtin_amdgcn_mfma_f32_32x32x16_bf16(kf[0],qr[0],f32x16{},0,0,0), P0[2],P0[3],P0[4],P0[5],     pw0[0]=PKW(P0,0), pw0[1]=PKW(P0,2), pw0); \
    VRD(4); SBAR(); GAPA(C1=__builtin_amdgcn_mfma_f32_32x32x16_bf16(kf[1],qr[0],f32x16{},0,0,0), P0[6],P0[7],P0[8],P0[9],     pw0[2]=PKW(P0,4), pw0[3]=PKW(P0,6), pw0); \
    VRD(1); SBAR(); GAPA(C0=__builtin_amdgcn_mfma_f32_32x32x16_bf16(kf[2],qr[1],C0,0,0,0),   P0[10],P0[11],P0[12],P0[13], pw1[0]=PKW(P0,8), pw1[1]=PKW(P0,10), pw1); \
    MWAIT(); MAPPLY1(P1); MLOAD_P0(t); SBAR(); \
    VRD(5); SBAR(); GAPA(C1=__builtin_amdgcn_mfma_f32_32x32x16_bf16(kf[3],qr[1],C1,0,0,0),   P0[14],P0[15],P1[0],P1[1],   pw1[2]=PKW(P0,12),pw1[3]=PKW(P0,14), pw1); \
    VRD(2); SBAR(); GAPA(C0=__builtin_amdgcn_mfma_f32_32x32x16_bf16(kf[4],qr[2],C0,0,0,0),   P1[2],P1[3],P1[4],P1[5],     pw2[0]=PKW(P1,0), pw2[1]=PKW(P1,2), pw2); \
    VRD(6); SBAR(); GAPA(C1=__builtin_amdgcn_mfma_f32_32x32x16_bf16(kf[5],qr[2],C1,0,0,0),   P1[6],P1[7],P1[8],P1[9],     pw2[2]=PKW(P1,4), pw2[3]=PKW(P1,6), pw2); \
    VRD(3); SBAR(); GAPA(C0=__builtin_amdgcn_mfma_f32_32x32x16_bf16(kf[6],qr[3],C0,0,0,0),   P1[10],P1[11],P1[12],P1[13], pw3[0]=PKW(P1,8), pw3[1]=PKW(P1,10), pw3); \
    VRD(7); SBAR(); GAPA(C1=__builtin_amdgcn_mfma_f32_32x32x16_bf16(kf[7],qr[3],C1,0,0,0),   P1[14],P1[15],0.f,0.f,       pw3[2]=PKW(P1,12),pw3[3]=PKW(P1,14), pw3); \
    l_reg+=sacc; \
    if(GK){DMA_K((t)+3,sl_cur);} if(GV){DMA_V((t)+1,sl_next);} \
    CMASK(C0,C1,t); \
    SBAR(); \
    GAPB(o[0]=__builtin_amdgcn_mfma_f32_32x32x16_bf16(PAF(0),VFR(0),o[0],0,0,0), C0,0); \
    GAPB(o[1]=__builtin_amdgcn_mfma_f32_32x32x16_bf16(PAF(0),VFR(4),o[1],0,0,0), C0,4); \
    KRD(GL,0); GAPB(o[0]=__builtin_amdgcn_mfma_f32_32x32x16_bf16(PAF(1),VFR(1),o[0],0,0,0), C0,8); \
    KRD(GL,1); GAPB(o[1]=__builtin_amdgcn_mfma_f32_32x32x16_bf16(PAF(1),VFR(5),o[1],0,0,0), C0,12); \
    KRD(GL,2); GAPB(o[0]=__builtin_amdgcn_mfma_f32_32x32x16_bf16(PAF(2),VFR(2),o[0],0,0,0), C1,0); \
    KRD(GL,3); GAPB(o[1]=__builtin_amdgcn_mfma_f32_32x32x16_bf16(PAF(2),VFR(6),o[1],0,0,0), C1,4); \
    GAPB(o[0]=__builtin_amdgcn_mfma_f32_32x32x16_bf16(PAF(3),VFR(3),o[0],0,0,0), C1,8); \
    GAPB(o[1]=__builtin_amdgcn_mfma_f32_32x32x16_bf16(PAF(3),VFR(7),o[1],0,0,0), C1,12); \
    }while(0)
  int t=1;
  #undef CMASK
  #define CMASK(P0,P1,t) do{}while(0)
  for(;t+5<NT;t+=2){
    STEP(pB0,pB1,pA0,pA1,t,true,true,true);     WAIT_BAR(2); RESC(); ROT();
    STEP(pA0,pA1,pB0,pB1,t+1,true,true,true);   WAIT_BAR(2); RESC(); ROT();
  }
  #undef CMASK
  #define CMASK(P0,P1,t) do{int jb_=(t)-(NT-4); if(jb_>=0)cmask(P0,P1,jb_,qrel,hi);}while(0)
  #define ENDW(tt) do{ if((tt)+3<NT){WAIT_BAR(2);} else if((tt)+2<NT){WAIT_BAR(1);} else {WAIT_BAR(0);} }while(0)
  for(;t+1<NT;t+=2){
    STEP(pB0,pB1,pA0,pA1,t,(t+3<NT),(t+1<NT),(t+1<NT));       ENDW(t);   RESC(); ROT();
    STEP(pA0,pA1,pB0,pB1,t+1,(t+4<NT),(t+2<NT),(t+2<NT));     ENDW(t+1); RESC(); ROT();
  }
  STEP(pB0,pB1,pA0,pA1,NT-1,false,false,false); RESC();
  MWAIT(); MAPPLY1(pB0); MLOAD_P1(NT-1); MWAIT(); MAPPLY1(pB1);
  { float sacc=pB0[0]+pB0[1]; _Pragma("unroll") for(int r=2;r<16;++r)sacc+=pB0[r]; _Pragma("unroll") for(int r=0;r<16;++r)sacc+=pB1[r]; l_reg+=sacc;
    pw0=(u32x4){PKW(pB0,0),PKW(pB0,2),PKW(pB0,4),PKW(pB0,6)};pw1=(u32x4){PKW(pB0,8),PKW(pB0,10),PKW(pB0,12),PKW(pB0,14)};pw2=(u32x4){PKW(pB1,0),PKW(pB1,2),PKW(pB1,4),PKW(pB1,6)};pw3=(u32x4){PKW(pB1,8),PKW(pB1,10),PKW(pB1,12),PKW(pB1,14)};
    SBAR(); pv(o,vb0+sl_cur,PAF(0),PAF(1),PAF(2),PAF(3)); }
  #undef PKW
  #undef PAF
  #undef VFR
  #undef PIN
  #undef MX3
  #undef GAPA
  #undef GAPB
  #undef EX
  #undef VRD
  #undef KRD
  #undef STEP
  #undef ENDW
  { const int lane=fresh_lane(),r32=lane&31,hi=lane>>5; float*wsf=(float*)(shm+LDS_WS)+wid*64;
  {auto rr=__builtin_amdgcn_permlane32_swap(__float_as_uint(l_reg),__float_as_uint(l_reg),false,false);l_reg=__uint_as_float(rr[0])+__uint_as_float(rr[1]);}
  if(hi==0)wsf[32+r32]=l_reg;asm volatile("s_waitcnt lgkmcnt(0)":::"memory");
  float rli[16];
  #pragma unroll
  for(int r=0;r<16;++r)rli[r]=__builtin_amdgcn_rcpf(wsf[32+crow(r,hi)]);
  bf16*Ow=O+(rowbase+q0+wid*QBLK)*OPITCH+h*D;
  { bf16*stg=(bf16*)(shm+LDS_OST)+wid*2048;
    #pragma unroll
    for(int r=0;r<16;++r){const int orow=crow(r,hi);
      #pragma unroll
      for(int d0=0;d0<2;++d0)stg[orow*64+d0*32+r32]=__float2bfloat16(o[d0][r]*rli[r]);}
    asm volatile("s_waitcnt lgkmcnt(0)":::"memory");
    #pragma unroll
    for(int i=0;i<4;++i){const int row=i*8+(lane>>3),ch=lane&7; const u32x4 v=*(const u32x4*)(stg+row*64+ch*8); ATTN_STORE16(Ow+(long)row*OPITCH+ch*8,v);} }
  }
  asm volatile("s_waitcnt lgkmcnt(0)\n\ts_barrier":::"memory");
  #undef DMA_K
  #undef DMA_V
  #undef CMASK
  #undef START
  #undef RESC
  #undef ROT
}
constexpr int ATTN_LDS_BYTES=LDS_BYTES;
struct AttnTensors { const bf16* Q; const bf16* K; const bf16* V; bf16* O; const unsigned long long* M; int wave; };
struct AttnUnit { int bh; int qb; };
struct StaticOrder {
  int vcu;
  __device__ __forceinline__ explicit StaticOrder(int grid,int block):vcu((block%8)*(grid/8)+block/8){}
  __device__ __forceinline__ bool next(int i,AttnUnit&u)const{ if(i>=2)return false; const int s=vcu&15; u.bh=vcu>>4; u.qb=(i==0)?s:31-s; return true; }
  __device__ __forceinline__ void a_ready(const AttnUnit&)const{}
  __device__ __forceinline__ void done(const AttnUnit&)const{}
};
template<class Sched,int THRL=8> __device__ __forceinline__ void attn_phase(char*lds,const AttnTensors&T,const Sched&S){
  AttnUnit u;
  for(int i=0;S.next(i,u);++i){ S.a_ready(u); attn_unit<THRL>(u.bh/NHEAD,u.bh%NHEAD,u.qb,T.Q,T.K,T.V,T.O,T.M,lds,T.wave); S.done(u); }
}
#undef SBAR
#undef WAIT_BAR
#undef MLOAD_P0
#undef MLOAD_P1
#undef MAP1
#undef MAPPLY1
#undef MWAIT
}
namespace pg8 {
#define PG8_LAS __attribute__((address_space(3)))
typedef unsigned short bf16_t;
typedef short bf16x8 __attribute__((ext_vector_type(8)));
typedef float f32x4 __attribute__((ext_vector_type(4)));
typedef unsigned u32x4 __attribute__((ext_vector_type(4)));
constexpr int BM = 256, BK = 64, HALF = 128, HTB = HALF * BK * 2  , STAGE_BYTES = 8 * HTB, NXCD = 8, WGM = 8;

__host__ __device__ __forceinline__ int lds_byte(int r, int c) { const int st = (r >> 4) * 2 + (c >> 5), rr = r & 15, cc = c & 31, ob = rr * 64 + cc * 2; return st * 1024 + (ob ^ (((ob >> 9) & 1) << 5)); }
__host__ __device__ __forceinline__ void stage_rc(int b, int& R, int& C) { const int st = b / 1024, sb = b % 1024, swz = sb ^ (((sb >> 9) & 1) << 5); R = (st >> 1) * 16 + swz / 64; C = (st & 1) * 32 + (swz % 64) / 2; }
__host__ __device__ __forceinline__ int perm32(int rho) { const int n = rho >> 4, i = rho & 15; return 8 * (i >> 2) + 4 * n + (i & 3); }

struct Unit { int pm, pn; };
struct Gemm { const bf16_t* A; const bf16_t* Bt; int M, N, K, wave; };

struct StaticOrder {
    int nM, nN, nwg, G, c;
    __host__ __device__ void init(int M, int N, int G_, int c_) { nM = M / BM; nN = N / BM; nwg = nM * nN; G = G_; c = c_; }
    __host__ __device__ bool next(int i, Unit& u) const {
        const long L = (long)i * G + c; if (L >= nwg) return false;
        int wgid = (int)L; { const int q = nwg / NXCD, r = nwg % NXCD, xcd = wgid % NXCD, off = wgid / NXCD; wgid = (xcd < r ? xcd * (q + 1) : r * (q + 1) + (xcd - r) * q) + off; }
        const int nig = WGM * nN, gid = wgid / nig, fm = gid * WGM, gsz = (nM - fm) < WGM ? (nM - fm) : WGM;
        u.pm = fm + ((wgid % nig) % gsz); u.pn = (wgid % nig) / gsz; return true;
    }
    __device__ __forceinline__ void a_ready(const Unit&) const {}
    __device__ __forceinline__ void done(const Unit&) const {}
};

__device__ __forceinline__ unsigned cvt_pk_bf16(float lo, float hi) { unsigned r; asm volatile("v_cvt_pk_bf16_f32 %0, %1, %2" : "=v"(r) : "v"(lo), "v"(hi)); return r; }
typedef float f32x2 __attribute__((ext_vector_type(2)));
template <class Epi, class Sched, bool ALIGN_EPI = false, bool SP2 = false>
__device__ __forceinline__ void gemm_phase(PG8_LAS unsigned char* lds, const Gemm g, const Sched& S, const Epi& E) {
    const int wid = g.wave, lane = fresh_lane(), tid = wid * 64 + lane, wr = wid >> 2, wc = wid & 3, fr = lane & 15, fq = lane >> 4;
    const int K = g.K, nt = K / BK;
    unsigned voffA[2], voffB[2];
#pragma unroll
    for (int i = 0; i < 2; ++i) { int R, C; stage_rc(tid * 16 + i * 8192, R, C); const int Rb = Epi::PERM ? ((R & ~31) + perm32(R & 31)) : R;
        voffA[i] = (unsigned)(R * K + C) * 2u; voffB[i] = (unsigned)(Rb * K + C) * 2u; }
    const size_t kstep = (size_t)(BK * 2);
    const size_t hstep = (size_t)HALF * K * 2;
    const size_t tstep = 2 * hstep;
    const unsigned ldsw = (unsigned)wid * 1024u;
    const int aoff = lds_byte(wr * 64 + fr, fq * 8), boff = lds_byte(wc * 32 + fr, fq * 8);
#define PG8_SA(b, h) (((b) * 2 + (h)) * HTB)
#define PG8_SB(b, h) ((4 + (b) * 2 + (h)) * HTB)
#define PG8_STAGE(bufoff, gbase, voff) do { _Pragma("unroll") for (int _i = 0; _i < 2; ++_i) \
        __builtin_amdgcn_global_load_lds((const unsigned*)((const char*)(gbase) + (voff)[_i]), (PG8_LAS unsigned*)(lds + (bufoff) + ldsw + _i * 8192), 16, 0, 0); } while (0)
#define PG8_LDA(dst, b, h) do { _Pragma("unroll") for (int m = 0; m < 4; ++m) _Pragma("unroll") for (int k = 0; k < 2; ++k) dst[m][k] = *(const PG8_LAS bf16x8*)(lds + PG8_SA(b, h) + aoff + m * 2048 + k * 1024); } while (0)
#define PG8_LDB(dst, b, h) do { _Pragma("unroll") for (int n = 0; n < 2; ++n) _Pragma("unroll") for (int k = 0; k < 2; ++k) dst[n][k] = *(const PG8_LAS bf16x8*)(lds + PG8_SB(b, h) + boff + n * 2048 + k * 1024); } while (0)
#define PG8_MMA(ai, bj, At, Bt) do { __builtin_amdgcn_s_setprio(1); _Pragma("unroll") for (int m = 0; m < 4; ++m) _Pragma("unroll") for (int n = 0; n < 2; ++n) _Pragma("unroll") for (int k = 0; k < 2; ++k) \
        acc[ai][bj][m][n] = __builtin_amdgcn_mfma_f32_16x16x32_bf16(Bt[n][k], At[m][k], acc[ai][bj][m][n], 0, 0, 0); __builtin_amdgcn_s_setprio(0); } while (0)
#define PG8_WAIT_V(n) asm volatile("s_waitcnt vmcnt(" #n ")" ::: "memory")
#define PG8_WAIT_L(n) asm volatile("s_waitcnt lgkmcnt(" #n ")" ::: "memory")
#define PG8_BAR __builtin_amdgcn_s_barrier()
#define PG8_SCHED __builtin_amdgcn_sched_barrier(0)
    Unit cur, nxt; int ui = 0;
    if (!S.next(0, cur)) return;
    f32x4 acc[2][2][4][2];
#pragma unroll
    for (int a = 0; a < 2; ++a)
#pragma unroll
        for (int b = 0; b < 2; ++b)
#pragma unroll
            for (int m = 0; m < 4; ++m)
#pragma unroll
                for (int n = 0; n < 2; ++n) acc[a][b][m][n] = (f32x4){0.f, 0.f, 0.f, 0.f};
    bf16x8 At[4][2], B0[2][2], B1[2][2];
    const char* cA = (const char*)g.A + (size_t)cur.pm * tstep; const char* cB = (const char*)g.Bt + (size_t)cur.pn * tstep;
    S.a_ready(cur);
    if constexpr (SP2) {
        PG8_STAGE(PG8_SB(0, 0), cB, voffB); PG8_STAGE(PG8_SB(0, 1), cB + hstep, voffB); PG8_STAGE(PG8_SA(0, 0), cA, voffA); PG8_STAGE(PG8_SA(0, 1), cA + hstep, voffA);
        if (wr == 1) PG8_BAR;
        PG8_WAIT_V(2); PG8_BAR;
        PG8_STAGE(PG8_SB(1, 0), cB + kstep, voffB); PG8_STAGE(PG8_SA(1, 0), cA + kstep, voffA); PG8_STAGE(PG8_SB(1, 1), cB + hstep + kstep, voffB);
        PG8_WAIT_V(6); PG8_BAR;
    } else {
        PG8_STAGE(PG8_SB(0, 0), cB, voffB); PG8_STAGE(PG8_SA(0, 0), cA, voffA); PG8_STAGE(PG8_SB(0, 1), cB + hstep, voffB); PG8_STAGE(PG8_SA(0, 1), cA + hstep, voffA);
        if (wr == 1) PG8_BAR;
        PG8_WAIT_V(4); PG8_BAR;
        PG8_STAGE(PG8_SB(1, 0), cB + kstep, voffB); PG8_STAGE(PG8_SA(1, 0), cA + kstep, voffA); PG8_STAGE(PG8_SB(1, 1), cB + hstep + kstep, voffB);
        PG8_WAIT_V(6); PG8_BAR;
    }
    for (;;) {
        const bool has_next = S.next(ui + 1, nxt);
        const char* nA = has_next ? (const char*)g.A + (size_t)nxt.pm * tstep : cA; const char* nB = has_next ? (const char*)g.Bt + (size_t)nxt.pn * tstep : cB;
        for (int t = 0; t < nt; t += 2) {
            const bool last = (t == nt - 2);
            const char* a1 = cA + (size_t)(t + 1) * kstep;
            const char* a2 = last ? nA : cA + (size_t)(t + 2) * kstep; const char* b2 = last ? nB : cB + (size_t)(t + 2) * kstep;
            const char* a3 = a2 + kstep; const char* b3 = b2 + kstep;
            if (last && has_next) S.a_ready(nxt);
            if constexpr (SP2) {
            PG8_LDB(B0, 0, 0); PG8_LDB(B1, 0, 1); PG8_SCHED; PG8_LDA(At, 0, 0); PG8_STAGE(PG8_SA(1, 1), a1 + hstep, voffA);
            PG8_WAIT_V(8); PG8_WAIT_L(0); PG8_BAR; PG8_MMA(0, 0, At, B0); PG8_MMA(0, 1, At, B1); PG8_BAR; PG8_SCHED;
            PG8_LDA(At, 0, 1); PG8_STAGE(PG8_SB(0, 0), b2, voffB); PG8_STAGE(PG8_SB(0, 1), b2 + hstep, voffB); PG8_STAGE(PG8_SA(0, 0), a2, voffA);
            PG8_WAIT_V(8); PG8_WAIT_L(0); PG8_BAR; PG8_MMA(1, 0, At, B0); PG8_MMA(1, 1, At, B1); PG8_BAR; PG8_SCHED;
            PG8_LDB(B0, 1, 0); PG8_LDB(B1, 1, 1); PG8_SCHED; PG8_LDA(At, 1, 0); PG8_STAGE(PG8_SA(0, 1), a2 + hstep, voffA);
            PG8_WAIT_V(8); PG8_WAIT_L(0); PG8_BAR; PG8_MMA(0, 0, At, B0); PG8_MMA(0, 1, At, B1); PG8_BAR; PG8_SCHED;
            PG8_LDA(At, 1, 1); PG8_STAGE(PG8_SB(1, 0), b3, voffB); PG8_STAGE(PG8_SB(1, 1), b3 + hstep, voffB); PG8_STAGE(PG8_SA(1, 0), a3, voffA);
            PG8_WAIT_V(8); PG8_WAIT_L(0); PG8_BAR; PG8_MMA(1, 0, At, B0); PG8_MMA(1, 1, At, B1); PG8_BAR; PG8_SCHED;
            } else {
            PG8_LDB(B0, 0, 0); PG8_SCHED; PG8_LDA(At, 0, 0); PG8_STAGE(PG8_SA(1, 1), a1 + hstep, voffA);
            PG8_WAIT_L(8); PG8_BAR; PG8_WAIT_L(0); PG8_MMA(0, 0, At, B0); PG8_BAR; PG8_SCHED;
            PG8_LDB(B1, 0, 1); PG8_STAGE(PG8_SB(0, 0), b2, voffB);
            PG8_BAR; PG8_WAIT_L(0); PG8_MMA(0, 1, At, B1); PG8_BAR;
            PG8_LDA(At, 0, 1); PG8_STAGE(PG8_SA(0, 0), a2, voffA);
            PG8_BAR; PG8_WAIT_L(0); PG8_MMA(1, 0, At, B0); PG8_BAR; PG8_SCHED;
            PG8_STAGE(PG8_SB(0, 1), b2 + hstep, voffB);
            PG8_WAIT_V(6); PG8_BAR; PG8_MMA(1, 1, At, B1); PG8_BAR;
            PG8_LDB(B0, 1, 0); PG8_SCHED; PG8_LDA(At, 1, 0); PG8_STAGE(PG8_SA(0, 1), a2 + hstep, voffA);
            PG8_WAIT_L(8); PG8_BAR; PG8_WAIT_L(0); PG8_MMA(0, 0, At, B0); PG8_BAR; PG8_SCHED;
            PG8_LDB(B1, 1, 1); PG8_STAGE(PG8_SB(1, 0), b3, voffB);
            PG8_BAR; PG8_WAIT_L(0); PG8_MMA(0, 1, At, B1); PG8_BAR;
            PG8_LDA(At, 1, 1); PG8_STAGE(PG8_SA(1, 0), a3, voffA);
            PG8_BAR; PG8_WAIT_L(0); PG8_MMA(1, 0, At, B0); PG8_BAR; PG8_SCHED;
            PG8_STAGE(PG8_SB(1, 1), b3 + hstep, voffB);
            PG8_WAIT_V(6); PG8_BAR; PG8_MMA(1, 1, At, B1); PG8_BAR;
            }
        }
        if constexpr (ALIGN_EPI) { if (wr == 0) PG8_BAR; }
        if constexpr (!Epi::AFTER_DRAIN) { E(acc, cur, wr, wc, fr, fq); S.done(cur); }
        if (!has_next) break;
#pragma unroll
        for (int a = 0; a < 2; ++a)
#pragma unroll
            for (int b = 0; b < 2; ++b)
#pragma unroll
                for (int m = 0; m < 4; ++m)
#pragma unroll
                    for (int n = 0; n < 2; ++n) acc[a][b][m][n] = (f32x4){0.f, 0.f, 0.f, 0.f};
        cur = nxt; cA = nA; cB = nB; ++ui;
        if constexpr (ALIGN_EPI) { if (wr == 1) PG8_BAR; }
    }
    PG8_WAIT_V(0);
    if constexpr (!ALIGN_EPI) { if (wr == 0) PG8_BAR; }
    PG8_BAR;
    if constexpr (Epi::AFTER_DRAIN) { E.fused(acc, cur, wr, wc, fr, fq, lds, wid, lane); S.done(cur); }
#undef PG8_SA
#undef PG8_SB
#undef PG8_STAGE
#undef PG8_LDA
#undef PG8_LDB
#undef PG8_MMA
#undef PG8_WAIT_V
#undef PG8_WAIT_L
#undef PG8_BAR
#undef PG8_SCHED
}
}
#define GAS __attribute__((address_space(1)))
#define LAS __attribute__((address_space(3)))
#define RLX_AGENT __ATOMIC_RELAXED, __HIP_MEMORY_SCOPE_AGENT
#define XB_TMO      128
#define XB_XCNT(j)  (256  + 64 * (j))
#define XB_XSUB(j)  (1280 + 64 * (j))
#define XB_XGEN(j)  (2304 + 64 * (j))
#define XB_TOP      3328
#define XB_TOPGEN   3392
#define XCD_BAR_WORDS 3456
#define XB_SPIN_CAP (1u << 21)

__device__ __forceinline__ unsigned xb_ld(unsigned* p)              { return __hip_atomic_load(p, __ATOMIC_RELAXED, __HIP_MEMORY_SCOPE_AGENT); }
__device__ __forceinline__ unsigned xb_add(unsigned* p, unsigned v) { return __hip_atomic_fetch_add(p, v, __ATOMIC_RELAXED, __HIP_MEMORY_SCOPE_AGENT); }
__device__ __forceinline__ unsigned xb_xcc_id() { return (unsigned)__builtin_amdgcn_s_getreg((3 << 11) | 20) & 0xFu; }
#define XB_SPIN(cond, bar) do { unsigned _sp = 0; while (cond) { __builtin_amdgcn_s_sleep(1); \
    if ((++_sp & 255u) == 0u) { if (xb_ld(&(bar)[XB_TMO])) break; if (_sp > XB_SPIN_CAP) { atomicAdd(&(bar)[XB_TMO], 1u); break; } } } } while (0)

struct XcdBarrier {
    unsigned* bar; unsigned x; int wv;
    volatile LAS unsigned* st;
};

__device__ __forceinline__ XcdBarrier xcd_barrier_post(unsigned* bar, volatile LAS unsigned* st) {
    XcdBarrier b; b.bar = bar; b.x = xb_xcc_id(); b.st = st;
    if (threadIdx.x == 0) (void)xb_add(&bar[XB_XCNT(b.x)], 1u);
    return b;
}
__device__ __forceinline__ void xcd_barrier_complete(unsigned* bar, unsigned x, unsigned& nloc, unsigned& nx) {
    const unsigned G = gridDim.x * gridDim.y * gridDim.z;
    unsigned sum, cnt, mine, sp = 0u;
    for (;;) {
        sum = 0u; cnt = 0u; mine = 0u;
#pragma unroll
        for (unsigned j = 0; j < 16; ++j) { const unsigned c = xb_ld(&bar[XB_XCNT(j)]); sum += c; cnt += (c > 0u) ? 1u : 0u; mine = (j == x) ? c : mine; }
        if (sum == G) break;
        __builtin_amdgcn_s_sleep(1);
        if ((++sp & 255u) == 0u) { if (xb_ld(&bar[XB_TMO])) break; if (sp > XB_SPIN_CAP) { atomicAdd(&bar[XB_TMO], 1u); break; } }
    }
    nloc = mine > 0u ? mine : 1u; nx = cnt > 0u ? cnt : 1u;
}

__device__ __forceinline__ void xcd_barrier(const XcdBarrier& b) {
    asm volatile("s_waitcnt vmcnt(0)" ::: "memory");
    __syncthreads();
    if (b.wv == 0 && fresh_lane() == 0) {
        unsigned* bar = b.bar;
        __builtin_amdgcn_s_waitcnt(0);
        unsigned nloc = b.st[0], nx = b.st[1];
        if (nloc == 0u) { xcd_barrier_complete(bar, b.x, nloc, nx); b.st[0] = nloc; b.st[1] = nx; }
        const unsigned old = xb_add(&bar[XB_XSUB(b.x)], 1u);
        const unsigned gen = old / nloc;
        if (old + 1u == (gen + 1u) * nloc) {
            __builtin_amdgcn_fence(__ATOMIC_RELEASE, "agent");
            asm volatile("s_waitcnt vmcnt(0)" ::: "memory");
            const unsigned og = xb_add(&bar[XB_TOP], 1u);
            const unsigned tg = og / nx;
            if (og + 1u == (tg + 1u) * nx) xb_add(&bar[XB_TOPGEN], 1u);
            else XB_SPIN(xb_ld(&bar[XB_TOPGEN]) == tg, bar);
            __builtin_amdgcn_fence(__ATOMIC_ACQUIRE, "agent");
            xb_add(&bar[XB_XGEN(b.x)], 1u);
            asm volatile("s_waitcnt vmcnt(0)" ::: "memory");
        } else {
            XB_SPIN(xb_ld(&bar[XB_XGEN(b.x)]) == gen, bar);
            __builtin_amdgcn_fence(__ATOMIC_ACQUIRE, "agent");
            asm volatile("s_waitcnt vmcnt(0)" ::: "memory");
        }
    }
    __syncthreads();
}
#ifndef PROBE_DUP
#define PROBE_DUP -1
#endif
using pg8::bf16_t; using pg8::f32x4; using pg8::u32x4; using pg8::Unit; using pg8::cvt_pk_bf16;
typedef unsigned long long u64;
constexpr int DM = 1024, SEQ = 8192, NB = 2, MP = NB * SEQ, DB = 128, DS = 8, MS = DB * DS, MT = MP + MS;
constexpr int PAST = 2048, PAGE = 128, NPAGES = 16;
constexpr int DCONV = 512, NH = 8, HD = 64, TOPK = 256;
constexpr int NMEM = 256, MH = 4, MHD = 256, DFF = 2816;
constexpr int DIN = 3656, DINP = 3840;
constexpr float EPS = 1e-6f;
constexpr int SPITCH = 2112;
constexpr int NWAVES = 8, NTHREADS = 512;
constexpr int NPHASE = 12;
constexpr int N_LAUNCHES = MK_N_LAUNCHES;

constexpr size_t OFF_Y_P = 0, OFF_Y_S = 16777216, OFF_K_P = 17825792, OFF_V_P = 26214400, OFF_IK_P = 34603008, OFF_CM_P = 35651584, OFF_CF_P = 35653632,
                 OFF_MK_P = 35664896, OFF_MV_P = 36189184, OFF_K_S = 36713472, OFF_V_S = 37237760, OFF_IK_S = 37762048, OFF_CM_S = 37827584, OFF_CF_S = 37958656, OUT_TOTAL = 38679552;

constexpr size_t MiB = 1u << 20;
constexpr size_t WS_CTL = 0, CTL_ZERO_BYTES = 1 * MiB;
constexpr size_t ACC_SS1 = 65536, ACC_SS2 = 139264, ACC_SSQ = 212992, ACC_SSK = 491520;
constexpr size_t WS_WIN = 1 * MiB, WS_WOUT = 9 * MiB, WS_WQ = 11 * MiB, WS_WKV = 13 * MiB, WS_WO = 17 * MiB, WS_WGU = 19 * MiB, WS_WDOWN = 30 * MiB;
constexpr size_t WS_COS = 36 * MiB, WS_SIN = 37 * MiB, WS_RSTD = 38 * MiB, WS_IW = 39 * MiB;
constexpr size_t WS_XB = 40 * MiB, WS_MEMB = 74 * MiB, WS_QIF = 75 * MiB  , WS_CB = 78 * MiB, WS_U = 95 * MiB;
constexpr size_t WS_Q = 112 * MiB, WS_K = 129 * MiB, WS_V = 146 * MiB, WS_QI = 163 * MiB, WS_KI = 180 * MiB, WS_AMIX = 183 * MiB;
constexpr size_t WS_H1 = 217 * MiB, WS_H1B = 285 * MiB, WS_QMEM = 319 * MiB, WS_OMEM = 353 * MiB, WS_H2 = 387 * MiB, WS_H2B = 455 * MiB;
constexpr size_t WS_SIDEG = 489 * MiB, WS_SIDEU = 491 * MiB, WS_LASTG = 493 * MiB, WS_G = 496 * MiB, WS_UP = 676 * MiB, WS_AFF = 770 * MiB, WS_SC = 864 * MiB, WS_SCS = 1376 * MiB, WS_SEL = 1385 * MiB, WS_CNT = 1403 * MiB, WS_MASK = 1404 * MiB, WS_MKF = 1420 * MiB, WS_MVF = 1421 * MiB, WS_END = 1422 * MiB;

constexpr int CW_BAR = 4096;
constexpr int CQ_PH2 = 1024, CQ_PH7 = 1536;
constexpr int RING_BYTES = 131072, MISC_OFF = RING_BYTES + 320, HALO_OFF = RING_BYTES + 1024, LDS_BYTES = 147456;

#define GAS __attribute__((address_space(1)))
#define LAS __attribute__((address_space(3)))
#define LDS_WAIT() asm volatile("s_waitcnt lgkmcnt(0)" ::: "memory")
typedef short bf16x8 __attribute__((ext_vector_type(8)));
typedef float f32x16 __attribute__((ext_vector_type(16)));

__device__ __forceinline__ float bf2f(unsigned b) { return __uint_as_float(b << 16); }
__device__ __forceinline__ float wave_sum(float v) {
#pragma unroll
    for (int o = 1; o < 64; o <<= 1) v += __shfl_xor(v, o);
    return v;
}
__device__ __forceinline__ float wave_max(float v) {
#pragma unroll
    for (int o = 1; o < 64; o <<= 1) v = fmaxf(v, __shfl_xor(v, o));
    return v;
}
__device__ __forceinline__ void store8_bf16(bf16_t* p, const float* v) {
    u32x4 w; w.x = cvt_pk_bf16(v[0], v[1]); w.y = cvt_pk_bf16(v[2], v[3]); w.z = cvt_pk_bf16(v[4], v[5]); w.w = cvt_pk_bf16(v[6], v[7]);
    *(u32x4*)p = w;
}
__device__ __forceinline__ void store8_f32(float* p, const float* v) {
    *(f32x4*)p = (f32x4){v[0], v[1], v[2], v[3]}; *(f32x4*)(p + 4) = (f32x4){v[4], v[5], v[6], v[7]};
}
__device__ __forceinline__ void load8_f32(const float* p, float* v) {
    const f32x4 a = *(const f32x4*)p, b = *(const f32x4*)(p + 4);
    v[0] = a.x; v[1] = a.y; v[2] = a.z; v[3] = a.w; v[4] = b.x; v[5] = b.y; v[6] = b.z; v[7] = b.w;
}
__device__ __forceinline__ void load8_bf16(const bf16_t* p, float* v) {
    const u32x4 w = *(const u32x4*)p;
    v[0] = bf2f(w.x & 0xffffu); v[1] = bf2f(w.x >> 16); v[2] = bf2f(w.y & 0xffffu); v[3] = bf2f(w.y >> 16);
    v[4] = bf2f(w.z & 0xffffu); v[5] = bf2f(w.z >> 16); v[6] = bf2f(w.w & 0xffffu); v[7] = bf2f(w.w >> 16);
}

struct Args { const void* in[29]; float* out; unsigned char* ws; int ph_lo, ph_hi; };
struct Ctx {
    const float *x_p, *x_s, *cache_k, *cache_v, *cache_ik, *st_mix, *st_ffn, *cmem_k, *cmem_v; const int* page_table; const float* mem_p;
    const float *g_mix, *w_in, *conv_mix_w, *q_g, *k_g, *w_out, *g_mem, *g_mem_src, *w_q, *w_kv, *mq_g, *mk_g, *w_o, *g_ffn, *w_gu, *conv_ffn_w, *conv_ffn_b, *w_down;
    float* out; unsigned char* ws;
    int tid, lane, wave, G, bid;
};

#define EPI_ROWS(ai, m) (u.pm * 256 + (ai) * 128 + wr * 64 + (m) * 16 + fr)
#define EPI_GET(dst, ai, bj, m, s) do { _Pragma("unroll") for (int e_ = 0; e_ < 4; ++e_) { (dst)[e_] = acc[ai][bj][m][0][e_] * (s); (dst)[4 + e_] = acc[ai][bj][m][1][e_] * (s); } } while (0)

struct EpiIn {
    static constexpr bool PERM = true, AFTER_DRAIN = false;
    const float* rstd; const float* cosT; const float* sinT; const float* qg; const float* kg;
    bf16_t *cbb, *ub, *qb, *kb, *vb, *qib, *kib; float* iwf; float* qif; float* out;
    __device__ __forceinline__ void operator()(const f32x4 (&acc)[2][2][4][2], const Unit& u, int wr, int wc, int fr, int fq) const {
        const int pn = u.pn; const int c8 = wc * 32 + 8 * fq; const bool samp = (u.pm >= 64);
#pragma unroll
        for (int ai = 0; ai < 2; ++ai) {
            float rsa[4];
#pragma unroll
            for (int m = 0; m < 4; ++m) rsa[m] = rstd[EPI_ROWS(ai, m)];
#pragma unroll
            for (int m = 0; m < 4; ++m) {
                const int r = EPI_ROWS(ai, m); const float rs = rsa[m];
                float lo[8], hi[8]; EPI_GET(lo, ai, 0, m, rs); EPI_GET(hi, ai, 1, m, rs);
                const int rl = samp ? r - MP : r; const int pos = samp ? PAST + (rl & 7) : (rl & (SEQ - 1));
                if (pn < 2) {
                    store8_bf16(cbb + (size_t)r * 512 + pn * 256 + c8, lo); store8_bf16(cbb + (size_t)r * 512 + pn * 256 + 128 + c8, hi);
                } else if (pn < 6) {
                    const int ch = 128 * (pn - 2) + c8; float uu[8];
#pragma unroll
                    for (int e = 0; e < 8; ++e) uu[e] = lo[e] * hi[e];
                    store8_bf16(ub + (size_t)r * 512 + ch, uu);
                    if (!samp) { const int t = rl & (SEQ - 1); if (t >= SEQ - 2) store8_f32(out + OFF_CM_P + (size_t)((rl >> 13) * 2 + (t - (SEQ - 2))) * 512 + ch, uu); }
                    else { const int tt = rl & 7; if (tt >= 6) store8_f32(out + OFF_CM_S + (size_t)((rl >> 3) * 2 + (tt - 6)) * 512 + ch, uu); }
                } else if (pn < 10 || pn == 12 || pn == 13) {
                    const int head = 4 * (pn & 1) + wc; const int d0 = 8 * fq;
                    if (pn < 10) {
                        float ss = 0.f;
#pragma unroll
                        for (int e = 0; e < 8; ++e) ss += lo[e] * lo[e] + hi[e] * hi[e];
                        ss += __shfl_xor(ss, 16); ss += __shfl_xor(ss, 32);
                        const float rn = 1.0f / sqrtf(ss * (1.f / 64.f) + EPS);
                        const float* g = (pn < 8) ? qg : kg; float gl[8], gh[8]; load8_f32(g + d0, gl); load8_f32(g + 32 + d0, gh);
#pragma unroll
                        for (int e = 0; e < 8; ++e) { lo[e] *= rn * gl[e]; hi[e] *= rn * gh[e]; }
                    }
                    float cs[8], sn[8]; load8_f32(cosT + (size_t)pos * 32 + d0, cs); load8_f32(sinT + (size_t)pos * 32 + d0, sn);
                    float ol[8], oh[8];
#pragma unroll
                    for (int e = 0; e < 8; ++e) { ol[e] = lo[e] * cs[e] - hi[e] * sn[e]; oh[e] = hi[e] * cs[e] + lo[e] * sn[e]; }
                    const size_t o512 = (size_t)r * 512 + head * 64 + d0;
                    if (pn < 8) {
#pragma unroll
                        for (int e = 0; e < 8; ++e) { ol[e] *= 0.18033688011112042f; oh[e] *= 0.18033688011112042f; }
                        store8_bf16(qb + o512, ol); store8_bf16(qb + o512 + 32, oh);
                    } else if (pn < 10) {
                        store8_bf16(kb + o512, ol); store8_bf16(kb + o512 + 32, oh);
                        float* ko = out + (samp ? OFF_K_S : OFF_K_P) + (size_t)rl * 512 + head * 64 + d0; store8_f32(ko, ol); store8_f32(ko + 32, oh);
                    } else {
                        store8_bf16(qib + o512, ol); store8_bf16(qib + o512 + 32, oh);
                    }
                } else if (pn < 12) {
                    const int c = 256 * (pn - 10) + c8;
                    store8_bf16(vb + (size_t)r * 512 + c, lo); store8_bf16(vb + (size_t)r * 512 + c + 128, hi);
                    float* vo = out + (samp ? OFF_V_S : OFF_V_P) + (size_t)rl * 512 + c; store8_f32(vo, lo); store8_f32(vo + 128, hi);
                } else {
                    if (wc == 0) {
                        const int d0 = 8 * fq; float cs[8], sn[8]; load8_f32(cosT + (size_t)pos * 32 + d0, cs); load8_f32(sinT + (size_t)pos * 32 + d0, sn);
                        float ol[8], oh[8];
#pragma unroll
                        for (int e = 0; e < 8; ++e) { ol[e] = lo[e] * cs[e] - hi[e] * sn[e]; oh[e] = hi[e] * cs[e] + lo[e] * sn[e]; }
                        store8_bf16(kib + (size_t)r * 64 + d0, ol); store8_bf16(kib + (size_t)r * 64 + 32 + d0, oh);
                        float* io = out + (samp ? OFF_IK_S : OFF_IK_P) + (size_t)rl * 64 + d0; store8_f32(io, ol); store8_f32(io + 32, oh);
                    } else if (wc == 1 && fq == 0) {
                        store8_f32(iwf + (size_t)r * 8, lo);
                    }
                }
            }
        }
    }
};

struct EpiKv {
    static constexpr bool PERM = true, AFTER_DRAIN = false;
    const float* rstd; float* ssk; float* out;
    __device__ __forceinline__ void operator()(const f32x4 (&acc)[2][2][4][2], const Unit& u, int wr, int wc, int fr, int fq) const {
        const int pn = u.pn; const int c8 = wc * 32 + 8 * fq;
        float rsv[2][4];
#pragma unroll
        for (int ai = 0; ai < 2; ++ai)
#pragma unroll
            for (int m = 0; m < 4; ++m) rsv[ai][m] = rstd[EPI_ROWS(ai, m)];
#pragma unroll
        for (int ai = 0; ai < 2; ++ai)
#pragma unroll
            for (int m = 0; m < 4; ++m) {
                const int r = EPI_ROWS(ai, m); const float rs = rsv[ai][m];
                float lo[8], hi[8]; EPI_GET(lo, ai, 0, m, rs); EPI_GET(hi, ai, 1, m, rs);
                if (pn < 4) {
                    float* o = out + OFF_MK_P + (size_t)r * 1024 + pn * 256 + c8; store8_f32(o, lo); store8_f32(o + 128, hi);
                    float ss = 0.f;
#pragma unroll
                    for (int e = 0; e < 8; ++e) ss += lo[e] * lo[e] + hi[e] * hi[e];
                    ss += __shfl_xor(ss, 16); ss += __shfl_xor(ss, 32);
                    if (fq == 0) atomicAdd(ssk + r * 4 + pn, ss);
                } else {
                    float* o = out + OFF_MV_P + (size_t)r * 1024 + (pn - 4) * 256 + c8; store8_f32(o, lo); store8_f32(o + 128, hi);
                }
            }
    }
    __device__ __forceinline__ void small8(int r, int c, const f32x4& v0, const f32x4& v1) const {
        const float rs = rstd[r];
        float v[8] = {v0.x * rs, v0.y * rs, v0.z * rs, v0.w * rs, v1.x * rs, v1.y * rs, v1.z * rs, v1.w * rs};
        if (c < 1024) {
            store8_f32(out + OFF_MK_P + (size_t)r * 1024 + c, v);
            float ss = 0.f;
#pragma unroll
            for (int e = 0; e < 8; ++e) ss += v[e] * v[e];
            ss += __shfl_xor(ss, 1); ss += __shfl_xor(ss, 2); ss += __shfl_xor(ss, 4);
            if ((fresh_lane() & 7) == 0) atomicAdd(ssk + r * 4 + (c >> 8), ss);
        } else store8_f32(out + OFF_MV_P + (size_t)r * 1024 + (c - 1024), v);
    }
};

struct EpiRes {
    static constexpr bool PERM = true, AFTER_DRAIN = false;
    const float* resP; const float* resS; const bf16_t* resB; float* dstP; float* dstS; bf16_t* dstB; float* ss;
    __device__ __forceinline__ void row(const f32x4 (&acc)[2][2][4][2], int ai, int m, int r, int rl, bool samp, int c8, int fq, const float* a, const float* b) const {
        float lo[8], hi[8]; EPI_GET(lo, ai, 0, m, 1.f); EPI_GET(hi, ai, 1, m, 1.f);
        float s2 = 0.f;
#pragma unroll
        for (int e = 0; e < 8; ++e) { lo[e] += a[e]; hi[e] += b[e]; s2 += lo[e] * lo[e] + hi[e] * hi[e]; }
        if (dstP) { float* dp = (samp ? dstS : dstP) + (size_t)rl * 1024 + c8; store8_f32(dp, lo); store8_f32(dp + 128, hi); }
        if (dstB) { store8_bf16(dstB + (size_t)r * 1024 + c8, lo); store8_bf16(dstB + (size_t)r * 1024 + c8 + 128, hi); }
        if (ss) { s2 += __shfl_xor(s2, 16); s2 += __shfl_xor(s2, 32); if (fq == 0) atomicAdd(ss + r, s2); }
    }
    __device__ __forceinline__ void operator()(const f32x4 (&acc)[2][2][4][2], const Unit& u, int wr, int wc, int fr, int fq) const {
        const bool samp = (u.pm >= 64); const int c8 = u.pn * 256 + wc * 32 + 8 * fq;
        if (resB) {
#pragma unroll
            for (int ai = 0; ai < 2; ++ai) {
                u32x4 ra[4], rb[4];
#pragma unroll
                for (int m = 0; m < 4; ++m) { const int r = EPI_ROWS(ai, m); ra[m] = *(const u32x4*)(resB + (size_t)r * 1024 + c8); rb[m] = *(const u32x4*)(resB + (size_t)r * 1024 + c8 + 128); }
#pragma unroll
                for (int m = 0; m < 4; ++m) { const int r = EPI_ROWS(ai, m); const int rl = samp ? r - MP : r; float a[8], b[8];
                    const u32x4 wa = ra[m], wb = rb[m];
                    a[0] = bf2f(wa.x & 0xffffu); a[1] = bf2f(wa.x >> 16); a[2] = bf2f(wa.y & 0xffffu); a[3] = bf2f(wa.y >> 16); a[4] = bf2f(wa.z & 0xffffu); a[5] = bf2f(wa.z >> 16); a[6] = bf2f(wa.w & 0xffffu); a[7] = bf2f(wa.w >> 16);
                    b[0] = bf2f(wb.x & 0xffffu); b[1] = bf2f(wb.x >> 16); b[2] = bf2f(wb.y & 0xffffu); b[3] = bf2f(wb.y >> 16); b[4] = bf2f(wb.z & 0xffffu); b[5] = bf2f(wb.z >> 16); b[6] = bf2f(wb.w & 0xffffu); b[7] = bf2f(wb.w >> 16);
                    row(acc, ai, m, r, rl, samp, c8, fq, a, b); }
            }
        } else {
#pragma unroll
            for (int ai = 0; ai < 2; ++ai) {
                f32x4 fa[4][2], fb[4][2];
#pragma unroll
                for (int m = 0; m < 4; ++m) { const int r = EPI_ROWS(ai, m); const int rl = samp ? r - MP : r; const float* rp = (samp ? resS : resP) + (size_t)rl * 1024 + c8;
                    fa[m][0] = *(const f32x4*)rp; fa[m][1] = *(const f32x4*)(rp + 4); fb[m][0] = *(const f32x4*)(rp + 128); fb[m][1] = *(const f32x4*)(rp + 132); }
#pragma unroll
                for (int m = 0; m < 4; ++m) { const int r = EPI_ROWS(ai, m); const int rl = samp ? r - MP : r;
                    const float a[8] = {fa[m][0].x, fa[m][0].y, fa[m][0].z, fa[m][0].w, fa[m][1].x, fa[m][1].y, fa[m][1].z, fa[m][1].w};
                    const float b[8] = {fb[m][0].x, fb[m][0].y, fb[m][0].z, fb[m][0].w, fb[m][1].x, fb[m][1].y, fb[m][1].z, fb[m][1].w};
                    row(acc, ai, m, r, rl, samp, c8, fq, a, b); }
            }
        }
    }
    __device__ __forceinline__ void small8(int r, int c, const f32x4& v0, const f32x4& v1) const {
        const int rl = r - MP; f32x4 a, b;
        if (resB) { const u32x4 w = *(const u32x4*)(resB + (size_t)r * 1024 + c);
            a = (f32x4){bf2f(w.x & 0xffffu), bf2f(w.x >> 16), bf2f(w.y & 0xffffu), bf2f(w.y >> 16)}; b = (f32x4){bf2f(w.z & 0xffffu), bf2f(w.z >> 16), bf2f(w.w & 0xffffu), bf2f(w.w >> 16)}; }
        else { const float* rp = resS + (size_t)rl * 1024 + c; a = *(const f32x4*)rp; b = *(const f32x4*)(rp + 4); }
        a = a + v0; b = b + v1;
        if (dstS) { float* dp = dstS + (size_t)rl * 1024 + c; *(f32x4*)dp = a; *(f32x4*)(dp + 4) = b; }
        if (dstB) { u32x4 w; w.x = cvt_pk_bf16(a.x, a.y); w.y = cvt_pk_bf16(a.z, a.w); w.z = cvt_pk_bf16(b.x, b.y); w.w = cvt_pk_bf16(b.z, b.w); *(u32x4*)(dstB + (size_t)r * 1024 + c) = w; }
        if (ss) { float s2 = (a.x * a.x + a.y * a.y) + (a.z * a.z + a.w * a.w) + (b.x * b.x + b.y * b.y) + (b.z * b.z + b.w * b.w);
            s2 += __shfl_xor(s2, 1); s2 += __shfl_xor(s2, 2); s2 += __shfl_xor(s2, 4); if ((c & 63) == 0) atomicAdd(ss + r, s2); }
    }
    __device__ __forceinline__ void small(int r, int c, int q, const f32x4& v0, const f32x4& v1) const {
        const int rl = r - MP; f32x4 a, b;
        if (resB) { const u64 w0 = *(const u64*)(resB + (size_t)r * 1024 + c), w1 = *(const u64*)(resB + (size_t)r * 1024 + c + 16);
            a = (f32x4){bf2f((unsigned)w0 & 0xffffu), bf2f(((unsigned)w0) >> 16), bf2f((unsigned)(w0 >> 32) & 0xffffu), bf2f((unsigned)(w0 >> 48))};
            b = (f32x4){bf2f((unsigned)w1 & 0xffffu), bf2f(((unsigned)w1) >> 16), bf2f((unsigned)(w1 >> 32) & 0xffffu), bf2f((unsigned)(w1 >> 48))}; }
        else { const float* rp = resS + (size_t)rl * 1024 + c; a = *(const f32x4*)rp; b = *(const f32x4*)(rp + 16); }
        a = a + v0; b = b + v1;
        if (dstS) { float* dp = dstS + (size_t)rl * 1024 + c; *(f32x4*)dp = a; *(f32x4*)(dp + 16) = b; }
        if (dstB) { bf16_t* bp = dstB + (size_t)r * 1024 + c; *(u64*)bp = (u64)cvt_pk_bf16(a.x, a.y) | ((u64)cvt_pk_bf16(a.z, a.w) << 32); *(u64*)(bp + 16) = (u64)cvt_pk_bf16(b.x, b.y) | ((u64)cvt_pk_bf16(b.z, b.w) << 32); }
        if (ss) { float s2 = (a.x * a.x + a.y * a.y) + (a.z * a.z + a.w * a.w) + (b.x * b.x + b.y * b.y) + (b.z * b.z + b.w * b.w); s2 += __shfl_xor(s2, 16); s2 += __shfl_xor(s2, 32); if (q == 0) atomicAdd(ss + r, s2); }
    }
};

struct EpiQm {
    static constexpr bool PERM = true, AFTER_DRAIN = false;
    const float* ss1; const float* mqg; bf16_t* qmem; float* ssq;
    __device__ __forceinline__ void operator()(const f32x4 (&acc)[2][2][4][2], const Unit& u, int wr, int wc, int fr, int fq) const {
        const int c8 = wc * 32 + 8 * fq; float gl[8], gh[8]; load8_f32(mqg + c8, gl); load8_f32(mqg + 128 + c8, gh);
        float rsv[2][4];
#pragma unroll
        for (int ai = 0; ai < 2; ++ai)
#pragma unroll
            for (int m = 0; m < 4; ++m) rsv[ai][m] = __builtin_amdgcn_rsqf(ss1[EPI_ROWS(ai, m)] * (1.f / 1024.f) + EPS);
#pragma unroll
        for (int ai = 0; ai < 2; ++ai)
#pragma unroll
            for (int m = 0; m < 4; ++m) {
                const int r = EPI_ROWS(ai, m); const float rs = rsv[ai][m];
                float lo[8], hi[8]; EPI_GET(lo, ai, 0, m, rs); EPI_GET(hi, ai, 1, m, rs);
                float s2 = 0.f;
#pragma unroll
                for (int e = 0; e < 8; ++e) { s2 += lo[e] * lo[e] + hi[e] * hi[e]; lo[e] *= gl[e]; hi[e] *= gh[e]; }
                s2 += __shfl_xor(s2, 16); s2 += __shfl_xor(s2, 32); if (fq == 0) atomicAdd(ssq + r * 4 + u.pn, s2);
                bf16_t* o = qmem + (size_t)r * 1024 + u.pn * 256 + c8; store8_bf16(o, lo); store8_bf16(o + 128, hi);
            }
    }
    __device__ __forceinline__ void small8(int r, int c, const f32x4& v0, const f32x4& v1) const {
        const float rs = __builtin_amdgcn_rsqf(ss1[r] * (1.f / 1024.f) + EPS); const f32x4 a = v0 * rs, b = v1 * rs;
        float s2 = (a.x * a.x + a.y * a.y) + (a.z * a.z + a.w * a.w) + (b.x * b.x + b.y * b.y) + (b.z * b.z + b.w * b.w); s2 += __shfl_xor(s2, 1); s2 += __shfl_xor(s2, 2); s2 += __shfl_xor(s2, 4);
        if ((c & 63) == 0) atomicAdd(ssq + r * 4 + (c >> 8), s2);
        const f32x4 g0 = *(const f32x4*)(mqg + (c & 255)), g1 = *(const f32x4*)(mqg + (c & 255) + 4); const f32x4 x = a * g0, y = b * g1;
        u32x4 w; w.x = cvt_pk_bf16(x.x, x.y); w.y = cvt_pk_bf16(x.z, x.w); w.z = cvt_pk_bf16(y.x, y.y); w.w = cvt_pk_bf16(y.z, y.w); *(u32x4*)(qmem + (size_t)r * 1024 + c) = w;
    }
    __device__ __forceinline__ void small(int r, int c, int q, const f32x4& v0, const f32x4& v1) const {
        const float rs = 1.0f / sqrtf(ss1[r] * (1.f / 1024.f) + EPS); const f32x4 a = v0 * rs, b = v1 * rs;
        float s2 = (a.x * a.x + a.y * a.y) + (a.z * a.z + a.w * a.w) + (b.x * b.x + b.y * b.y) + (b.z * b.z + b.w * b.w); s2 += __shfl_xor(s2, 16); s2 += __shfl_xor(s2, 32);
        if (q == 0) atomicAdd(ssq + r * 4 + (c >> 8), s2);
        const f32x4 g0 = *(const f32x4*)(mqg + (c & 255)), g1 = *(const f32x4*)(mqg + (c & 255) + 16); const f32x4 x = a * g0, y = b * g1;
        bf16_t* bp = qmem + (size_t)r * 1024 + c; *(u64*)bp = (u64)cvt_pk_bf16(x.x, x.y) | ((u64)cvt_pk_bf16(x.z, x.w) << 32); *(u64*)(bp + 16) = (u64)cvt_pk_bf16(y.x, y.y) | ((u64)cvt_pk_bf16(y.z, y.w) << 32);
    }
};

#define DPP_SHR1(old, x) __builtin_bit_cast(float, __builtin_amdgcn_update_dpp(__builtin_bit_cast(int, (old)), __builtin_bit_cast(int, (x)), 0x111, 0xF, 0xF, false))
#define DPP_SHR2(old, x) __builtin_bit_cast(float, __builtin_amdgcn_update_dpp(__builtin_bit_cast(int, (old)), __builtin_bit_cast(int, (x)), 0x112, 0xF, 0xF, false))
#define DPP_ROR1(x) __builtin_bit_cast(float, __builtin_amdgcn_update_dpp(0, __builtin_bit_cast(int, (x)), 0x121, 0xF, 0xF, true))
#define DPP_ROR2(x) __builtin_bit_cast(float, __builtin_amdgcn_update_dpp(0, __builtin_bit_cast(int, (x)), 0x122, 0xF, 0xF, true))
struct EpiGu {
    static constexpr bool PERM = true, AFTER_DRAIN = false;
    const float* ss2; const float* cw; const float* cb; const float* st; bf16_t* aff; float* sideg; float* sideu; float* lastg; float* out; float* halo;
    __device__ __forceinline__ void operator()(const f32x4 (&acc)[2][2][4][2], const Unit& u, int wr, int wc, int fr, int fq) const {
        const int ch = 128 * u.pn + wc * 32 + 8 * fq; const bool samp = (u.pm >= 64);
        float w0[8], w1[8], w2[8], bb[8]; load8_f32(cw + ch, w0); load8_f32(cw + DFF + ch, w1); load8_f32(cw + 2 * DFF + ch, w2); load8_f32(cb + ch, bb);
        float* hme = halo + (((wr * 4 + wc) * 4 + fq) * 2) * 8;
        float rsv[2][4];
#pragma unroll
        for (int ai = 0; ai < 2; ++ai)
#pragma unroll
            for (int m = 0; m < 4; ++m) rsv[ai][m] = __builtin_amdgcn_rsqf(ss2[EPI_ROWS(ai, m)] * (1.f / 1024.f) + EPS);
#pragma unroll
        for (int ai = 0; ai < 2; ++ai) {
            const int r = EPI_ROWS(ai, 3); const float rs = rsv[ai][3];
            float g[8]; EPI_GET(g, ai, 0, 3, rs);
            if (fr >= 14) { store8_f32(hme + ai * 512 + (fr - 14) * 8, g); if (ai == 1 && wr == 1 && !samp) store8_f32(lastg + (size_t)(u.pm * 2 + (fr - 14)) * DFF + ch, g); }
        }
        asm volatile("s_waitcnt lgkmcnt(0)" ::: "memory"); __builtin_amdgcn_s_barrier();
#pragma unroll
        for (int ai = 0; ai < 2; ++ai) {
            float prev[8];
#pragma unroll
            for (int m = 0; m < 4; ++m) {
                const int r = EPI_ROWS(ai, m); const float rs = rsv[ai][m];
                float g[8], up[8], p1[8], p2[8]; EPI_GET(g, ai, 0, m, rs); EPI_GET(up, ai, 1, m, rs);
                if (m == 0) {
                    float x1[8], x2[8];
#pragma unroll
                    for (int e = 0; e < 8; ++e) { x1[e] = 0.f; x2[e] = 0.f; }
                    if (!(ai == 0 && wr == 0) && !samp) {
                        const float* hp = halo + (wr == 1 ? ai * 512 : (ai - 1) * 512) + ((((wr ^ 1) * 4 + wc) * 4 + fq) * 2) * 8;
                        if (fr == 0) { load8_f32(hp, x2); load8_f32(hp + 8, x1); } else if (fr == 1) { load8_f32(hp + 8, x2); }
                    }
#pragma unroll
                    for (int e = 0; e < 8; ++e) { p1[e] = DPP_SHR1(x1[e], g[e]); p2[e] = DPP_SHR2(x2[e], g[e]); }
                    if (ai == 0 && wr == 0 && !samp && (u.pm & 31) != 0 && fr < 2) {
                        store8_f32(sideg + (size_t)(u.pm * 2 + fr) * DFF + ch, g); store8_f32(sideu + (size_t)(u.pm * 2 + fr) * DFF + ch, up);
                    }
                } else {
#pragma unroll
                    for (int e = 0; e < 8; ++e) { const float x1 = DPP_ROR1(prev[e]), x2 = DPP_ROR2(prev[e]); p1[e] = DPP_SHR1(x1, g[e]); p2[e] = DPP_SHR2(x2, g[e]); }
                }
                if (samp) {
                    const int rl = r - MP, b = rl >> 3, tt = rl & 7;
                    if (tt == 0) { load8_f32(st + (size_t)(b * 2 + 1) * DFF + ch, p1); load8_f32(st + (size_t)(b * 2) * DFF + ch, p2); }
                    else if (tt == 1) { load8_f32(st + (size_t)(b * 2 + 1) * DFF + ch, p2); }
                    if (tt >= 6) store8_f32(out + OFF_CF_S + (size_t)(b * 2 + (tt - 6)) * DFF + ch, g);
                } else {
                    const int t = r & (SEQ - 1); if (t >= SEQ - 2) store8_f32(out + OFF_CF_P + (size_t)((r >> 13) * 2 + (t - (SEQ - 2))) * DFF + ch, g);
                }
                float y[8];
#pragma unroll
                for (int e = 0; e < 8; ++e) { const float z = w0[e] * p2[e] + w1[e] * p1[e] + w2[e] * g[e] + bb[e]; y[e] = (z * __builtin_amdgcn_rcpf(1.0f + __builtin_amdgcn_exp2f(-1.4426950408889634f * z))) * up[e]; prev[e] = g[e]; }
                store8_bf16(aff + (size_t)r * DFF + ch, y);
            }
        }
    }
};
__device__ __forceinline__ void ffn_fixup_rows(const Ctx& C, int pm) {
    if (pm >= 64 || (pm & 31) == 0) return;
    const float* sideg = (const float*)(C.ws + WS_SIDEG); const float* sideu = (const float*)(C.ws + WS_SIDEU); const float* lastg = (const float*)(C.ws + WS_LASTG);
    bf16_t* aff = (bf16_t*)(C.ws + WS_AFF);
    constexpr int NC = (DFF + NTHREADS - 1) / NTHREADS;
    float g0[NC], g1[NC], u0[NC], u1[NC], l0[NC], l1[NC], w0[NC], w1[NC], w2[NC], bb[NC];
#pragma unroll
    for (int i = 0; i < NC; ++i) { const int c = C.tid + i * NTHREADS; const int cc = (c < DFF) ? c : 0;
        g0[i] = sideg[(size_t)(pm * 2) * DFF + cc]; g1[i] = sideg[(size_t)(pm * 2 + 1) * DFF + cc]; u0[i] = sideu[(size_t)(pm * 2) * DFF + cc]; u1[i] = sideu[(size_t)(pm * 2 + 1) * DFF + cc];
        l0[i] = lastg[(size_t)((pm - 1) * 2) * DFF + cc]; l1[i] = lastg[(size_t)((pm - 1) * 2 + 1) * DFF + cc];
        w0[i] = C.conv_ffn_w[cc]; w1[i] = C.conv_ffn_w[DFF + cc]; w2[i] = C.conv_ffn_w[2 * DFF + cc]; bb[i] = C.conv_ffn_b[cc]; }
#pragma unroll
    for (int i = 0; i < NC; ++i) { const int c = C.tid + i * NTHREADS;
        const float z0 = w0[i] * l0[i] + w1[i] * l1[i] + w2[i] * g0[i] + bb[i], z1 = w0[i] * l1[i] + w1[i] * g0[i] + w2[i] * g1[i] + bb[i];
        if (c < DFF) {
            aff[(size_t)(256 * pm) * DFF + c] = (bf16_t)(cvt_pk_bf16((z0 * __builtin_amdgcn_rcpf(1.0f + __builtin_amdgcn_exp2f(-1.4426950408889634f * z0))) * u0[i], 0.f) & 0xffffu);
            aff[(size_t)(256 * pm + 1) * DFF + c] = (bf16_t)(cvt_pk_bf16((z1 * __builtin_amdgcn_rcpf(1.0f + __builtin_amdgcn_exp2f(-1.4426950408889634f * z1))) * u1[i], 0.f) & 0xffffu); } }
    asm volatile("s_waitcnt vmcnt(0)" ::: "memory");
    __syncthreads();
}

template <class Epi> __device__ __forceinline__ void gemm_small(const bf16_t* A, const bf16_t* Bt, int K, int tile, int wave, int lane, const Epi& E) {
    const int i = lane & 15, q = lane >> 4, wm = wave & 3, wn = wave >> 2;
    const int row = MP + (tile >> 4) * 64 + wm * 16 + i, col0 = (tile & 15) * 64 + wn * 32;
    const bf16_t* ap = A + (size_t)row * K + 8 * q; const bf16_t* bp0 = Bt + (size_t)(col0 + i) * K + 8 * q; const bf16_t* bp1 = bp0 + (size_t)16 * K;
    f32x4 c0 = {0.f, 0.f, 0.f, 0.f}, c1 = {0.f, 0.f, 0.f, 0.f};
    for (int k0 = 0; k0 < K; k0 += 256) {
        bf16x8 a[8], b0[8], b1[8];
#pragma unroll
        for (int u = 0; u < 8; ++u) { a[u] = *(const bf16x8*)(ap + k0 + 32 * u); b0[u] = *(const bf16x8*)(bp0 + k0 + 32 * u); b1[u] = *(const bf16x8*)(bp1 + k0 + 32 * u); }
#pragma unroll
        for (int u = 0; u < 8; ++u) { c0 = __builtin_amdgcn_mfma_f32_16x16x32_bf16(b0[u], a[u], c0, 0, 0, 0); c1 = __builtin_amdgcn_mfma_f32_16x16x32_bf16(b1[u], a[u], c1, 0, 0, 0); }
    }
    E.small(row, col0 + 4 * q, q, c0, c1);
}

template <int K, class Epi> __device__ __forceinline__ void gemm_small2_rc(const bf16_t* A, const bf16_t* Bt, int row0, int col0, int wave, int lane, const Epi& E, unsigned char* lds) {
    constexpr int KW = K / 8, NS = KW / 32;
    const int i = lane & 15, q = lane >> 4;
    const bf16_t* ap = A + (size_t)(row0 + i) * K + wave * KW + 8 * q; const bf16_t* bp = Bt + (size_t)(col0 + i) * K + wave * KW + 8 * q;
    f32x4 acc[4][4];
#pragma unroll
    for (int cb = 0; cb < 4; ++cb)
#pragma unroll
        for (int rb = 0; rb < 4; ++rb) acc[cb][rb] = (f32x4){0.f, 0.f, 0.f, 0.f};
#pragma unroll
    for (int s0 = 0; s0 < NS; s0 += 4) {
        bf16x8 a[4][4], b[4][4];
#pragma unroll
        for (int s = 0; s < 4; ++s) if (s0 + s < NS) {
#pragma unroll
            for (int x = 0; x < 4; ++x) { a[s][x] = *(const bf16x8*)(ap + (size_t)(16 * x) * K + 32 * (s0 + s)); b[s][x] = *(const bf16x8*)(bp + (size_t)(16 * x) * K + 32 * (s0 + s)); } }
#pragma unroll
        for (int s = 0; s < 4; ++s) if (s0 + s < NS) {
#pragma unroll
            for (int cb = 0; cb < 4; ++cb)
#pragma unroll
                for (int rb = 0; rb < 4; ++rb) acc[cb][rb] = __builtin_amdgcn_mfma_f32_16x16x32_bf16(b[s][cb], a[s][rb], acc[cb][rb], 0, 0, 0); }
    }
    float* slab = (float*)lds + wave * 4096;
    __syncthreads();
#pragma unroll
    for (int cb = 0; cb < 4; ++cb)
#pragma unroll
        for (int rb = 0; rb < 4; ++rb) *(f32x4*)(slab + (16 * rb + i) * 64 + 4 * ((4 * cb + q) ^ i)) = acc[cb][rb];
    __syncthreads();
    {
        const int t = wave * 64 + lane, r = t >> 3, c8 = t & 7;
        f32x4 v0 = {0.f, 0.f, 0.f, 0.f}, v1 = {0.f, 0.f, 0.f, 0.f};
#pragma unroll
        for (int w = 0; w < 8; ++w) { const float* sp = (const float*)lds + w * 4096 + r * 64;
            v0 += *(const f32x4*)(sp + 4 * ((2 * c8) ^ (r & 15))); v1 += *(const f32x4*)(sp + 4 * ((2 * c8 + 1) ^ (r & 15))); }
        E.small8(row0 + r, col0 + 8 * c8, v0, v1);
    }
    __syncthreads();
}
template <int K, class Epi> __device__ __forceinline__ void gemm_small2(const bf16_t* A, const bf16_t* Bt, int tile, int wave, int lane, const Epi& E, unsigned char* lds) {
    gemm_small2_rc<K, Epi>(A, Bt, MP + (tile >> 4) * 64, (tile & 15) * 64, wave, lane, E, lds);
}

__device__ __forceinline__ int orig_win(int np) {
    const int T = np >> 8, cl = np & 255, bj = cl >> 7, wc = (cl >> 5) & 3, i = cl & 31;
    if (T < 2) return np;
    if (T < 6) return (bj ? 1024 : 512) + 128 * (T - 2) + (cl & 127);
    if (T < 8) return 1536 + (4 * (T - 6) + wc) * 64 + 32 * bj + i;
    if (T < 10) return 2048 + (4 * (T - 8) + wc) * 64 + 32 * bj + i;
    if (T < 12) return 2560 + 256 * (T - 10) + cl;
    if (T < 14) return 3072 + (4 * (T - 12) + wc) * 64 + 32 * bj + i;
    if (wc == 0) return 3584 + 32 * bj + i;
    if (wc == 1 && bj == 0 && i < 8) return 3648 + i;
    return -1;
}
__device__ __forceinline__ int orig_wgu(int np) { const int T = np >> 8, cl = np & 255; return ((cl >> 7) ? DFF : 0) + 128 * T + (cl & 127); }

template <int MODE> __device__ __forceinline__ void wt_item(const float* W, int K, int N, int Np, const float* gain, bf16_t* WT, int item, float* scr, int lane) {
    const int nblk = Np / 32, kb = item / nblk, nb = item - kb * nblk, k0 = 64 * kb, n0 = 32 * nb;
    const int np = n0 + (lane & 31); const int o = (MODE == 1) ? orig_win(np) : (MODE == 2) ? orig_wgu(np) : np;
    float wv[32];
#pragma unroll
    for (int i = 0; i < 32; ++i) { const int kk = 2 * i + (lane >> 5); wv[i] = (o >= 0) ? W[(size_t)(k0 + kk) * N + o] : 0.f; }
    if (gain) {
        float gv[32];
#pragma unroll
        for (int i = 0; i < 32; ++i) gv[i] = gain[k0 + 2 * i + (lane >> 5)];
#pragma unroll
        for (int i = 0; i < 32; ++i) wv[i] *= gv[i];
    }
#pragma unroll
    for (int i = 0; i < 32; ++i) scr[(2 * i + (lane >> 5)) * 33 + (lane & 31)] = wv[i];
    LDS_WAIT();
    const int c = lane & 7;
#pragma unroll
    for (int j = 0; j < 4; ++j) { const int n = (lane >> 3) + 8 * j; const float* s = scr + (8 * c) * 33 + n;
        u32x4 ov; ov.x = cvt_pk_bf16(s[0 * 33], s[1 * 33]); ov.y = cvt_pk_bf16(s[2 * 33], s[3 * 33]); ov.z = cvt_pk_bf16(s[4 * 33], s[5 * 33]); ov.w = cvt_pk_bf16(s[6 * 33], s[7 * 33]);
        *(u32x4*)(WT + (size_t)(n0 + n) * K + k0 + 8 * c) = ov; }
    LDS_WAIT();
}
__device__ __forceinline__ void row_to_bf16(const float* xrow, bf16_t* orow, float* rstd_out, int lane) {
    const f32x4* xr = (const f32x4*)xrow + lane; f32x4 v[4]; float s = 0.f;
#pragma unroll
    for (int j = 0; j < 4; ++j) { v[j] = xr[64 * j]; s += (v[j].x * v[j].x + v[j].y * v[j].y) + (v[j].z * v[j].z + v[j].w * v[j].w); }
    s = wave_sum(s); if (lane == 0) *rstd_out = 1.0f / sqrtf(s * (1.f / 1024.f) + EPS);
    u64* o8 = (u64*)orow + lane;
#pragma unroll
    for (int j = 0; j < 4; ++j) o8[64 * j] = (u64)cvt_pk_bf16(v[j].x, v[j].y) | ((u64)cvt_pk_bf16(v[j].z, v[j].w) << 32);
}
__device__ __forceinline__ void sincos_d(double a, float& sn, float& cs) {
    const double n = __builtin_rint(a * 0.63661977236758134308); const int q = ((int)n) & 3;
    double r = __builtin_fma(-n, 1.57079632679489655800e+00, a); r = __builtin_fma(-n, 6.12323399573676603587e-17, r);
    const double r2 = r * r;
    double ps = 1.0 / 6227020800.0; ps = ps * r2 - 1.0 / 39916800.0; ps = ps * r2 + 1.0 / 362880.0; ps = ps * r2 - 1.0 / 5040.0; ps = ps * r2 + 1.0 / 120.0; ps = ps * r2 - 1.0 / 6.0; ps = ps * r2 * r + r;
    double pc = -1.0 / 87178291200.0; pc = pc * r2 + 1.0 / 479001600.0; pc = pc * r2 - 1.0 / 3628800.0; pc = pc * r2 + 1.0 / 40320.0; pc = pc * r2 - 1.0 / 720.0; pc = pc * r2 + 1.0 / 24.0; pc = pc * r2 - 0.5; pc = pc * r2 + 1.0;
    const double s = (q == 0) ? ps : (q == 1) ? pc : (q == 2) ? -ps : -pc;
    const double c = (q == 0) ? pc : (q == 1) ? -ps : (q == 2) ? -pc : ps;
    sn = (float)s; cs = (float)c;
}
__device__ __forceinline__ void ph0_prologue(const Ctx& C, unsigned char* lds) {
    float* scr = (float*)lds + C.wave * (64 * 33);
    const int gw = C.bid * NWAVES + C.wave, NGW = C.G * NWAVES;
    constexpr int I_IN = 16 * (DINP / 32), I_OUT = 16 * 32, I_Q = 16 * 32, I_KV = 16 * 64, I_O = 16 * 32, I_GU = 16 * (2 * DFF / 32), I_DN = (DFF / 64) * 32;
    constexpr int NIT = I_IN + I_OUT + I_Q + I_KV + I_O + I_GU + I_DN;
    for (int it = gw; it < NIT; it += NGW) {
        int r = __builtin_amdgcn_readfirstlane(it);
        if (r < I_IN) { wt_item<1>(C.w_in, DM, DIN, DINP, C.g_mix, (bf16_t*)(C.ws + WS_WIN), r, scr, C.lane); continue; } r -= I_IN;
        if (r < I_OUT) { wt_item<0>(C.w_out, DM, DM, DM, nullptr, (bf16_t*)(C.ws + WS_WOUT), r, scr, C.lane); continue; } r -= I_OUT;
        if (r < I_Q) { wt_item<0>(C.w_q, DM, DM, DM, C.g_mem, (bf16_t*)(C.ws + WS_WQ), r, scr, C.lane); continue; } r -= I_Q;
        if (r < I_KV) { wt_item<0>(C.w_kv, DM, 2 * DM, 2 * DM, C.g_mem_src, (bf16_t*)(C.ws + WS_WKV), r, scr, C.lane); continue; } r -= I_KV;
        if (r < I_O) { wt_item<0>(C.w_o, DM, DM, DM, nullptr, (bf16_t*)(C.ws + WS_WO), r, scr, C.lane); continue; } r -= I_O;
        if (r < I_GU) { wt_item<2>(C.w_gu, DM, 2 * DFF, 2 * DFF, C.g_ffn, (bf16_t*)(C.ws + WS_WGU), r, scr, C.lane); continue; } r -= I_GU;
        wt_item<0>(C.w_down, DFF, DM, DM, nullptr, (bf16_t*)(C.ws + WS_WDOWN), r, scr, C.lane);
    }
    float* rstd = (float*)(C.ws + WS_RSTD);
    for (int m0 = gw; m0 < MT + 512; m0 += 4 * NGW) {
        const float* src[4]; bf16_t* dst[4]; bool ok[4]; f32x4 v[4][4];
#pragma unroll
        for (int u = 0; u < 4; ++u) { const int m = m0 + u * NGW; ok[u] = m < MT + 512; const int mm = ok[u] ? m : 0;
            if (mm < MP) { src[u] = C.x_p + (size_t)mm * DM; dst[u] = (bf16_t*)(C.ws + WS_XB) + (size_t)mm * DM; }
            else if (mm < MT) { src[u] = C.x_s + (size_t)(mm - MP) * DM; dst[u] = (bf16_t*)(C.ws + WS_XB) + (size_t)mm * DM; }
            else { src[u] = C.mem_p + (size_t)(mm - MT) * DM; dst[u] = (bf16_t*)(C.ws + WS_MEMB) + (size_t)(mm - MT) * DM; }
#pragma unroll
            for (int j = 0; j < 4; ++j) v[u][j] = ((const f32x4*)src[u] + C.lane)[64 * j]; }
#pragma unroll
        for (int u = 0; u < 4; ++u) { const int m = m0 + u * NGW; float s = 0.f;
#pragma unroll
            for (int j = 0; j < 4; ++j) s += (v[u][j].x * v[u][j].x + v[u][j].y * v[u][j].y) + (v[u][j].z * v[u][j].z + v[u][j].w * v[u][j].w);
            s = wave_sum(s);
            if (ok[u]) { if (C.lane == 0) rstd[m] = 1.0f / sqrtf(s * (1.f / 1024.f) + EPS);
                u64* o8 = (u64*)dst[u] + C.lane;
#pragma unroll
                for (int j = 0; j < 4; ++j) o8[64 * j] = (u64)cvt_pk_bf16(v[u][j].x, v[u][j].y) | ((u64)cvt_pk_bf16(v[u][j].z, v[u][j].w) << 32); } }
    }
    const int gt = C.bid * NTHREADS + C.tid, NGT = C.G * NTHREADS;
    float* cosT = (float*)(C.ws + WS_COS); float* sinT = (float*)(C.ws + WS_SIN);
    for (int i = gt; i < SEQ * 32; i += NGT) {
        const int pos = i >> 5, d = i & 31;
        const float inv = expf((float)d * (float)(-2.0 * 9.210340371976184 / 64.0));
        const float ang = (float)pos * inv;
        float sn, cs; sincos_d((double)ang, sn, cs); cosT[i] = cs; sinT[i] = sn;
    }
}

__device__ __forceinline__ void ph2_memprep(const Ctx& C) {
    const int gt = C.bid * NTHREADS + C.tid, NGT = C.G * NTHREADS;
    const float* ssk = (const float*)(C.ws + ACC_SSK); float* mk = C.out + OFF_MK_P; const float* mv = C.out + OFF_MV_P;
    bf16_t* mkF = (bf16_t*)(C.ws + WS_MKF); bf16_t* mvF = (bf16_t*)(C.ws + WS_MVF);
    for (int c = gt; c < 65536; c += NGT) {
        const int lane = c & 63, ks = (c >> 6) & 15, mb = (c >> 10) & 7, h = (c >> 13) & 3, b = c >> 15; const int r32 = lane & 31, hi = lane >> 5;
        const int r = b * 256 + 32 * mb + r32, d0 = 16 * ks + 8 * hi;
        const float rn = 1.0f / sqrtf(ssk[r * 4 + h] * (1.f / 256.f) + EPS);
        float v[8], g[8]; float* p = mk + (size_t)r * 1024 + h * 256 + d0; load8_f32(p, v); load8_f32(C.mk_g + d0, g);
#pragma unroll
        for (int e = 0; e < 8; ++e) v[e] = v[e] * rn * g[e];
        store8_f32(p, v); store8_bf16(mkF + (size_t)c * 8, v);
    }
    for (int c = gt; c < 65536; c += NGT) {
        const int lane = c & 63, s = (c >> 6) & 1, mb = (c >> 7) & 7, db = (c >> 10) & 7, h = (c >> 13) & 3, b = c >> 15; const int r32 = lane & 31, hi = lane >> 5;
        float v[8];
#pragma unroll
        for (int j = 0; j < 8; ++j) { const int m = 32 * mb + 16 * s + 8 * (j >> 2) + 4 * hi + (j & 3); v[j] = mv[(size_t)(b * 256 + m) * 1024 + h * 256 + 32 * db + r32]; }
        store8_bf16(mvF + (size_t)c * 8, v);
    }
}
__device__ __forceinline__ void score_unit_prompt(const Ctx& C, int b, int g, unsigned char* lds) {
    const int lane = fresh_lane(), tid = C.wave * 64 + lane, r32 = lane & 31, hi = lane >> 5;
    const bf16_t* qib = (const bf16_t*)(C.ws + WS_QI); const bf16_t* kib = (const bf16_t*)(C.ws + WS_KI);
#pragma unroll
    for (int j = 0; j < 4; ++j) { const int id = tid + 512 * j, c = id >> 5, r = id & 31;
        *(u32x4*)(lds + id * 16) = *(const u32x4*)(qib + (size_t)(b * SEQ + 32 * g + r) * 512 + c * 8); }
    __syncthreads();
    const int qrow0 = b * SEQ + 32 * g;
    float w[8]; load8_f32((const float*)(C.ws + WS_IW) + (size_t)(qrow0 + r32) * 8, w);
    float* stg = (float*)(lds + 32768 + C.wave * 8704);
    float* sout = (float*)(C.ws + WS_SC) + (size_t)(qrow0 + (lane >> 4)) * SEQ + (lane & 15) * 4;
    const int nt = (g >> 1) + 1;
    const int ntp = ((32 * g + 32 + 511) >> 9) << 3;
    const int tq = 32 * g + r32;
    const unsigned char* qbase = lds + hi * 512 + r32 * 16;
    const unsigned qaddr = (unsigned)(uintptr_t)qbase;
    const bf16_t* kp0 = kib + (size_t)(b * SEQ + r32) * 64 + hi * 8;
    bf16x8 kf[4][2];
    { const bf16_t* kp = kp0 + (size_t)((C.wave < nt) ? C.wave : 0) * 4096;
#pragma unroll
      for (int d0 = 0; d0 < 4; ++d0) { kf[d0][0] = *(const bf16x8*)(kp + d0 * 16); kf[d0][1] = *(const bf16x8*)(kp + 32 * 64 + d0 * 16); } }
    for (int kt = C.wave; kt < ntp; kt += NWAVES) {
        bf16x8 kn[4][2];
        { const bf16_t* kp = kp0 + (size_t)((kt + NWAVES < nt) ? kt + NWAVES : kt) * 4096;
#pragma unroll
          for (int d0 = 0; d0 < 4; ++d0) { kn[d0][0] = *(const bf16x8*)(kp + d0 * 16); kn[d0][1] = *(const bf16x8*)(kp + 32 * 64 + d0 * 16); } }
        float a0[16], a1[16];
#pragma unroll
        for (int r = 0; r < 16; ++r) { a0[r] = 0.f; a1[r] = 0.f; }
        if (kt < nt) {
        bf16x8 qn[4];
#define QREAD(dst, h_) do { _Pragma("unroll") for (int d0 = 0; d0 < 4; ++d0) asm volatile("ds_read_b128 %0, %1 offset:%c2" : "=v"(dst[d0]) : "v"(qaddr), "i"(((h_) * 8 + d0 * 2) * 512)); } while (0)
        QREAD(qn, 0);
#pragma unroll
        for (int h = 0; h < 8; ++h) {
            bf16x8 qf[4];
            asm volatile("s_waitcnt lgkmcnt(0)" : "+v"(qn[0]), "+v"(qn[1]), "+v"(qn[2]), "+v"(qn[3]));
#pragma unroll
            for (int d0 = 0; d0 < 4; ++d0) qf[d0] = qn[d0];
            if (h < 7) QREAD(qn, h + 1);
            f32x16 p = {};
#pragma unroll
            for (int d0 = 0; d0 < 4; ++d0) p = __builtin_amdgcn_mfma_f32_32x32x16_bf16(kf[d0][0], qf[d0], p, 0, 0, 0);
#pragma unroll
            for (int r = 0; r < 16; ++r) a0[r] = __builtin_fmaf(w[h], __builtin_amdgcn_fmed3f(p[r], 0.f, 3.0e38f), a0[r]);
            f32x16 p2 = {};
#pragma unroll
            for (int d0 = 0; d0 < 4; ++d0) p2 = __builtin_amdgcn_mfma_f32_32x32x16_bf16(kf[d0][1], qf[d0], p2, 0, 0, 0);
#pragma unroll
            for (int r = 0; r < 16; ++r) a1[r] = __builtin_fmaf(w[h], __builtin_amdgcn_fmed3f(p2[r], 0.f, 3.0e38f), a1[r]);
#pragma unroll
            for (int r = 0; r < 16; ++r) { asm volatile("" : "+v"(a0[r])); asm volatile("" : "+v"(a1[r])); }
        }
        }
        if (kt * 64 + 63 > 32 * g) {
#pragma unroll
            for (int r = 0; r < 16; ++r) { const int key = kt * 64 + (r & 3) + 8 * (r >> 2) + 4 * hi; if (key > tq) a0[r] = -INFINITY; if (key + 32 > tq) a1[r] = -INFINITY; }
        }
#pragma unroll
        for (int r = 0; r < 16; ++r) { const unsigned u0 = __float_as_uint(a0[r]), u1 = __float_as_uint(a1[r]);
            a0[r] = __uint_as_float(u0 ^ ((unsigned)((int)u0 >> 31) | 0x80000000u)); a1[r] = __uint_as_float(u1 ^ ((unsigned)((int)u1 >> 31) | 0x80000000u)); }
#pragma unroll
        for (int rq = 0; rq < 4; ++rq) {
            *(f32x4*)(stg + r32 * 68 + 8 * rq + 4 * hi) = (f32x4){a0[4 * rq], a0[4 * rq + 1], a0[4 * rq + 2], a0[4 * rq + 3]};
            *(f32x4*)(stg + r32 * 68 + 32 + 8 * rq + 4 * hi) = (f32x4){a1[4 * rq], a1[4 * rq + 1], a1[4 * rq + 2], a1[4 * rq + 3]};
        }
#pragma unroll
        for (int i = 0; i < 8; ++i) { const f32x4 v = *(const f32x4*)(stg + (i * 4 + (lane >> 4)) * 68 + (lane & 15) * 4); *(f32x4*)(sout + (size_t)(i * 4) * SEQ + kt * 64) = v; }
#pragma unroll
        for (int d0 = 0; d0 < 4; ++d0) { kf[d0][0] = kn[d0][0]; kf[d0][1] = kn[d0][1]; }
    }
    asm volatile("s_waitcnt vmcnt(0)" ::: "memory");
    __syncthreads();
}
__device__ __forceinline__ float dpp_sum8s(float x) {
    x += __builtin_bit_cast(float, __builtin_amdgcn_update_dpp(0, __builtin_bit_cast(int, x), 0xB1, 0xF, 0xF, true));
    x += __builtin_bit_cast(float, __builtin_amdgcn_update_dpp(0, __builtin_bit_cast(int, x), 0x4E, 0xF, 0xF, true));
    x += __builtin_bit_cast(float, __builtin_amdgcn_update_dpp(0, __builtin_bit_cast(int, x), 0x141, 0xF, 0xF, true));
    return x;
}
__device__ __forceinline__ void score_unit_sample(const Ctx& C, int b, int c) {
    const int lane = fresh_lane(), r32 = lane & 31, hi = lane >> 5;
    const bf16_t* qib = (const bf16_t*)(C.ws + WS_QI);
    bf16x8 qf[2][4]; float w2[2];
#pragma unroll
    for (int nb = 0; nb < 2; ++nb) { const int row = MP + b * DS + 4 * nb + (r32 >> 3), h = r32 & 7;
        w2[nb] = ((const float*)(C.ws + WS_IW))[(size_t)row * 8 + h];
#pragma unroll
        for (int d0 = 0; d0 < 4; ++d0) qf[nb][d0] = *(const bf16x8*)(qib + (size_t)row * 512 + h * 64 + d0 * 16 + hi * 8); }
    const int kb0 = 4 * c, kb1 = (c == 15) ? 65 : 4 * c + 4;
    float* scs = (float*)(C.ws + WS_SCS) + (size_t)(b * DS) * SPITCH;
#define SKP(kb_) (((kb_) < 64) ? (C.cache_ik + ((size_t)C.page_table[b * NPAGES + ((kb_) >> 2)] * PAGE + ((kb_) & 3) * 32 + r32) * 64 + 8 * hi) : (C.out + OFF_IK_S + (size_t)(b * DS + (r32 & 7)) * 64 + 8 * hi))
    f32x4 kr[4][2];
    { const float* kp = SKP(kb0);
#pragma unroll
      for (int d0 = 0; d0 < 4; ++d0) { kr[d0][0] = *(const f32x4*)(kp + 16 * d0); kr[d0][1] = *(const f32x4*)(kp + 16 * d0 + 4); } }
    for (int kb = kb0; kb < kb1; ++kb) {
        f32x4 kn[4][2];
        { const int kbn = (kb + 1 < kb1) ? kb + 1 : kb; const float* kp = SKP(kbn);
#pragma unroll
          for (int d0 = 0; d0 < 4; ++d0) { kn[d0][0] = *(const f32x4*)(kp + 16 * d0); kn[d0][1] = *(const f32x4*)(kp + 16 * d0 + 4); } }
        bf16x8 kf[4];
#pragma unroll
        for (int d0 = 0; d0 < 4; ++d0) {
            const u32x4 pk = (u32x4){cvt_pk_bf16(kr[d0][0].x, kr[d0][0].y), cvt_pk_bf16(kr[d0][0].z, kr[d0][0].w), cvt_pk_bf16(kr[d0][1].x, kr[d0][1].y), cvt_pk_bf16(kr[d0][1].z, kr[d0][1].w)}; kf[d0] = __builtin_bit_cast(bf16x8, pk); }
#pragma unroll
        for (int nb = 0; nb < 2; ++nb) {
            f32x16 D = {};
#pragma unroll
            for (int d0 = 0; d0 < 4; ++d0) D = __builtin_amdgcn_mfma_f32_32x32x16_bf16(kf[d0], qf[nb][d0], D, 0, 0, 0);
            float s[16];
#pragma unroll
            for (int r = 0; r < 16; ++r) s[r] = dpp_sum8s(w2[nb] * __builtin_amdgcn_fmed3f(D[r], 0.f, 3.0e38f));
            if ((r32 & 7) == 0) {
                float* dst = scs + (size_t)(4 * nb + (r32 >> 3)) * SPITCH + 32 * kb + 4 * hi;
#pragma unroll
                for (int rq = 0; rq < 4; ++rq) if (32 * kb + 8 * rq + 4 * hi < PAST + DS) *(f32x4*)(dst + 8 * rq) = (f32x4){s[4 * rq], s[4 * rq + 1], s[4 * rq + 2], s[4 * rq + 3]};
            }
        }
#pragma unroll
        for (int d0 = 0; d0 < 4; ++d0) { kr[d0][0] = kn[d0][0]; kr[d0][1] = kn[d0][1]; }
    }
#undef SKP
}
__device__ __forceinline__ int mask_col(int lane) { const int p = lane >> 5, k5 = lane & 31, hi = (k5 >> 2) & 1, r = (k5 & 3) | ((k5 >> 3) << 2); return (p * 16 + r) * 2 + hi; }
template <int NI, int SHIFT, int BITS, int PSHIFT>
__device__ __forceinline__ void radix_pass(const unsigned (&v)[NI], int n, unsigned prefix, unsigned* hist, int lane, unsigned& bin_out, int& k) {
    constexpr int NBINS = 1 << BITS, BPL = NBINS / 64;
    lane = fresh_lane();
#pragma unroll
    for (int j = 0; j < BPL; ++j) hist[j * 64 + lane] = 0u;
    LDS_WAIT();
    int nn = n; asm volatile("" : "+s"(nn));
#pragma unroll
    for (int c = 0; c < NI / 8; ++c) if (c * 512 < nn) {
#pragma unroll
        for (int j = 0; j < 8; ++j) { const int i = c * 8 + j;
            const bool match = (PSHIFT >= 32) ? true : ((v[i] >> (PSHIFT & 31)) == prefix);
            if (match && (lane < nn - i * 64)) atomicAdd(&hist[(v[i] >> SHIFT) & (NBINS - 1)], 1u); }
    }
    LDS_WAIT();
    unsigned cnt = 0u;
    { constexpr int NSL = BPL / 4; const u32x4* hp = (const u32x4*)(hist + BPL * lane); const int f = (lane / (16 / NSL)) & (NSL - 1);
#pragma unroll
      for (int j = 0; j < NSL; ++j) { const u32x4 h = hp[j ^ f]; cnt += (h.x + h.y) + (h.z + h.w); } }
    unsigned S = cnt;
#pragma unroll
    for (int off = 1; off < 64; off <<= 1) { const unsigned t = __shfl_down(S, off); if (lane + off < 64) S += t; }
    const u64 bal = __ballot(S >= (unsigned)k);
    const int Ls = bal ? (63 - __clzll(bal)) : 0;
    const unsigned Sn = __shfl(S, (Ls + 1) & 63); const unsigned above = (Ls < 63) ? Sn : 0u;
    const unsigned hj = hist[BPL * Ls + (lane & (BPL - 1))];
    unsigned T = (lane < BPL) ? hj : 0u;
#pragma unroll
    for (int off = 1; off < BPL; off <<= 1) { const unsigned t = __shfl_down(T, off); if (lane + off < BPL) T += t; }
    const u64 bal2 = __ballot((lane < BPL) && (above + T >= (unsigned)k));
    const int js = bal2 ? (63 - __clzll(bal2)) : 0;
    const unsigned Tj = __shfl(T, js), hjs = __shfl(hj, js);
    LDS_WAIT();
    bin_out = (unsigned)(BPL * Ls + js); k = k - (int)(above + Tj - hjs);
}
template <int NI, bool MASK> __device__ __forceinline__ void select_row(const float* sc, int n, int* list, unsigned* hist, int lane, unsigned* maskw, int qbit) {
    lane = fresh_lane();
    if (n <= TOPK) {
#pragma unroll
        for (int i = 0; i < 4; ++i) { const int s = i * 64 + lane; if (s < n) { if (MASK) atomicOr(&maskw[i * 64 + mask_col(lane)], 1u << qbit); else list[s] = s; } }
        return;
    }
    unsigned v[NI];
    {
        lane = fresh_lane();
        int nn = n; asm volatile("" : "+s"(nn));
        const float* scl = sc + lane;
#pragma unroll
        for (int c = 0; c < NI / 16; ++c) {
            if (c * 1024 < nn) {
#pragma unroll
                for (int j = 0; j < 16; ++j) { const int i = c * 16 + j; v[i] = __float_as_uint(scl[(lane < nn - i * 64) ? i * 64 : 0]); }
            } else {
#pragma unroll
                for (int j = 0; j < 16; ++j) v[c * 16 + j] = 0u;
            }
        }
#pragma unroll
        for (int c = 0; c < NI / 16; ++c) {
            if (c * 1024 < nn) {
#pragma unroll
                for (int j = 0; j < 16; ++j) { const int i = c * 16 + j; const unsigned u = v[i]; const unsigned key = (u & 0x80000000u) ? ~u : (u | 0x80000000u); v[i] = (lane < nn - i * 64) ? key : 0u; }
            }
        }
    }
    int k = TOPK; unsigned b1, b2, b3;
    radix_pass<NI, 21, 11, 32>(v, n, 0u, hist, lane, b1, k);
    radix_pass<NI, 10, 11, 21>(v, n, b1, hist, lane, b2, k);
    radix_pass<NI, 0, 10, 10>(v, n, (b1 << 11) | b2, hist, lane, b3, k);
    const unsigned tau = (b1 << 21) | (b2 << 10) | b3;
    lane = fresh_lane();
    int nn = n; asm volatile("" : "+s"(nn));
    int base = 0, eqc = 0; const u64 ltmask = (1ull << lane) - 1ull; const int mcol = mask_col(lane);
#pragma unroll
    for (int c = 0; c < NI / 8; ++c) if (c * 512 < nn) {
#pragma unroll
        for (int j = 0; j < 8; ++j) { const int i = c * 8 + j;
            const bool inb = (lane < nn - i * 64); const bool gt = inb && (v[i] > tau), eq = inb && (v[i] == tau);
            const u64 eqb = __ballot(eq); const int erank = eqc + __popcll(eqb & ltmask);
            const bool take = gt || (eq && erank < k); eqc += __popcll(eqb);
            const u64 tb = __ballot(take); const int pos = base + __popcll(tb & ltmask);
            if (take && pos < TOPK) { if (MASK) atomicOr(&maskw[i * 64 + mcol], 1u << qbit); else list[pos] = i * 64 + lane; }
            base += __popcll(tb); }
    }
}
template <int NI, int SHIFT, int BITS, int PSHIFT>
__device__ __forceinline__ void radix_pass_p(const unsigned (&v)[NI], int nch, unsigned prefix, unsigned* hist, int lane, unsigned& bin_out, int& k, int& hcnt) {
    constexpr int NBINS = 1 << BITS, BPL = NBINS / 64;
    lane = fresh_lane();
#pragma unroll
    for (int j = 0; j < BPL; ++j) hist[j * 64 + lane] = 0u;
    LDS_WAIT();
    int nc = nch; asm volatile("" : "+s"(nc));
#pragma unroll
    for (int c = 0; c < NI / 8; ++c) if (c < nc) {
#pragma unroll
        for (int j = 0; j < 8; ++j) { const int i = c * 8 + j;
            if (PSHIFT >= 32) atomicAdd(&hist[(v[i] >> SHIFT) & (NBINS - 1)], 1u);
            else if ((v[i] >> (PSHIFT & 31)) == prefix) atomicAdd(&hist[(v[i] >> SHIFT) & (NBINS - 1)], 1u); }
    }
    if (PROBE_DUP == 33 && PSHIFT >= 32) {
#pragma unroll
        for (int c = 0; c < NI / 8; ++c) if (c < nc) {
#pragma unroll
            for (int j = 0; j < 8; ++j) { const int i = c * 8 + j; atomicSub(&hist[(v[i] >> SHIFT) & (NBINS - 1)], 1u); }
        }
#pragma unroll
        for (int c = 0; c < NI / 8; ++c) if (c < nc) {
#pragma unroll
            for (int j = 0; j < 8; ++j) { const int i = c * 8 + j; atomicAdd(&hist[(v[i] >> SHIFT) & (NBINS - 1)], 1u); }
        }
    }
    LDS_WAIT();
    unsigned cnt = 0u;
    { constexpr int NSL = BPL / 4; const u32x4* hp = (const u32x4*)(hist + BPL * lane); const int f = (lane / (16 / NSL)) & (NSL - 1);
#pragma unroll
      for (int j = 0; j < NSL; ++j) { const u32x4 h = hp[j ^ f]; cnt += (h.x + h.y) + (h.z + h.w); } }
    unsigned S = cnt;
#pragma unroll
    for (int off = 1; off < 64; off <<= 1) { const unsigned t = __shfl_down(S, off); if (lane + off < 64) S += t; }
    const u64 bal = __ballot(S >= (unsigned)k);
    const int Ls = bal ? (63 - __clzll(bal)) : 0;
    const unsigned Sn = __shfl(S, (Ls + 1) & 63); const unsigned above = (Ls < 63) ? Sn : 0u;
    const unsigned hj = hist[BPL * Ls + (lane & (BPL - 1))];
    unsigned T = (lane < BPL) ? hj : 0u;
#pragma unroll
    for (int off = 1; off < BPL; off <<= 1) { const unsigned t = __shfl_down(T, off); if (lane + off < BPL) T += t; }
    const u64 bal2 = __ballot((lane < BPL) && (above + T >= (unsigned)k));
    const int js = bal2 ? (63 - __clzll(bal2)) : 0;
    const unsigned Tj = __shfl(T, js), hjs = __shfl(hj, js);
    LDS_WAIT();
    bin_out = (unsigned)(BPL * Ls + js); hcnt = (int)hjs; k = k - (int)(above + Tj - hjs);
}
template <int NI> __device__ __forceinline__ void select_row_p(const float* sc, int n, unsigned* hist, unsigned* maskw, int qbit) {
    int lane = fresh_lane();
    if (n <= TOPK) {
#pragma unroll
        for (int i = 0; i < 4; ++i) { const int s = i * 64 + lane; if (s < n) atomicOr(&maskw[i * 64 + mask_col(lane)], 1u << qbit); }
        return;
    }
    const int nch = (n + 511) >> 9;
    unsigned v[NI];
    {
        int nc = nch; asm volatile("" : "+s"(nc));
        const float* scl = sc + lane;
#pragma unroll
        for (int c = 0; c < NI / 8; ++c) {
            if (c < nc) {
#pragma unroll
                for (int j = 0; j < 8; ++j) { const int i = c * 8 + j; v[i] = __float_as_uint(scl[i * 64]); }
            } else {
#pragma unroll
                for (int j = 0; j < 8; ++j) v[c * 8 + j] = 0u;
            }
        }
    }
    int k = TOPK, hc = 0; unsigned b1, b2 = 0u, b3 = 0u; unsigned tau; bool exact;
    radix_pass_p<NI, 21, 11, 32>(v, nch, 0u, hist, lane, b1, k, hc);
    tau = b1 << 21; exact = (hc == k);
    if (!exact) {
        radix_pass_p<NI, 10, 11, 21>(v, nch, b1, hist, lane, b2, k, hc);
        tau = (b1 << 21) | (b2 << 10); exact = (hc == k);
        if (!exact) { radix_pass_p<NI, 0, 10, 10>(v, nch, (b1 << 11) | b2, hist, lane, b3, k, hc); tau = (b1 << 21) | (b2 << 10) | b3; exact = (hc == k); }
    }
    lane = fresh_lane();
    int nc = nch; asm volatile("" : "+s"(nc));
    const int mcol = mask_col(lane);
    if (exact) {
#pragma unroll
        for (int c = 0; c < NI / 8; ++c) if (c < nc) {
#pragma unroll
            for (int j = 0; j < 8; ++j) { const int i = c * 8 + j; if (v[i] >= tau) atomicOr(&maskw[i * 64 + mcol], 1u << qbit); }
        }
    } else {
        int eqc = 0; const u64 ltmask = (1ull << lane) - 1ull;
#pragma unroll
        for (int c = 0; c < NI / 8; ++c) if (c < nc) {
#pragma unroll
            for (int j = 0; j < 8; ++j) { const int i = c * 8 + j;
                const bool gt = v[i] > tau, eq = v[i] == tau;
                const u64 eqb = __ballot(eq); const int erank = eqc + __popcll(eqb & ltmask); eqc += __popcll(eqb);
                if (gt || (eq && erank < k)) atomicOr(&maskw[i * 64 + mcol], 1u << qbit); }
        }
    }
}
__device__ __forceinline__ void select_group_prompt(const Ctx& C, int b, int g, unsigned char* lds) {
    unsigned* hist = (unsigned*)lds + C.wave * 2048; unsigned* maskw = (unsigned*)(lds + 65536);
    { const int tid0 = C.wave * 64 + fresh_lane();
#pragma unroll
      for (int j = 0; j < 16; ++j) maskw[tid0 + 512 * j] = 0u; }
    __syncthreads();
#pragma unroll 1
    for (int j = 0; j < 4; ++j) {
        const int q = C.wave + 8 * j, t = 32 * g + q, ru = b * SEQ + t;
        select_row_p<128>((const float*)(C.ws + WS_SC) + (size_t)ru * SEQ, t + 1, hist, maskw, q);
    }
    __syncthreads();
    const int ntile = 4 * ((g >> 3) + 1);
    u32x4* dst = (u32x4*)((u64*)(C.ws + WS_MASK) + (size_t)(b * 256 + g) * (128 * 32));
    for (int i = C.wave * 64 + fresh_lane(); i < ntile * 16; i += NTHREADS) dst[i] = *(const u32x4*)(maskw + 4 * i);
    __syncthreads();
}
constexpr int CONV_CHUNK = 4096, NCONV = (MT * 64 + CONV_CHUNK - 1) / CONV_CHUNK;
__device__ __forceinline__ void conv_mix_branch(const Ctx& C, int chunk) {
    const int tid2 = C.wave * 64 + fresh_lane();
    const int gt = chunk * CONV_CHUNK + tid2, NGT = NTHREADS, itEnd = (chunk + 1) * CONV_CHUNK;
    const bf16_t* ub = (const bf16_t*)(C.ws + WS_U); const bf16_t* cbb = (const bf16_t*)(C.ws + WS_CB); bf16_t* amix = (bf16_t*)(C.ws + WS_AMIX);
    for (int it0 = gt; it0 < itEnd; it0 += 4 * NGT) {
        u32x4 ru0[4], rp1[4], rp2[4], rcb[4]; f32x4 fp1[4][2], fp2[4][2]; bool ok[4], s1[4], s2[4];
#pragma unroll
        for (int q = 0; q < 4; ++q) { const int it = it0 + q * NGT; ok[q] = it < MT * 64; const int itc = ok[q] ? it : 0; const int r = itc >> 6, c = (itc & 63) * 8;
            ru0[q] = *(const u32x4*)(ub + (size_t)r * 512 + c); rcb[q] = *(const u32x4*)(cbb + (size_t)r * 512 + c);
            int t; bool smp = r >= MP; int b = 0;
            if (!smp) t = r & (SEQ - 1); else { const int rl = r - MP; b = rl >> 3; t = rl & 7; }
            s1[q] = smp && t < 1; s2[q] = smp && t < 2;
            rp1[q] = (t >= 1) ? *(const u32x4*)(ub + (size_t)(r - 1) * 512 + c) : (u32x4){0u, 0u, 0u, 0u};
            rp2[q] = (t >= 2) ? *(const u32x4*)(ub + (size_t)(r - 2) * 512 + c) : (u32x4){0u, 0u, 0u, 0u};
            if (s1[q]) { const float* sp = C.st_mix + (size_t)(b * 2 + 1) * 512 + c; fp1[q][0] = *(const f32x4*)sp; fp1[q][1] = *(const f32x4*)(sp + 4); }
            if (s2[q]) { const float* sp = C.st_mix + (size_t)(b * 2 + t) * 512 + c; fp2[q][0] = *(const f32x4*)sp; fp2[q][1] = *(const f32x4*)(sp + 4); } }
#pragma unroll
        for (int q = 0; q < 4; ++q) if (ok[q]) { const int it = it0 + q * NGT; const int r = it >> 6, c = (it & 63) * 8;
            float u0[8], p1[8], p2[8], cb[8], w0[8], w1[8], w2[8], y[8];
            const u32x4 a = ru0[q], bq = rcb[q], c1 = rp1[q], c2 = rp2[q];
            u0[0] = bf2f(a.x & 0xffffu); u0[1] = bf2f(a.x >> 16); u0[2] = bf2f(a.y & 0xffffu); u0[3] = bf2f(a.y >> 16); u0[4] = bf2f(a.z & 0xffffu); u0[5] = bf2f(a.z >> 16); u0[6] = bf2f(a.w & 0xffffu); u0[7] = bf2f(a.w >> 16);
            cb[0] = bf2f(bq.x & 0xffffu); cb[1] = bf2f(bq.x >> 16); cb[2] = bf2f(bq.y & 0xffffu); cb[3] = bf2f(bq.y >> 16); cb[4] = bf2f(bq.z & 0xffffu); cb[5] = bf2f(bq.z >> 16); cb[6] = bf2f(bq.w & 0xffffu); cb[7] = bf2f(bq.w >> 16);
            p1[0] = bf2f(c1.x & 0xffffu); p1[1] = bf2f(c1.x >> 16); p1[2] = bf2f(c1.y & 0xffffu); p1[3] = bf2f(c1.y >> 16); p1[4] = bf2f(c1.z & 0xffffu); p1[5] = bf2f(c1.z >> 16); p1[6] = bf2f(c1.w & 0xffffu); p1[7] = bf2f(c1.w >> 16);
            p2[0] = bf2f(c2.x & 0xffffu); p2[1] = bf2f(c2.x >> 16); p2[2] = bf2f(c2.y & 0xffffu); p2[3] = bf2f(c2.y >> 16); p2[4] = bf2f(c2.z & 0xffffu); p2[5] = bf2f(c2.z >> 16); p2[6] = bf2f(c2.w & 0xffffu); p2[7] = bf2f(c2.w >> 16);
            if (s1[q]) { p1[0] = fp1[q][0].x; p1[1] = fp1[q][0].y; p1[2] = fp1[q][0].z; p1[3] = fp1[q][0].w; p1[4] = fp1[q][1].x; p1[5] = fp1[q][1].y; p1[6] = fp1[q][1].z; p1[7] = fp1[q][1].w; }
            if (s2[q]) { p2[0] = fp2[q][0].x; p2[1] = fp2[q][0].y; p2[2] = fp2[q][0].z; p2[3] = fp2[q][0].w; p2[4] = fp2[q][1].x; p2[5] = fp2[q][1].y; p2[6] = fp2[q][1].z; p2[7] = fp2[q][1].w; }
            load8_f32(C.conv_mix_w + c, w0); load8_f32(C.conv_mix_w + 512 + c, w1); load8_f32(C.conv_mix_w + 1024 + c, w2);
#pragma unroll
            for (int e2 = 0; e2 < 8; ++e2) y[e2] = cb[e2] * (w0[e2] * p2[e2] + w1[e2] * p1[e2] + w2[e2] * u0[e2]);
            store8_bf16(amix + (size_t)r * 1024 + c, y); }
    }
}

__device__ __forceinline__ int queue_pop(unsigned* q, volatile LAS unsigned* slot) {
    __syncthreads();
    if (threadIdx.x == 0) *slot = xb_add(q, 1u);
    __syncthreads();
    return __builtin_amdgcn_readfirstlane((int)*slot);
}
__device__ __forceinline__ void ph2_scores_select(const Ctx& C, unsigned char* lds, unsigned* q, volatile LAS unsigned* slot) {
    for (;;) {
        const int it = queue_pop(q, slot);
        if (it >= DB + 512 + NCONV) break;
        if (it < DB) {
            const int bt = it;
            score_unit_sample(C, bt, 2 * C.wave); score_unit_sample(C, bt, 2 * C.wave + 1);
            asm volatile("s_waitcnt vmcnt(0)" ::: "memory");
            __syncthreads();
            const int rl = bt * DS + C.wave;
            select_row<48, false>((const float*)(C.ws + WS_SCS) + (size_t)rl * SPITCH, PAST + C.wave + 1, (int*)(C.ws + WS_SEL) + (size_t)(MP + rl) * TOPK, (unsigned*)lds + C.wave * 2048, 0, nullptr, 0);
        } else if (it < DB + 512) {
            const int j = it - DB, b = j & 1, g = 255 - (j >> 1);
            score_unit_prompt(C, b, g, lds); if (PROBE_DUP == 12) score_unit_prompt(C, b, g, lds);
            select_group_prompt(C, b, g, lds); if (PROBE_DUP == 13) select_group_prompt(C, b, g, lds);
        } else conv_mix_branch(C, it - DB - 512);
    }
}

template <bool SAMP> __device__ __forceinline__ void attn_gather_row(const Ctx& C, int r, int lane) {
    const int rl = SAMP ? r - MP : r; const int b = SAMP ? (rl >> 3) : (rl >> 13);
    const int n = SAMP ? PAST + (rl & 7) + 1 : (rl & (SEQ - 1)) + 1; const int cnt = n < TOPK ? n : TOPK;
    const int* __restrict__ list = (const int*)(C.ws + WS_SEL) + (size_t)r * TOPK;
    float q[8]; load8_bf16((const bf16_t*)(C.ws + WS_Q) + (size_t)r * 512 + lane * 8, q);
    float mrun = -INFINITY, l = 0.f, o[8];
#pragma unroll
    for (int e = 0; e < 8; ++e) o[e] = 0.f;
    for (int j0 = 0; j0 < cnt; j0 += 4) {
        float kk[4][8], vv[4][8];
#pragma unroll
        for (int u = 0; u < 4; ++u) {
            const int j = (j0 + u < cnt) ? j0 + u : j0; const int s = list[j];
            if (SAMP) {
                const float *kp, *vp;
                if (s < PAST) { const size_t ro = ((size_t)C.page_table[b * NPAGES + (s >> 7)] * PAGE + (s & (PAGE - 1))) * 512 + lane * 8; kp = C.cache_k + ro; vp = C.cache_v + ro; }
                else { const size_t ro = (size_t)(b * DS + (s - PAST)) * 512 + lane * 8; kp = C.out + OFF_K_S + ro; vp = C.out + OFF_V_S + ro; }
                load8_f32(kp, kk[u]); load8_f32(vp, vv[u]);
            } else {
                const size_t ro = (size_t)(b * SEQ + s) * 512 + lane * 8;
                load8_bf16((const bf16_t*)(C.ws + WS_K) + ro, kk[u]); load8_bf16((const bf16_t*)(C.ws + WS_V) + ro, vv[u]);
            }
        }
#pragma unroll
        for (int u = 0; u < 4; ++u) if (j0 + u < cnt) {
            float d = 0.f;
#pragma unroll
            for (int e = 0; e < 8; ++e) d = fmaf(q[e], kk[u][e], d);
            d += __shfl_xor(d, 1); d += __shfl_xor(d, 2); d += __shfl_xor(d, 4);
            const float mn = fmaxf(mrun, d); const float corr = __builtin_amdgcn_exp2f(mrun - mn), p = __builtin_amdgcn_exp2f(d - mn);
            l = l * corr + p;
#pragma unroll
            for (int e = 0; e < 8; ++e) o[e] = o[e] * corr + p * vv[u][e];
            mrun = mn;
        }
    }
    const float il = 1.0f / l;
#pragma unroll
    for (int e = 0; e < 8; ++e) o[e] *= il;
    store8_bf16((bf16_t*)(C.ws + WS_AMIX) + (size_t)r * 1024 + 512 + lane * 8, o);
}
__device__ __forceinline__ float dpp_sum8(float x) {
    x += __builtin_bit_cast(float, __builtin_amdgcn_update_dpp(0, __builtin_bit_cast(int, x), 0xB1, 0xF, 0xF, true));
    x += __builtin_bit_cast(float, __builtin_amdgcn_update_dpp(0, __builtin_bit_cast(int, x), 0x4E, 0xF, 0xF, true));
    x += __builtin_bit_cast(float, __builtin_amdgcn_update_dpp(0, __builtin_bit_cast(int, x), 0x141, 0xF, 0xF, true));
    return x;
}
__device__ __forceinline__ void gather_half(const Ctx& C, int r, int hf, int lane, float* part) {
    const int rl = r - MP, b = rl >> 3;
    const int* list = (const int*)(C.ws + WS_SEL) + (size_t)r * TOPK + 128 * hf;
    int rowid[2];
#pragma unroll
    for (int c = 0; c < 2; ++c) { const int s = list[64 * c + lane];
        rowid[c] = (s < PAST) ? (C.page_table[b * NPAGES + (s >> 7)] * PAGE + (s & (PAGE - 1))) : (0x40000000 | (b * DS + (s - PAST))); }
    float q[8]; load8_bf16((const bf16_t*)(C.ws + WS_Q) + (size_t)r * 512 + lane * 8, q);
    float mrun = -1e30f, l = 0.f, o[8];
#pragma unroll
    for (int e = 0; e < 8; ++e) o[e] = 0.f;
    const float* newK = C.out + OFF_K_S; const float* newV = C.out + OFF_V_S;
#define G_LOAD(KK, VV, c_, j_) do { _Pragma("unroll") for (int u = 0; u < 4; ++u) { \
        const int id = __builtin_amdgcn_readlane(rowid[c_], (j_) + u); const bool isnew = (id >> 30) != 0; const size_t ro = (size_t)(id & 0x3FFFFFFF) * 512; \
        const float* kp = (isnew ? newK : C.cache_k) + ro + lane * 8; const float* vp = (isnew ? newV : C.cache_v) + ro + lane * 8; \
        load8_f32(kp, KK[u]); load8_f32(vp, VV[u]); } } while (0)
#define G_FOLD(KK, VV) do { float d[4]; float mx = mrun; \
        _Pragma("unroll") for (int u = 0; u < 4; ++u) { float t = 0.f; _Pragma("unroll") for (int e = 0; e < 8; ++e) t = fmaf(q[e], KK[u][e], t); d[u] = dpp_sum8(t); mx = fmaxf(mx, d[u]); } \
        const float corr = __builtin_amdgcn_exp2f(mrun - mx); l *= corr; \
        _Pragma("unroll") for (int e = 0; e < 8; ++e) o[e] *= corr; \
        _Pragma("unroll") for (int u = 0; u < 4; ++u) { const float p = __builtin_amdgcn_exp2f(d[u] - mx); l += p; _Pragma("unroll") for (int e = 0; e < 8; ++e) o[e] = fmaf(p, VV[u][e], o[e]); } \
        mrun = mx; } while (0)
#pragma unroll
    for (int c = 0; c < 2; ++c) {
        float ka[4][8], va[4][8], kb[4][8], vb[4][8];
        G_LOAD(ka, va, c, 0);
#pragma unroll 1
        for (int j0 = 0; j0 < 64; j0 += 8) {
            G_LOAD(kb, vb, c, j0 + 4);
            G_FOLD(ka, va);
            if (j0 + 8 < 64) G_LOAD(ka, va, c, j0 + 8);
            G_FOLD(kb, vb);
        }
    }
#undef G_LOAD
#undef G_FOLD
    part[lane * 10] = mrun; part[lane * 10 + 1] = l;
#pragma unroll
    for (int e = 0; e < 8; ++e) part[lane * 10 + 2 + e] = o[e];
}
struct AttnOrder {
    int v, i0, n;
    __device__ __forceinline__ bool next(int i, attn_body::AttnUnit& u) const { if (i >= n) return false; const int s = v & 15; u.bh = v >> 4; u.qb = (i0 + i == 0) ? s : 31 - s; return true; }
    __device__ __forceinline__ void a_ready(const attn_body::AttnUnit&) const {}
    __device__ __forceinline__ void done(const attn_body::AttnUnit&) const {}
};
__device__ __forceinline__ void ph4_gather_unit(const Ctx& C, int u, unsigned char* lds, int lane2) {
    const int batch = (u & 7) + 8 * (u >> 4), r = MP + batch * DS + 4 * ((u >> 3) & 1) + (C.wave & 3), hf = C.wave >> 2;
    float* part = (float*)lds + C.wave * 640;
    __syncthreads();
    gather_half(C, r, hf, lane2, part);
    __syncthreads();
    if (C.wave < 4) {
        const float* p0 = part + lane2 * 10; const float* p1 = p0 + 4 * 640;
        const float m0 = p0[0], m1 = p1[0], m = fmaxf(m0, m1), c0 = __builtin_amdgcn_exp2f(m0 - m), c1 = __builtin_amdgcn_exp2f(m1 - m);
        const float il = 1.0f / (p0[1] * c0 + p1[1] * c1); float o[8];
#pragma unroll
        for (int e = 0; e < 8; ++e) o[e] = (p0[2 + e] * c0 + p1[2 + e] * c1) * il;
        store8_bf16((bf16_t*)(C.ws + WS_AMIX) + (size_t)r * 1024 + 512 + lane2 * 8, o);
    }
    __syncthreads();
}
__device__ __forceinline__ void ph4_attn_conv(const Ctx& C, unsigned char* lds) {
    const attn_body::AttnTensors AT{(const attn_body::bf16*)(C.ws + WS_Q), (const attn_body::bf16*)(C.ws + WS_K), (const attn_body::bf16*)(C.ws + WS_V),
                                    (attn_body::bf16*)(C.ws + WS_AMIX) + 512, (const u64*)(C.ws + WS_MASK), C.wave};
    const int vcu = (C.G % 8 == 0) ? (C.bid % 8) * (C.G / 8) + C.bid / 8 : C.bid;
    const int mode = (C.bid >> 4) % 3;
    for (int v = vcu, u = C.bid; v < 256; v += C.G, u += C.G) {
        if (mode == 0) ph4_gather_unit(C, u, lds, fresh_lane());
        { const AttnOrder S{v, 0, 1}; attn_body::attn_phase<AttnOrder>((char*)lds, AT, S); }
        if (mode == 1) ph4_gather_unit(C, u, lds, fresh_lane());
        { const AttnOrder S{v, 1, 1}; attn_body::attn_phase<AttnOrder>((char*)lds, AT, S); }
        if (mode == 2) ph4_gather_unit(C, u, lds, fresh_lane());
        if (PROBE_DUP == 24) ph4_gather_unit(C, u, lds, fresh_lane());
    }
}

typedef __bf16 bf16x2_t __attribute__((ext_vector_type(2)));
__device__ __forceinline__ float dot2bf(unsigned a, unsigned b, float c) { return __builtin_amdgcn_fdot2_f32_bf16(__builtin_bit_cast(bf16x2_t, a), __builtin_bit_cast(bf16x2_t, b), c, false); }
__device__ __forceinline__ float dpp_sum16(float x) {
    x += __builtin_bit_cast(float, __builtin_amdgcn_update_dpp(0, __builtin_bit_cast(int, x), 0xB1, 0xF, 0xF, true));
    x += __builtin_bit_cast(float, __builtin_amdgcn_update_dpp(0, __builtin_bit_cast(int, x), 0x4E, 0xF, 0xF, true));
    x += __builtin_bit_cast(float, __builtin_amdgcn_update_dpp(0, __builtin_bit_cast(int, x), 0x141, 0xF, 0xF, true));
    x += __builtin_bit_cast(float, __builtin_amdgcn_update_dpp(0, __builtin_bit_cast(int, x), 0x140, 0xF, 0xF, true));
    return x;
}
__device__ __forceinline__ void memattn_unit(const Ctx& C, int r0, const float* kp0, const float* vp0, unsigned char* lds, int lane) {
    const int w = C.wave, h = lane >> 4;
    float* logits = (float*)lds;
    const bf16_t* qmem = (const bf16_t*)(C.ws + WS_QMEM); const float* ssq = (const float*)(C.ws + ACC_SSQ);
    {
        unsigned q[8][8]; float rsq[8];
#pragma unroll
        for (int qi = 0; qi < 8; ++qi) { const u32x4 a = *(const u32x4*)(qmem + (size_t)(r0 + qi) * 1024 + lane * 16), bq = *(const u32x4*)(qmem + (size_t)(r0 + qi) * 1024 + lane * 16 + 8);
            q[qi][0] = a.x; q[qi][1] = a.y; q[qi][2] = a.z; q[qi][3] = a.w; q[qi][4] = bq.x; q[qi][5] = bq.y; q[qi][6] = bq.z; q[qi][7] = bq.w;
            rsq[qi] = (1.0f / sqrtf(ssq[(r0 + qi) * 4 + h] * (1.f / 256.f) + EPS)) * (0.0625f * 1.4426950408889634f); }
        const float* kbase = kp0 + (size_t)(32 * w) * 1024 + lane * 16;
#pragma unroll 1
        for (int mb = 0; mb < 8; ++mb) {
            f32x4 kr[4][4];
#pragma unroll
            for (int u = 0; u < 4; ++u)
#pragma unroll
                for (int j = 0; j < 4; ++j) kr[u][j] = *(const f32x4*)(kbase + (size_t)(mb * 4 + u) * 1024 + 4 * j);
#pragma unroll
            for (int u = 0; u < 4; ++u) {
                unsigned kb[8];
#pragma unroll
                for (int j = 0; j < 4; ++j) { kb[2 * j] = cvt_pk_bf16(kr[u][j].x, kr[u][j].y); kb[2 * j + 1] = cvt_pk_bf16(kr[u][j].z, kr[u][j].w); }
                const int m = 32 * w + mb * 4 + u;
#pragma unroll
                for (int qi = 0; qi < 8; ++qi) {
                    float p = 0.f;
#pragma unroll
                    for (int e = 0; e < 8; ++e) p = dot2bf(q[qi][e], kb[e], p);
                    p = dpp_sum16(p);
                    if ((lane & 15) == 0) logits[(qi * 4 + h) * 256 + m] = p * rsq[qi];
                }
            }
        }
    }
    __syncthreads();
#pragma unroll
    for (int rr = 0; rr < 4; ++rr) {
        float* row = logits + (4 * w + rr) * 256; float x[4]; float mx = -INFINITY;
#pragma unroll
        for (int j = 0; j < 4; ++j) { x[j] = row[lane + 64 * j]; mx = fmaxf(mx, x[j]); }
        mx = wave_max(mx); float s = 0.f;
#pragma unroll
        for (int j = 0; j < 4; ++j) { x[j] = __builtin_amdgcn_exp2f(x[j] - mx); s += x[j]; }
        s = wave_sum(s); const float is = 1.0f / s;
#pragma unroll
        for (int j = 0; j < 4; ++j) row[lane + 64 * j] = x[j] * is;
    }
    __syncthreads();
    {
        const int hw = w >> 1;
        float acc[8][2];
#pragma unroll
        for (int qi = 0; qi < 8; ++qi) { acc[qi][0] = 0.f; acc[qi][1] = 0.f; }
        const float* vbase = vp0 + 128 * w + 2 * lane;
        float2 va[16];
#pragma unroll
        for (int u = 0; u < 16; ++u) va[u] = *(const float2*)(vbase + (size_t)u * 1024);
#pragma unroll 1
        for (int m0 = 0; m0 < 256; m0 += 16) {
            float2 vb[16];
            const int mn = (m0 + 16 < 256) ? m0 + 16 : m0;
#pragma unroll
            for (int u = 0; u < 16; ++u) vb[u] = *(const float2*)(vbase + (size_t)(mn + u) * 1024);
#pragma unroll
            for (int hf = 0; hf < 2; ++hf) {
#pragma unroll
                for (int qi = 0; qi < 8; ++qi) {
                    const float* pr = logits + (qi * 4 + hw) * 256 + m0 + 8 * hf;
                    const f32x4 p0 = *(const f32x4*)pr, p1 = *(const f32x4*)(pr + 4);
                    acc[qi][0] = fmaf(p0.x, va[8 * hf + 0].x, acc[qi][0]); acc[qi][1] = fmaf(p0.x, va[8 * hf + 0].y, acc[qi][1]);
                    acc[qi][0] = fmaf(p0.y, va[8 * hf + 1].x, acc[qi][0]); acc[qi][1] = fmaf(p0.y, va[8 * hf + 1].y, acc[qi][1]);
                    acc[qi][0] = fmaf(p0.z, va[8 * hf + 2].x, acc[qi][0]); acc[qi][1] = fmaf(p0.z, va[8 * hf + 2].y, acc[qi][1]);
                    acc[qi][0] = fmaf(p0.w, va[8 * hf + 3].x, acc[qi][0]); acc[qi][1] = fmaf(p0.w, va[8 * hf + 3].y, acc[qi][1]);
                    acc[qi][0] = fmaf(p1.x, va[8 * hf + 4].x, acc[qi][0]); acc[qi][1] = fmaf(p1.x, va[8 * hf + 4].y, acc[qi][1]);
                    acc[qi][0] = fmaf(p1.y, va[8 * hf + 5].x, acc[qi][0]); acc[qi][1] = fmaf(p1.y, va[8 * hf + 5].y, acc[qi][1]);
                    acc[qi][0] = fmaf(p1.z, va[8 * hf + 6].x, acc[qi][0]); acc[qi][1] = fmaf(p1.z, va[8 * hf + 6].y, acc[qi][1]);
                    acc[qi][0] = fmaf(p1.w, va[8 * hf + 7].x, acc[qi][0]); acc[qi][1] = fmaf(p1.w, va[8 * hf + 7].y, acc[qi][1]);
                }
                __builtin_amdgcn_sched_barrier(0);
            }
#pragma unroll
            for (int u = 0; u < 16; ++u) va[u] = vb[u];
        }
        bf16_t* op = (bf16_t*)(C.ws + WS_OMEM) + (size_t)r0 * 1024 + 128 * w + 2 * lane;
#pragma unroll
        for (int qi = 0; qi < 8; ++qi) *(unsigned*)(op + (size_t)qi * 1024) = cvt_pk_bf16(acc[qi][0], acc[qi][1]);
    }
    __syncthreads();
}
__device__ __forceinline__ void memattn_unit_mfma(const Ctx& C, int qg, int h, int lane) {
    const int r32 = lane & 31, hi = lane >> 5; const int b = qg >> 8; const int row = 32 * qg + r32;
    const bf16_t* qp = (const bf16_t*)(C.ws + WS_QMEM) + (size_t)row * 1024 + h * 256 + hi * 8;
    bf16x8 qf[16];
#pragma unroll
    for (int ks = 0; ks < 16; ++ks) qf[ks] = *(const bf16x8*)(qp + ks * 16);
    const float c = (1.0f / sqrtf(((const float*)(C.ws + ACC_SSQ))[row * 4 + h] * (1.f / 256.f) + EPS)) * (0.0625f * 1.4426950408889634f);
    const bf16x8* kF = (const bf16x8*)(C.ws + WS_MKF) + (size_t)((b * 4 + h) * 8 * 16) * 64 + lane;
    f32x16 S[8];
#pragma unroll
    for (int mb = 0; mb < 8; ++mb) {
        S[mb] = f32x16{};
#pragma unroll
        for (int kh = 0; kh < 2; ++kh) {
            bf16x8 kf[8];
#pragma unroll
            for (int k8 = 0; k8 < 8; ++k8) kf[k8] = kF[(size_t)(mb * 16 + kh * 8 + k8) * 64];
            __builtin_amdgcn_sched_barrier(0);
#pragma unroll
            for (int k8 = 0; k8 < 8; ++k8) S[mb] = __builtin_amdgcn_mfma_f32_32x32x16_bf16(kf[k8], qf[kh * 8 + k8], S[mb], 0, 0, 0);
            __builtin_amdgcn_sched_barrier(0);
        }
    }
    float mx = -INFINITY;
#pragma unroll
    for (int mb = 0; mb < 8; ++mb)
#pragma unroll
        for (int r = 0; r < 16; ++r) mx = fmaxf(mx, S[mb][r]);
    mx = fmaxf(mx, __shfl_xor(mx, 32));
    const float mc = mx * c; float sum = 0.f;
    unsigned pk[8][2][4];
#pragma unroll
    for (int mb = 0; mb < 8; ++mb) {
        float p[16];
#pragma unroll
        for (int r = 0; r < 16; ++r) { p[r] = __builtin_amdgcn_exp2f(S[mb][r] * c - mc); sum += p[r]; }
#pragma unroll
        for (int s = 0; s < 2; ++s)
#pragma unroll
            for (int j = 0; j < 4; ++j) pk[mb][s][j] = cvt_pk_bf16(p[8 * s + 2 * j], p[8 * s + 2 * j + 1]);
    }
    sum += __shfl_xor(sum, 32); const float inv = 1.0f / sum;
    const bf16x8* vF = (const bf16x8*)(C.ws + WS_MVF) + (size_t)((b * 4 + h) * 8 * 16) * 64 + lane;
    bf16_t* op = (bf16_t*)(C.ws + WS_OMEM) + (size_t)row * 1024 + h * 256 + 4 * hi;
#pragma unroll
    for (int db = 0; db < 8; ++db) {
        f32x16 O = f32x16{};
#pragma unroll
        for (int mh = 0; mh < 2; ++mh) {
            bf16x8 vf[8];
#pragma unroll
            for (int k8 = 0; k8 < 8; ++k8) vf[k8] = vF[(size_t)(db * 16 + mh * 8 + k8) * 64];
            __builtin_amdgcn_sched_barrier(0);
#pragma unroll
            for (int k8 = 0; k8 < 8; ++k8) { const int mb = mh * 4 + (k8 >> 1), s = k8 & 1;
                const u32x4 pw = (u32x4){pk[mb][s][0], pk[mb][s][1], pk[mb][s][2], pk[mb][s][3]};
                O = __builtin_amdgcn_mfma_f32_32x32x16_bf16(vf[k8], __builtin_bit_cast(bf16x8, pw), O, 0, 0, 0); }
            __builtin_amdgcn_sched_barrier(0);
        }
#pragma unroll
        for (int rq = 0; rq < 4; ++rq) {
            const unsigned w0 = cvt_pk_bf16(O[4 * rq] * inv, O[4 * rq + 1] * inv), w1 = cvt_pk_bf16(O[4 * rq + 2] * inv, O[4 * rq + 3] * inv);
            *(u64*)(op + 32 * db + 8 * rq) = (u64)w0 | ((u64)w1 << 32);
        }
    }
}
__device__ __forceinline__ void ph7_memattn(const Ctx& C, unsigned char* lds, unsigned* q, volatile LAS unsigned* slot) {
    for (;;) {
        const int it = queue_pop(q, slot);
        if (it >= DB + 256) break;
        if (it < DB) { const int r0 = MP + it * 8; memattn_unit(C, r0, C.cmem_k + (size_t)it * 262144, C.cmem_v + (size_t)it * 262144, lds, fresh_lane()); }
        else { const int uu = __builtin_amdgcn_readfirstlane((it - DB) * NWAVES + C.wave); memattn_unit_mfma(C, uu >> 2, uu & 3, fresh_lane()); }
    }
}

__device__ __forceinline__ void ph10_ffn_act(const Ctx& C) {
    const int gt = C.bid * NTHREADS + C.tid, NGT = C.G * NTHREADS;
    const float* G = (const float*)(C.ws + WS_G); const bf16_t* UP = (const bf16_t*)(C.ws + WS_UP); bf16_t* aff = (bf16_t*)(C.ws + WS_AFF);
    constexpr int CG = DFF / 8;
    for (int it = gt; it < MT * CG; it += NGT) {
        const int r = it / CG, c = (it - r * CG) * 8;
        float g0[8], p1[8], p2[8], up[8], w0[8], w1[8], w2[8], bb[8], y[8];
        load8_f32(G + (size_t)r * DFF + c, g0); load8_bf16(UP + (size_t)r * DFF + c, up);
        load8_f32(C.conv_ffn_w + c, w0); load8_f32(C.conv_ffn_w + DFF + c, w1); load8_f32(C.conv_ffn_w + 2 * DFF + c, w2); load8_f32(C.conv_ffn_b + c, bb);
        if (r < MP) {
            const int t = r & (SEQ - 1), b = r >> 13;
            if (t >= 1) load8_f32(G + (size_t)(r - 1) * DFF + c, p1); else { for (int e = 0; e < 8; ++e) p1[e] = 0.f; }
            if (t >= 2) load8_f32(G + (size_t)(r - 2) * DFF + c, p2); else { for (int e = 0; e < 8; ++e) p2[e] = 0.f; }
            if (t >= SEQ - 2) store8_f32(C.out + OFF_CF_P + (size_t)(b * 2 + (t - (SEQ - 2))) * DFF + c, g0);
        } else {
            const int rl = r - MP, b = rl >> 3, tt = rl & 7;
            if (tt >= 1) load8_f32(G + (size_t)(r - 1) * DFF + c, p1); else load8_f32(C.st_ffn + (size_t)(b * 2 + 1) * DFF + c, p1);
            if (tt >= 2) load8_f32(G + (size_t)(r - 2) * DFF + c, p2); else load8_f32(C.st_ffn + (size_t)(b * 2 + tt) * DFF + c, p2);
            if (tt >= 6) store8_f32(C.out + OFF_CF_S + (size_t)(b * 2 + (tt - 6)) * DFF + c, g0);
        }
#pragma unroll
        for (int e = 0; e < 8; ++e) { const float z = w0[e] * p2[e] + w1[e] * p1[e] + w2[e] * g0[e] + bb[e]; y[e] = (z / (1.0f + __expf(-z))) * up[e]; }
        store8_bf16(aff + (size_t)r * DFF + c, y);
    }
}

__device__ __forceinline__ void memattn_tile_lds(const Ctx& C, int pm, int h, unsigned char* lds) {
    const int lane = fresh_lane(), tid = C.wave * 64 + lane, r32 = lane & 31, hi = lane >> 5; const int b = pm >> 5; const int row = 256 * pm + 32 * C.wave + r32;
    LAS unsigned char* ldsl = (LAS unsigned char*)lds;
    const u32x4* kG = (const u32x4*)(C.ws + WS_MKF) + (size_t)((b * 4 + h) * 8 * 16) * 64;
    const u32x4* vG = (const u32x4*)(C.ws + WS_MVF) + (size_t)((b * 4 + h) * 8 * 16) * 64;
#pragma unroll 1
    for (int i0 = 0; i0 < 16; i0 += 8) { u32x4 t[8];
#pragma unroll
      for (int i = 0; i < 8; ++i) t[i] = kG[(i0 + i) * 512 + tid];
#pragma unroll
      for (int i = 0; i < 8; ++i) *(LAS u32x4*)(ldsl + (size_t)((i0 + i) * 512 + tid) * 16) = t[i]; }
    __builtin_amdgcn_sched_barrier(0);
    const bf16_t* qp = (const bf16_t*)(C.ws + WS_QMEM) + (size_t)row * 1024 + h * 256 + hi * 8;
    bf16x8 qf[16];
#pragma unroll
    for (int ks = 0; ks < 16; ++ks) qf[ks] = *(const bf16x8*)(qp + ks * 16);
    const float c = (1.0f / sqrtf(((const float*)(C.ws + ACC_SSQ))[row * 4 + h] * (1.f / 256.f) + EPS)) * (0.0625f * 1.4426950408889634f);
    __syncthreads();
    const LAS unsigned char* fL0 = ldsl + lane * 16; const LAS unsigned char* fL1 = fL0 + 65536;
#define FRAG(f) (*(const LAS bf16x8*)(((f) < 64 ? fL0 : fL1) + ((f) & 63) * 1024))
    float sum = 0.f;
    unsigned pk[8][2][4];
#pragma unroll
    for (int mb = 0; mb < 8; ++mb) {
        f32x16 S = f32x16{};
#pragma unroll
        for (int kh = 0; kh < 2; ++kh) {
            bf16x8 kf[8];
#pragma unroll
            for (int k8 = 0; k8 < 8; ++k8) kf[k8] = FRAG(mb * 16 + kh * 8 + k8);
#pragma unroll
            for (int k8 = 0; k8 < 8; ++k8) S = __builtin_amdgcn_mfma_f32_32x32x16_bf16(kf[k8], qf[kh * 8 + k8], S, 0, 0, 0);
        }
        float p[16];
#pragma unroll
        for (int r = 0; r < 16; ++r) { p[r] = __builtin_amdgcn_exp2f(S[r] * c); sum += p[r]; }
        asm volatile("" : "+v"(sum));
#pragma unroll
        for (int s2 = 0; s2 < 2; ++s2)
#pragma unroll
            for (int j = 0; j < 4; ++j) pk[mb][s2][j] = cvt_pk_bf16(p[8 * s2 + 2 * j], p[8 * s2 + 2 * j + 1]);
    }
    sum += __shfl_xor(sum, 32); const float inv = 1.0f / sum;
    __syncthreads();
#pragma unroll 1
    for (int i0 = 0; i0 < 16; i0 += 8) { u32x4 t[8];
#pragma unroll
      for (int i = 0; i < 8; ++i) t[i] = vG[(i0 + i) * 512 + tid];
#pragma unroll
      for (int i = 0; i < 8; ++i) *(LAS u32x4*)(ldsl + (size_t)((i0 + i) * 512 + tid) * 16) = t[i]; }
    __syncthreads();
    bf16_t* op = (bf16_t*)(C.ws + WS_OMEM) + (size_t)row * 1024 + h * 256 + 4 * hi;
#pragma unroll
    for (int db = 0; db < 8; ++db) {
        f32x16 O = f32x16{};
#pragma unroll
        for (int mh = 0; mh < 2; ++mh) {
            bf16x8 vf[8];
#pragma unroll
            for (int k8 = 0; k8 < 8; ++k8) vf[k8] = FRAG(db * 16 + mh * 8 + k8);
#pragma unroll
            for (int k8 = 0; k8 < 8; ++k8) { const int mb = mh * 4 + (k8 >> 1), s = k8 & 1;
                const u32x4 pw = (u32x4){pk[mb][s][0], pk[mb][s][1], pk[mb][s][2], pk[mb][s][3]};
                O = __builtin_amdgcn_mfma_f32_32x32x16_bf16(vf[k8], __builtin_bit_cast(bf16x8, pw), O, 0, 0, 0); }
        }
#pragma unroll
        for (int rq = 0; rq < 4; ++rq) {
            const unsigned w0 = cvt_pk_bf16(O[4 * rq] * inv, O[4 * rq + 1] * inv), w1 = cvt_pk_bf16(O[4 * rq + 2] * inv, O[4 * rq + 3] * inv);
            *(u64*)(op + 32 * db + 8 * rq) = (u64)w0 | ((u64)w1 << 32);
        }
    }
#undef FRAG
    __syncthreads();
}
__global__ void __launch_bounds__(NTHREADS, 2) fwd(Args args) {
    extern __shared__ __attribute__((aligned(16))) unsigned char lds[];
    Ctx C;
    C.x_p = (const float*)args.in[0]; C.x_s = (const float*)args.in[1]; C.cache_k = (const float*)args.in[2]; C.cache_v = (const float*)args.in[3]; C.cache_ik = (const float*)args.in[4];
    C.st_mix = (const float*)args.in[5]; C.st_ffn = (const float*)args.in[6]; C.cmem_k = (const float*)args.in[7]; C.cmem_v = (const float*)args.in[8]; C.page_table = (const int*)args.in[9];
    C.mem_p = (const float*)args.in[10]; C.g_mix = (const float*)args.in[11]; C.w_in = (const float*)args.in[12]; C.conv_mix_w = (const float*)args.in[13]; C.q_g = (const float*)args.in[14];
    C.k_g = (const float*)args.in[15]; C.w_out = (const float*)args.in[16]; C.g_mem = (const float*)args.in[17]; C.g_mem_src = (const float*)args.in[18]; C.w_q = (const float*)args.in[19];
    C.w_kv = (const float*)args.in[20]; C.mq_g = (const float*)args.in[21]; C.mk_g = (const float*)args.in[22]; C.w_o = (const float*)args.in[23]; C.g_ffn = (const float*)args.in[24];
    C.w_gu = (const float*)args.in[25]; C.conv_ffn_w = (const float*)args.in[26]; C.conv_ffn_b = (const float*)args.in[27]; C.w_down = (const float*)args.in[28];
    C.out = args.out; C.ws = args.ws;
    C.wave = __builtin_amdgcn_readfirstlane(threadIdx.x >> 6); C.lane = fresh_lane(); C.tid = C.wave * 64 + C.lane; C.G = gridDim.x; C.bid = blockIdx.x;
    unsigned char* ws = args.ws;
    LAS unsigned char* ldsl = (LAS unsigned char*)lds;
    volatile LAS unsigned* MISC = (volatile LAS unsigned*)(ldsl + MISC_OFF);
    for (int u = C.tid; u < (LDS_BYTES - RING_BYTES) / 4; u += NTHREADS) ((LAS unsigned*)(ldsl + RING_BYTES))[u] = 0u;
    __syncthreads();
    XcdBarrier bar; bar.bar = (unsigned*)(ws + WS_CTL) + CW_BAR; bar.x = 0; bar.st = nullptr;
    if (N_LAUNCHES == 1) bar = xcd_barrier_post((unsigned*)(ws + WS_CTL) + CW_BAR, MISC + 8);
    bar.wv = C.wave;
    const int lo = args.ph_lo, hi = args.ph_hi;
#ifndef PHMASK
#define PHMASK 0xFFFF
#endif
#define IN(k) (((PHMASK >> (k)) & 1) && lo <= (k) && (k) < hi)
#define DUP(k) (PROBE_DUP == (k))
#define SEAM(k) do { if (IN(k) && IN((k) + 1)) xcd_barrier(bar); C.lane = fresh_lane(); C.tid = C.wave * 64 + C.lane; } while (0)
    float* ss1 = (float*)(ws + ACC_SS1); float* ss2 = (float*)(ws + ACC_SS2); float* ssq = (float*)(ws + ACC_SSQ); float* ssk = (float*)(ws + ACC_SSK);
    float* rstd = (float*)(ws + WS_RSTD);

    if (IN(0)) { ph0_prologue(C, lds); if (DUP(0)) { __syncthreads(); ph0_prologue(C, lds); } } SEAM(0);
    if (IN(1)) {
        { pg8::Gemm g{(const bf16_t*)(ws + WS_XB), (const bf16_t*)(ws + WS_WIN), MT, DINP, DM, C.wave}; pg8::StaticOrder S; S.init(MT, DINP, C.G, C.bid);
          EpiIn E{rstd, (const float*)(ws + WS_COS), (const float*)(ws + WS_SIN), C.q_g, C.k_g, (bf16_t*)(ws + WS_CB), (bf16_t*)(ws + WS_U), (bf16_t*)(ws + WS_Q), (bf16_t*)(ws + WS_K), (bf16_t*)(ws + WS_V),
                  (bf16_t*)(ws + WS_QI), (bf16_t*)(ws + WS_KI), (float*)(ws + WS_IW), (float*)(ws + WS_QIF), C.out};
          pg8::gemm_phase<EpiIn, pg8::StaticOrder, true, true>(ldsl, g, S, E);
          if (DUP(1)) pg8::gemm_phase<EpiIn, pg8::StaticOrder, true, true>(ldsl, g, S, E); }
        { EpiKv E{rstd + MT, ssk, C.out};
          for (int t = C.bid; t < 256; t += C.G) gemm_small2_rc<DM, EpiKv>((const bf16_t*)(ws + WS_MEMB), (const bf16_t*)(ws + WS_WKV), (t >> 5) * 64, (t & 31) * 64, C.wave, fresh_lane(), E, lds); }
    } SEAM(1);
    if (IN(2)) { ph2_memprep(C); ph2_scores_select(C, lds, (unsigned*)(ws + WS_CTL) + CQ_PH2, MISC + 16); if (DUP(2)) { __syncthreads(); ph2_scores_select(C, lds, (unsigned*)(ws + WS_CTL) + CQ_PH2 + 128, MISC + 16); } } SEAM(2);
    if (IN(4)) { ph4_attn_conv(C, lds); if (DUP(4)) { __syncthreads(); ph4_attn_conv(C, lds); } } SEAM(4);
    if (IN(5)) {
        pg8::Gemm g{(const bf16_t*)(ws + WS_AMIX), (const bf16_t*)(ws + WS_WOUT), MP, DM, DM, C.wave}; pg8::StaticOrder S; S.init(MP, DM, C.G, C.bid);
        EpiRes E{C.x_p, C.x_s, nullptr, nullptr, nullptr, (bf16_t*)(ws + WS_H1B), ss1};
        pg8::gemm_phase<EpiRes, pg8::StaticOrder, true, true>(ldsl, g, S, E);
        for (int t = C.bid; t < 256; t += C.G) gemm_small2<DM, EpiRes>(g.A, g.Bt, t, C.wave, fresh_lane(), E, lds);
        if (DUP(15)) { EpiRes E2{C.x_p, C.x_s, nullptr, nullptr, nullptr, (bf16_t*)(ws + WS_H1B), nullptr}; for (int t = C.bid; t < 256; t += C.G) gemm_small<EpiRes>(g.A, g.Bt, DM, t, C.wave, fresh_lane(), E2); }
        if (DUP(5)) { EpiRes E2{C.x_p, C.x_s, nullptr, nullptr, nullptr, (bf16_t*)(ws + WS_H1B), nullptr}; pg8::gemm_phase<EpiRes, pg8::StaticOrder, true, true>(ldsl, g, S, E2); }
    } SEAM(5);
    if (IN(6)) {
        pg8::Gemm g{(const bf16_t*)(ws + WS_H1B), (const bf16_t*)(ws + WS_WQ), MP, DM, DM, C.wave}; pg8::StaticOrder S; S.init(MP, DM, C.G, C.bid);
        EpiQm E{ss1, C.mq_g, (bf16_t*)(ws + WS_QMEM), ssq};
        pg8::gemm_phase<EpiQm, pg8::StaticOrder, true, true>(ldsl, g, S, E);
        const bool one = (MP / 256) * (DM / 256) <= C.G;
        if (one) {
            const int nM = MP / 256, nN = DM / 256, nwg = nM * nN; int wgid = C.bid;
            if (wgid < nwg) { const int q = nwg / 8, r = nwg % 8, xcd = wgid % 8, off = wgid / 8; wgid = (xcd < r ? xcd * (q + 1) : r * (q + 1) + (xcd - r) * q) + off;
                const int nig = 8 * nN, gid = wgid / nig, fm = gid * 8, gsz = (nM - fm) < 8 ? (nM - fm) : 8; const int pm = fm + ((wgid % nig) % gsz), pn = (wgid % nig) / gsz;
                asm volatile("s_waitcnt vmcnt(0)" ::: "memory");
                __syncthreads();
                memattn_tile_lds(C, pm, pn, lds); }
        }
        for (int t = C.bid; t < 256; t += C.G) gemm_small2<DM, EpiQm>(g.A, g.Bt, t, C.wave, fresh_lane(), E, lds);
        if (!one) { xcd_barrier(bar); for (int u = C.bid * NWAVES + C.wave; u < 2048; u += C.G * NWAVES) { const int uu = __builtin_amdgcn_readfirstlane(u); memattn_unit_mfma(C, uu >> 2, uu & 3, fresh_lane()); } }
    } SEAM(6);
    if (IN(7)) {
        const int wg0 = (C.G > DB) ? DB : 0;
        if (C.bid < wg0 || wg0 == 0) for (int u = C.bid; u < DB; u += (wg0 ? wg0 : C.G)) memattn_unit(C, MP + u * 8, C.cmem_k + (size_t)u * 262144, C.cmem_v + (size_t)u * 262144, lds, fresh_lane());
        if (C.bid >= wg0) {
            pg8::Gemm g{(const bf16_t*)(ws + WS_OMEM), (const bf16_t*)(ws + WS_WO), MP, DM, DM, C.wave}; pg8::StaticOrder S; S.init(MP, DM, C.G - wg0, C.bid - wg0);
            EpiRes E{nullptr, nullptr, (const bf16_t*)(ws + WS_H1B), nullptr, nullptr, (bf16_t*)(ws + WS_H2B), ss2};
            pg8::gemm_phase<EpiRes, pg8::StaticOrder, true, true>(ldsl, g, S, E);
        }
    } SEAM(7);
    if (IN(8)) {
        pg8::Gemm g{(const bf16_t*)(ws + WS_OMEM), (const bf16_t*)(ws + WS_WO), MP, DM, DM, C.wave};
        EpiRes E{nullptr, nullptr, (const bf16_t*)(ws + WS_H1B), nullptr, nullptr, (bf16_t*)(ws + WS_H2B), ss2};
        for (int t = C.bid; t < 256; t += C.G) gemm_small2<DM, EpiRes>(g.A, g.Bt, t, C.wave, fresh_lane(), E, lds);
    } SEAM(8);
    if (IN(9)) {
        pg8::Gemm g{(const bf16_t*)(ws + WS_H2B), (const bf16_t*)(ws + WS_WGU), MT, 2 * DFF, DM, C.wave}; pg8::StaticOrder S; S.init(MT, 2 * DFF, C.G, C.bid);
        EpiGu E{ss2, C.conv_ffn_w, C.conv_ffn_b, C.st_ffn, (bf16_t*)(ws + WS_AFF), (float*)(ws + WS_SIDEG), (float*)(ws + WS_SIDEU), (float*)(ws + WS_LASTG), C.out, (float*)(lds + HALO_OFF)};
        pg8::gemm_phase<EpiGu, pg8::StaticOrder, true, true>(ldsl, g, S, E);
        if (DUP(9)) pg8::gemm_phase<EpiGu, pg8::StaticOrder, true, true>(ldsl, g, S, E);
    } SEAM(9);
    if (IN(11)) {
        pg8::Gemm g{(const bf16_t*)(ws + WS_AFF), (const bf16_t*)(ws + WS_WDOWN), MP, DM, DFF, C.wave}; pg8::StaticOrder S; S.init(MP, DM, C.G, C.bid);
        { const int nM = MP / 256, nN = DM / 256, nwg = nM * nN; int wgid = C.bid;
          if (wgid < nwg) { const int q = nwg / 8, r = nwg % 8, xcd = wgid % 8, off = wgid / 8; wgid = (xcd < r ? xcd * (q + 1) : r * (q + 1) + (xcd - r) * q) + off;
            const int nig = 8 * nN, gid = wgid / nig, fm = gid * 8, gsz = (nM - fm) < 8 ? (nM - fm) : 8; ffn_fixup_rows(C, fm + ((wgid % nig) % gsz)); } }
        EpiRes E{nullptr, nullptr, (const bf16_t*)(ws + WS_H2B), C.out + OFF_Y_P, C.out + OFF_Y_S, nullptr, nullptr};
        pg8::gemm_phase<EpiRes, pg8::StaticOrder, true, true>(ldsl, g, S, E);
        for (int t = C.bid; t < 256; t += C.G) gemm_small2<DFF, EpiRes>(g.A, g.Bt, t, C.wave, fresh_lane(), E, lds);
        if (DUP(11)) pg8::gemm_phase<EpiRes, pg8::StaticOrder, true, true>(ldsl, g, S, E);
    }
#undef IN
#undef SEAM
}

extern "C" void kernel_launch(void* const* d_in, const int* in_sizes, int n_in, void* d_out, int out_size, void* d_ws, size_t ws_size, hipStream_t stream) {
    static int grid = 0;
    if (grid == 0) {
        if (n_in != 29 || (size_t)out_size != OUT_TOTAL || ws_size < WS_END) { fprintf(stderr, "kernel_launch: unexpected problem (n_in %d, out %d, ws %zu); nothing launched\n", n_in, out_size, ws_size); grid = -1; return; }
        int dev = 0, cus = 0;
        if (hipGetDevice(&dev) != hipSuccess || hipDeviceGetAttribute(&cus, hipDeviceAttributeMultiprocessorCount, dev) != hipSuccess) { grid = -1; return; }
        if (hipFuncSetAttribute((const void*)fwd, hipFuncAttributeMaxDynamicSharedMemorySize, LDS_BYTES) != hipSuccess) { fprintf(stderr, "kernel_launch: hipFuncSetAttribute failed\n"); grid = -1; return; }
        (void)hipGetLastError();
        grid = cus;
    }
    if (grid < 0) return;
    (void)hipMemsetAsync((char*)d_ws + WS_CTL, 0, CTL_ZERO_BYTES, stream);
    Args a{};
    for (int i = 0; i < 29; ++i) a.in[i] = d_in[i];
    a.out = (float*)d_out; a.ws = (unsigned char*)d_ws;
    if (N_LAUNCHES == 1) { a.ph_lo = 0; a.ph_hi = NPHASE; hipLaunchKernelGGL(fwd, dim3(grid), dim3(NTHREADS), LDS_BYTES, stream, a); }
    else for (int p = 0; p < NPHASE; ++p) { a.ph_lo = p; a.ph_hi = p + 1; hipLaunchKernelGGL(fwd, dim3(grid), dim3(NTHREADS), LDS_BYTES, stream, a); }
}
```

```cpp
#include <hip/hip_runtime.h>
#include <cstdio>
#include <cstdint>

#ifndef MK_N_LAUNCHES
#define MK_N_LAUNCHES 1
#endif

__device__ __forceinline__ int fresh_lane() { int l; asm volatile("v_mbcnt_lo_u32_b32 %0, -1, 0\n\tv_mbcnt_hi_u32_b32 %0, -1, %0" : "=v"(l)); return l; }

#include <hip/hip_bf16.h>
#include <cmath>
namespace attn_body {
using bf16=__hip_bfloat16;
using bf16x8=__attribute__((ext_vector_type(8)))short;
using s16x4=__attribute__((ext_vector_type(4)))short;
using f32x16=__attribute__((ext_vector_type(16)))float;
using u32x4=__attribute__((ext_vector_type(4)))unsigned;
constexpr int BATCH=2,NHEAD=8,SEQ=8192,D=64,DM=NHEAD*D,OPITCH=1024;
constexpr int NW=8,QBLK=32,QB=QBLK*NW,KVBLK=64,NQB=SEQ/QB;
constexpr int ATTN_PITCH=DM, ATTN_UNIT_ROWS=QB;
__device__ __forceinline__ int crow(int r,int hi){return (r&3)+8*(r>>2)+4*hi;}
#define SBAR() __builtin_amdgcn_sched_barrier(0)
__device__ __forceinline__ void cmask(f32x16&p0,f32x16&p1,int jb,int qrel,int hi){
  const float NEG=-INFINITY; int kb=64*jb+4*hi;
  #pragma unroll
  for(int r=0;r<16;++r){int kv=kb+(r&3)+8*(r>>2); if(kv>qrel)p0[r]=NEG; if(kv+32>qrel)p1[r]=NEG;}
}

constexpr int NSLOT=3, SLOTB=8192;
constexpr int LDS_K=0, LDS_V=NSLOT*SLOTB, LDS_WS=2*NSLOT*SLOTB, LDS_OST=LDS_WS+NW*64*4, LDS_BYTES=LDS_OST+NW*4096;
constexpr float C2=0.125f*1.4426950408889634f;
__device__ __forceinline__ void glds16(const void*gsrc,unsigned lds_dst){unsigned keep;
  asm volatile("s_mov_b32 %0, m0\n\ts_mov_b32 m0, %2\n\ts_nop 0\n\tglobal_load_lds_dwordx4 %1, off\n\ts_mov_b32 m0, %0":"=&s"(keep):"v"(gsrc),"s"(lds_dst):"memory");}
__device__ __forceinline__ float max3f(float a,float b,float c){float r;asm("v_max3_f32 %0, %1, %2, %3":"=v"(r):"v"(a),"v"(b),"v"(c));return r;}
__device__ __forceinline__ float max2f(float a,float b){float r;asm("v_max_f32_e32 %0, %1, %2":"=v"(r):"v"(a),"v"(b));return r;}
__device__ __forceinline__ float fadd_s(float a,float b){float r;asm("v_add_f32_e32 %0, %1, %2":"=v"(r):"v"(a),"v"(b));return r;}
__device__ __forceinline__ float fsub_s(float a,float b){float r;asm("v_sub_f32_e32 %0, %1, %2":"=v"(r):"v"(a),"v"(b));return r;}
typedef float f32x2_t __attribute__((ext_vector_type(2))); typedef __bf16 bf16x2_t __attribute__((ext_vector_type(2)));
__device__ __forceinline__ unsigned cvtpk_s(float lo,float hi){f32x2_t v={lo,hi};bf16x2_t b=__builtin_convertvector(v,bf16x2_t);return __builtin_bit_cast(unsigned,b);}
#define WAIT_BAR(N) asm volatile("s_waitcnt vmcnt(" #N ") lgkmcnt(0)\n\ts_barrier":::"memory")

__device__ __forceinline__ void qkt(f32x16&p0,f32x16&p1,const char*Kslot,const bf16x8*qr,const f32x16&negm,int r32,int hi){
  const char*kb=Kslot+hi*1024+r32*16;
  #pragma unroll
  for(int d0=0;d0<4;++d0){
    const bf16x8 b0=*reinterpret_cast<const bf16x8*>(kb+d0*2048);
    const bf16x8 b1=*reinterpret_cast<const bf16x8*>(kb+d0*2048+512);
    if(d0==0){p0=__builtin_amdgcn_mfma_f32_32x32x16_bf16(b0,qr[0],negm,0,0,0);p1=__builtin_amdgcn_mfma_f32_32x32x16_bf16(b1,qr[0],negm,0,0,0);}
    else{p0=__builtin_amdgcn_mfma_f32_32x32x16_bf16(b0,qr[d0],p0,0,0,0);p1=__builtin_amdgcn_mfma_f32_32x32x16_bf16(b1,qr[d0],p1,0,0,0);}}
}
typedef __attribute__((address_space(3))) const char* lds_cptr;
typedef short v4i16_t __attribute__((ext_vector_type(4)));
__device__ __forceinline__ void kload8(bf16x8*kf,lds_cptr kp){
  kf[0]=*(const __attribute__((address_space(3))) bf16x8*)(kp);      kf[1]=*(const __attribute__((address_space(3))) bf16x8*)(kp+512);
  kf[2]=*(const __attribute__((address_space(3))) bf16x8*)(kp+2048); kf[3]=*(const __attribute__((address_space(3))) bf16x8*)(kp+2560);
  kf[4]=*(const __attribute__((address_space(3))) bf16x8*)(kp+4096); kf[5]=*(const __attribute__((address_space(3))) bf16x8*)(kp+4608);
  kf[6]=*(const __attribute__((address_space(3))) bf16x8*)(kp+6144); kf[7]=*(const __attribute__((address_space(3))) bf16x8*)(kp+6656);
}
__device__ __forceinline__ void kload2(bf16x8*kf,lds_cptr kp,int j){ kf[2*j]=*(const __attribute__((address_space(3))) bf16x8*)(kp+j*2048); kf[2*j+1]=*(const __attribute__((address_space(3))) bf16x8*)(kp+j*2048+512); }
__device__ __forceinline__ s16x4 vtr(lds_cptr p){ return __builtin_bit_cast(s16x4,__builtin_amdgcn_ds_read_tr16_b64_v4i16((__attribute__((address_space(3))) v4i16_t*)p)); }
__device__ __forceinline__ float rowmax(const f32x16&p0,const f32x16&p1){
  float a=max3f(p0[0],p0[1],p1[0]),b=max3f(p0[2],p0[3],p1[1]);a=max3f(a,p1[2],p1[3]);
  #pragma unroll
  for(int r=4;r<16;r+=4){a=max3f(a,p0[r],p0[r+1]);b=max3f(b,p0[r+2],p0[r+3]);a=max3f(a,p1[r],p1[r+1]);b=max3f(b,p1[r+2],p1[r+3]);}
  const float m=max2f(a,b);
  auto rr=__builtin_amdgcn_permlane32_swap(__float_as_uint(m),__float_as_uint(m),false,false);
  return max2f(__uint_as_float(rr[0]),__uint_as_float(rr[1]));
}
__device__ __forceinline__ void pv(f32x16*o,int vb,bf16x8 pa0,bf16x8 pa1,bf16x8 pa2,bf16x8 pa3){
  #pragma unroll
  for(int d0=0;d0<2;++d0){s16x4 lo[4],hi[4];
    #pragma unroll
    for(int ks=0;ks<4;++ks){
      asm volatile("ds_read_b64_tr_b16 %0,%1 offset:%c2":"=&v"(lo[ks]):"v"(vb),"i"(d0*4096+ks*1024):"memory");
      asm volatile("ds_read_b64_tr_b16 %0,%1 offset:%c2":"=&v"(hi[ks]):"v"(vb),"i"(d0*4096+ks*1024+512):"memory");}
    asm volatile("s_waitcnt lgkmcnt(0)":::"memory");SBAR();
    #define PK(k) (bf16x8){lo[k][0],lo[k][1],lo[k][2],lo[k][3],hi[k][0],hi[k][1],hi[k][2],hi[k][3]}
    o[d0]=__builtin_amdgcn_mfma_f32_32x32x16_bf16(pa0,PK(0),o[d0],0,0,0);
    o[d0]=__builtin_amdgcn_mfma_f32_32x32x16_bf16(pa1,PK(1),o[d0],0,0,0);
    o[d0]=__builtin_amdgcn_mfma_f32_32x32x16_bf16(pa2,PK(2),o[d0],0,0,0);
    o[d0]=__builtin_amdgcn_mfma_f32_32x32x16_bf16(pa3,PK(3),o[d0],0,0,0);
    #undef PK
  }
}

#ifndef ATTN_STORE16
#define ATTN_STORE16(p,v) (*(u32x4*)(p)=(v))
#endif
typedef unsigned long long v16i __attribute__((ext_vector_type(8)));
#define MLOAD_P0(t_) do{ const unsigned long long* mp_=mbase+(size_t)(t_)*32; \
  asm volatile("s_load_dwordx16 %0, %1, 0x0":"=s"(mwA):"s"(mp_)); asm volatile("s_load_dwordx16 %0, %1, 0x40":"=s"(mwB):"s"(mp_)); }while(0)
#define MLOAD_P1(t_) do{ const unsigned long long* mp_=mbase+(size_t)(t_)*32; \
  asm volatile("s_load_dwordx16 %0, %1, 0x80":"=s"(mwA):"s"(mp_)); asm volatile("s_load_dwordx16 %0, %1, 0xc0":"=s"(mwB):"s"(mp_)); }while(0)
#define MAP1(X,r,W) do{ float t_=X[r]; asm volatile("v_cndmask_b32_e64 %0, 0, %0, %1":"+v"(t_):"s"(W)); X[r]=t_; }while(0)
#define MAPPLY1(P) do{ _Pragma("unroll") for(int r_=0;r_<8;++r_){ MAP1(P,r_,mwA[r_]); MAP1(P,8+r_,mwB[r_]); } }while(0)
#define MWAIT() asm volatile("s_waitcnt lgkmcnt(0)":::"memory")
template<int THRL> __device__ __forceinline__ void attn_unit(int b,int h,int qb,const bf16*Q,const bf16*__restrict__ K,const bf16*__restrict__ V,bf16*O,const unsigned long long*M,char*shm,int wid_in){
  const int lane=fresh_lane(),r32=lane&31,hi=lane>>5; const int wid=wid_in;
  const long rowbase=(long)b*SEQ; const int q0=qb*QB;
  const bf16*Qw=Q+(rowbase+q0+wid*QBLK)*DM+h*D;
  const bf16*Kh=K+rowbase*DM+h*D,*Vh=V+rowbase*DM+h*D;
  const unsigned long long*mbase=M+((size_t)(b*256+qb*8+wid))*(128*32); v16i mwA,mwB;
  const unsigned lds0=(unsigned)(uintptr_t)shm;
  float*wsf=(float*)(shm+LDS_WS)+wid*64;
  const bf16*ksrc=Kh+(long)lane*DM+wid*8;
  const bf16*vsrc=Vh+(long)(16*(wid&3)+(lane>>2))*DM+(wid>>2)*32+(lane&3)*8;
  const unsigned kdst=lds0+LDS_K+wid*1024, vdst=lds0+LDS_V+wid*1024;
  #define DMA_K(t,slot) glds16(ksrc+(long)(t)*KVBLK*DM,(unsigned)__builtin_amdgcn_readfirstlane(kdst+(slot)))
  #define DMA_V(t,slot) glds16(vsrc+(long)(t)*KVBLK*DM,(unsigned)__builtin_amdgcn_readfirstlane(vdst+(slot)))
  const int vb0=(int)(lds0+LDS_V)+((lane>>4)&1)*32+(lane&3)*8+(4*hi+((lane&15)>>2))*64;
  const char*Kbase=shm+LDS_K; bf16x8 kf[8];
  const lds_cptr shm3=(lds_cptr)shm; const lds_cptr kp0=shm3+LDS_K+hi*1024+r32*16; const lds_cptr vp0=shm3+LDS_V+((lane>>4)&1)*32+(lane&3)*8+(4*hi+((lane&15)>>2))*64;
  const int NT=(q0+QB)/KVBLK;
  DMA_K(0,0);DMA_V(0,0);DMA_K(1,SLOTB);
  bf16x8 qr[4];
  #pragma unroll
  for(int d0=0;d0<4;++d0)qr[d0]=*reinterpret_cast<const bf16x8*>(&Qw[(long)r32*DM+d0*16+hi*8]);
  float l_reg=0.f;f32x16 o[2];o[0]=f32x16{};o[1]=f32x16{};
  const int qrel=wid*QBLK+r32;
  #define CMASK(P0,P1,t) do{int jb_=(t)-(NT-4); if(jb_>=0)cmask(P0,P1,jb_,qrel,hi);}while(0)
  bool resc=false;
  #define START(P0,P1) do{ resc=false; \
    _Pragma("unroll") for(int r=0;r<16;++r)P0[r]=__builtin_amdgcn_exp2f(P0[r]); }while(0)
  #define RESC() do{}while(0)
  f32x16 pA0,pA1,pB0,pB1;
  int sl_prev=0,sl_cur=0,sl_next=SLOTB;
  #define ROT() do{sl_prev=sl_cur;sl_cur=sl_next;sl_next=(sl_next==(NSLOT-1)*SLOTB)?0:sl_next+SLOTB;}while(0)
  MLOAD_P0(0);
  DMA_K(2,2*SLOTB);
  WAIT_BAR(3);
  qkt(pA0,pA1,Kbase,qr,f32x16{},r32,hi);asm volatile("s_nop 15\n\ts_nop 7":"+v"(pA0),"+v"(pA1));CMASK(pA0,pA1,0);
  START(pA0,pA1);
  _Pragma("unroll") for(int r=0;r<16;++r)pA1[r]=__builtin_amdgcn_exp2f(pA1[r]);
  WAIT_BAR(0);
  DMA_K(3,0);DMA_V(1,SLOTB);
  ROT();
  kload8(kf,kp0+sl_cur);
  WAIT_BAR(2);
  s16x4 vlo[8],vhi[8]; u32x4 pw0,pw1,pw2,pw3;
  #define PKW(P,B) cvtpk_s(P[B],P[B+1])
  #define PAF(k) __builtin_bit_cast(bf16x8,pw##k)
  #define VFR(i) (bf16x8){vlo[i][0],vlo[i][1],vlo[i][2],vlo[i][3],vhi[i][0],vhi[i][1],vhi[i][2],vhi[i][3]}
  #define PIN(x) asm volatile("":"+v"(x))
  #define MX3(a,b,c) __builtin_fmaxf(__builtin_fmaxf((a),(b)),(c))
  #define GAPA(MF,A0,A1,A2,A3,W0,W1,PW) do{ MF; sacc+=A0; sacc+=A1; sacc+=A2; sacc+=A3; PIN(sacc); W0; W1; PIN(PW); SBAR(); }while(0)
  #define EX(v) __builtin_amdgcn_exp2f(v)
  #define GAPB(MF,X,B) do{ MF; X[B]=EX(X[B]); X[B+1]=EX(X[B+1]); X[B+2]=EX(X[B+2]); X[B+3]=EX(X[B+3]); PIN(X); SBAR(); }while(0)
  #define VRD(i) do{ vlo[i]=vtr(vp_+(((i)>>2)*4096+((i)&3)*1024)); vhi[i]=vtr(vp_+(((i)>>2)*4096+((i)&3)*1024+512)); }while(0)
  #define KRD(G,j) do{ if(G){ kload2(kf,kp0+sl_next,j); SBAR(); } }while(0)
  #define STEP(C0,C1,P0,P1,t,GK,GV,GL) do{ SBAR(); MAPPLY1(P0); MLOAD_P1((t)-1); SBAR(); \
    const lds_cptr vp_=vp0+sl_prev; \
    VRD(0); SBAR(); float sacc=(P0[0]+P0[1]); \
    GAPA(C0=__builtin_amdgcn_mfma_f32_32x32x16_bf16(kf[0],qr[0],f32x16{},0,0,0), P0[2],P0[3],P0[4],P0[5],     pw0[0]=PKW(P0,0), pw0[1]=PKW(P0,2), pw0); \
    VRD(4); SBAR(); GAPA(C1=__builtin_amdgcn_mfma_f32_32x32x16_bf16(kf[1],qr[0],f32x16{},0,0,0), P0[6],P0[7],P0[8],P0[9],     pw0[2]=PKW(P0,4), pw0[3]=PKW(P0,6), pw0); \
    VRD(1); SBAR(); GAPA(C0=__builtin_amdgcn_mfma_f32_32x32x16_bf16(kf[2],qr[1],C0,0,0,0),   P0[10],P0[11],P0[12],P0[13], pw1[0]=PKW(P0,8), pw1[1]=PKW(P0,10), pw1); \
    MWAIT(); MAPPLY1(P1); MLOAD_P0(t); SBAR(); \
    VRD(5); SBAR(); GAPA(C1=__builtin_amdgcn_mfma_f32_32x32x16_bf16(kf[3],qr[1],C1,0,0,0),   P0[14],P0[15],P1[0],P1[1],   pw1[2]=PKW(P0,12),pw1[3]=PKW(P0,14), pw1); \
    VRD(2); SBAR(); GAPA(C0=__builtin_amdgcn_mfma_f32_32x32x16_bf16(kf[4],qr[2],C0,0,0,0),   P1[2],P1[3],P1[4],P1[5],     pw2[0]=PKW(P1,0), pw2[1]=PKW(P1,2), pw2); \
    VRD(6); SBAR(); GAPA(C1=__builtin_amdgcn_mfma_f32_32x32x16_bf16(kf[5],qr[2],C1,0,0,0),   P1[6],P1[7],P1[8],P1[9],     pw2[2]=PKW(P1,4), pw2[3]=PKW(P1,6), pw2); \
    VRD(3); SBAR(); GAPA(C0=__builtin_amdgcn_mfma_f32_32x32x16_bf16(kf[6],qr[3],C0,0,0,0),   P1[10],P1[11],P1[12],P1[13], pw3[0]=PKW(P1,8), pw3[1]=PKW(P1,10), pw3); \
    VRD(7); SBAR(); GAPA(C1=__builtin_amdgcn_mfma_f32_32x32x16_bf16(kf[7],qr[3],C1,0,0,0),   P1[14],P1[15],0.f,0.f,       pw3[2]=PKW(P1,12),pw3[3]=PKW(P1,14), pw3); \
    l_reg+=sacc; \
    if(GK){DMA_K((t)+3,sl_cur);} if(GV){DMA_V((t)+1,sl_next);} \
    CMASK(C0,C1,t); \
    SBAR(); \
    GAPB(o[0]=__builtin_amdgcn_mfma_f32_32x32x16_bf16(PAF(0),VFR(0),o[0],0,0,0), C0,0); \
    GAPB(o[1]=__builtin_amdgcn_mfma_f32_32x32x16_bf16(PAF(0),VFR(4),o[1],0,0,0), C0,4); \
    KRD(GL,0); GAPB(o[0]=__builtin_amdgcn_mfma_f32_32x32x16_bf16(PAF(1),VFR(1),o[0],0,0,0), C0,8); \
    KRD(GL,1); GAPB(o[1]=__builtin_amdgcn_mfma_f32_32x32x16_bf16(PAF(1),VFR(5),o[1],0,0,0), C0,12); \
    KRD(GL,2); GAPB(o[0]=__builtin_amdgcn_mfma_f32_32x32x16_bf16(PAF(2),VFR(2),o[0],0,0,0), C1,0); \
    KRD(GL,3); GAPB(o[1]=__builtin_amdgcn_mfma_f32_32x32x16_bf16(PAF(2),VFR(6),o[1],0,0,0), C1,4); \
    GAPB(o[0]=__builtin_amdgcn_mfma_f32_32x32x16_bf16(PAF(3),VFR(3),o[0],0,0,0), C1,8); \
    GAPB(o[1]=__builtin_amdgcn_mfma_f32_32x32x16_bf16(PAF(3),VFR(7),o[1],0,0,0), C1,12); \
    }while(0)
  int t=1;
  #undef CMASK
  #define CMASK(P0,P1,t) do{}while(0)
  for(;t+5<NT;t+=2){
    STEP(pB0,pB1,pA0,pA1,t,true,true,true);     WAIT_BAR(2); RESC(); ROT();
    STEP(pA0,pA1,pB0,pB1,t+1,true,true,true);   WAIT_BAR(2); RESC(); ROT();
  }
  #undef CMASK
  #define CMASK(P0,P1,t) do{int jb_=(t)-(NT-4); if(jb_>=0)cmask(P0,P1,jb_,qrel,hi);}while(0)
  #define ENDW(tt) do{ if((tt)+3<NT){WAIT_BAR(2);} else if((tt)+2<NT){WAIT_BAR(1);} else {WAIT_BAR(0);} }while(0)
  for(;t+1<NT;t+=2){
    STEP(pB0,pB1,pA0,pA1,t,(t+3<NT),(t+1<NT),(t+1<NT));       ENDW(t);   RESC(); ROT();
    STEP(pA0,pA1,pB0,pB1,t+1,(t+4<NT),(t+2<NT),(t+2<NT));     ENDW(t+1); RESC(); ROT();
  }
  STEP(pB0,pB1,pA0,pA1,NT-1,false,false,false); RESC();
  MWAIT(); MAPPLY1(pB0); MLOAD_P1(NT-1); MWAIT(); MAPPLY1(pB1);
  { float sacc=pB0[0]+pB0[1]; _Pragma("unroll") for(int r=2;r<16;++r)sacc+=pB0[r]; _Pragma("unroll") for(int r=0;r<16;++r)sacc+=pB1[r]; l_reg+=sacc;
    pw0=(u32x4){PKW(pB0,0),PKW(pB0,2),PKW(pB0,4),PKW(pB0,6)};pw1=(u32x4){PKW(pB0,8),PKW(pB0,10),PKW(pB0,12),PKW(pB0,14)};pw2=(u32x4){PKW(pB1,0),PKW(pB1,2),PKW(pB1,4),PKW(pB1,6)};pw3=(u32x4){PKW(pB1,8),PKW(pB1,10),PKW(pB1,12),PKW(pB1,14)};
    SBAR(); pv(o,vb0+sl_cur,PAF(0),PAF(1),PAF(2),PAF(3)); }
  #undef PKW
  #undef PAF
  #undef VFR
  #undef PIN
  #undef MX3
  #undef GAPA
  #undef GAPB
  #undef EX
  #undef VRD
  #undef KRD
  #undef STEP
  #undef ENDW
  { const int lane=fresh_lane(),r32=lane&31,hi=lane>>5; float*wsf=(float*)(shm+LDS_WS)+wid*64;
  {auto rr=__builtin_amdgcn_permlane32_swap(__float_as_uint(l_reg),__float_as_uint(l_reg),false,false);l_reg=__uint_as_float(rr[0])+__uint_as_float(rr[1]);}
  if(hi==0)wsf[32+r32]=l_reg;asm volatile("s_waitcnt lgkmcnt(0)":::"memory");
  float rli[16];
  #pragma unroll
  for(int r=0;r<16;++r)rli[r]=__builtin_amdgcn_rcpf(wsf[32+crow(r,hi)]);
  bf16*Ow=O+(rowbase+q0+wid*QBLK)*OPITCH+h*D;
  { bf16*stg=(bf16*)(shm+LDS_OST)+wid*2048;
    #pragma unroll
    for(int r=0;r<16;++r){const int orow=crow(r,hi);
      #pragma unroll
      for(int d0=0;d0<2;++d0)stg[orow*64+d0*32+r32]=__float2bfloat16(o[d0][r]*rli[r]);}
    asm volatile("s_waitcnt lgkmcnt(0)":::"memory");
    #pragma unroll
    for(int i=0;i<4;++i){const int row=i*8+(lane>>3),ch=lane&7; const u32x4 v=*(const u32x4*)(stg+row*64+ch*8); ATTN_STORE16(Ow+(long)row*OPITCH+ch*8,v);} }
  }
  asm volatile("s_waitcnt lgkmcnt(0)\n\ts_barrier":::"memory");
  #undef DMA_K
  #undef DMA_V
  #undef CMASK
  #undef START
  #undef RESC
  #undef ROT
}
constexpr int ATTN_LDS_BYTES=LDS_BYTES;
struct AttnTensors { const bf16* Q; const bf16* K; const bf16* V; bf16* O; const unsigned long long* M; int wave; };
struct AttnUnit { int bh; int qb; };
struct StaticOrder {
  int vcu;
  __device__ __forceinline__ explicit StaticOrder(int grid,int block):vcu((block%8)*(grid/8)+block/8){}
  __device__ __forceinline__ bool next(int i,AttnUnit&u)const{ if(i>=2)return false; const int s=vcu&15; u.bh=vcu>>4; u.qb=(i==0)?s:31-s; return true; }
  __device__ __forceinline__ void a_ready(const AttnUnit&)const{}
  __device__ __forceinline__ void done(const AttnUnit&)const{}
};
template<class Sched,int THRL=8> __device__ __forceinline__ void attn_phase(char*lds,const AttnTensors&T,const Sched&S){
  AttnUnit u;
  for(int i=0;S.next(i,u);++i){ S.a_ready(u); attn_unit<THRL>(u.bh/NHEAD,u.bh%NHEAD,u.qb,T.Q,T.K,T.V,T.O,T.M,lds,T.wave); S.done(u); }
}
#undef SBAR
#undef WAIT_BAR
#undef MLOAD_P0
#undef MLOAD_P1
#undef MAP1
#undef MAPPLY1
#undef MWAIT
}
namespace pg8 {
#define PG8_LAS __attribute__((address_space(3)))
typedef unsigned short bf16_t;
typedef short bf16x8 __attribute__((ext_vector_type(8)));
typedef float f32x4 __attribute__((ext_vector_type(4)));
typedef unsigned u32x4 __attribute__((ext_vector_type(4)));
constexpr int BM = 256, BK = 64, HALF = 128, HTB = HALF * BK * 2  , STAGE_BYTES = 8 * HTB, NXCD = 8, WGM = 8;

__host__ __device__ __forceinline__ int lds_byte(int r, int c) { const int st = (r >> 4) * 2 + (c >> 5), rr = r & 15, cc = c & 31, ob = rr * 64 + cc * 2; return st * 1024 + (ob ^ (((ob >> 9) & 1) << 5)); }
__host__ __device__ __forceinline__ void stage_rc(int b, int& R, int& C) { const int st = b / 1024, sb = b % 1024, swz = sb ^ (((sb >> 9) & 1) << 5); R = (st >> 1) * 16 + swz / 64; C = (st & 1) * 32 + (swz % 64) / 2; }
__host__ __device__ __forceinline__ int perm32(int rho) { const int n = rho >> 4, i = rho & 15; return 8 * (i >> 2) + 4 * n + (i & 3); }

struct Unit { int pm, pn; };
struct Gemm { const bf16_t* A; const bf16_t* Bt; int M, N, K, wave; };

struct StaticOrder {
    int nM, nN, nwg, G, c;
    __host__ __device__ void init(int M, int N, int G_, int c_) { nM = M / BM; nN = N / BM; nwg = nM * nN; G = G_; c = c_; }
    __host__ __device__ bool next(int i, Unit& u) const {
        const long L = (long)i * G + c; if (L >= nwg) return false;
        int wgid = (int)L; { const int q = nwg / NXCD, r = nwg % NXCD, xcd = wgid % NXCD, off = wgid / NXCD; wgid = (xcd < r ? xcd * (q + 1) : r * (q + 1) + (xcd - r) * q) + off; }
        const int nig = WGM * nN, gid = wgid / nig, fm = gid * WGM, gsz = (nM - fm) < WGM ? (nM - fm) : WGM;
        u.pm = fm + ((wgid % nig) % gsz); u.pn = (wgid % nig) / gsz; return true;
    }
    __device__ __forceinline__ void a_ready(const Unit&) const {}
    __device__ __forceinline__ void done(const Unit&) const {}
};

__device__ __forceinline__ unsigned cvt_pk_bf16(float lo, float hi) { unsigned r; asm volatile("v_cvt_pk_bf16_f32 %0, %1, %2" : "=v"(r) : "v"(lo), "v"(hi)); return r; }
typedef float f32x2 __attribute__((ext_vector_type(2)));
template <class Epi, class Sched, bool ALIGN_EPI = false, bool SP2 = false>
__device__ __forceinline__ void gemm_phase(PG8_LAS unsigned char* lds, const Gemm g, const Sched& S, const Epi& E) {
    const int wid = g.wave, lane = fresh_lane(), tid = wid * 64 + lane, wr = wid >> 2, wc = wid & 3, fr = lane & 15, fq = lane >> 4;
    const int K = g.K, nt = K / BK;
    unsigned voffA[2], voffB[2];
#pragma unroll
    for (int i = 0; i < 2; ++i) { int R, C; stage_rc(tid * 16 + i * 8192, R, C); const int Rb = Epi::PERM ? ((R & ~31) + perm32(R & 31)) : R;
        voffA[i] = (unsigned)(R * K + C) * 2u; voffB[i] = (unsigned)(Rb * K + C) * 2u; }
    const size_t kstep = (size_t)(BK * 2);
    const size_t hstep = (size_t)HALF * K * 2;
    const size_t tstep = 2 * hstep;
    const unsigned ldsw = (unsigned)wid * 1024u;
    const int aoff = lds_byte(wr * 64 + fr, fq * 8), boff = lds_byte(wc * 32 + fr, fq * 8);
#define PG8_SA(b, h) (((b) * 2 + (h)) * HTB)
#define PG8_SB(b, h) ((4 + (b) * 2 + (h)) * HTB)
#define PG8_STAGE(bufoff, gbase, voff) do { _Pragma("unroll") for (int _i = 0; _i < 2; ++_i) \
        __builtin_amdgcn_global_load_lds((const unsigned*)((const char*)(gbase) + (voff)[_i]), (PG8_LAS unsigned*)(lds + (bufoff) + ldsw + _i * 8192), 16, 0, 0); } while (0)
#define PG8_LDA(dst, b, h) do { _Pragma("unroll") for (int m = 0; m < 4; ++m) _Pragma("unroll") for (int k = 0; k < 2; ++k) dst[m][k] = *(const PG8_LAS bf16x8*)(lds + PG8_SA(b, h) + aoff + m * 2048 + k * 1024); } while (0)
#define PG8_LDB(dst, b, h) do { _Pragma("unroll") for (int n = 0; n < 2; ++n) _Pragma("unroll") for (int k = 0; k < 2; ++k) dst[n][k] = *(const PG8_LAS bf16x8*)(lds + PG8_SB(b, h) + boff + n * 2048 + k * 1024); } while (0)
#define PG8_MMA(ai, bj, At, Bt) do { __builtin_amdgcn_s_setprio(1); _Pragma("unroll") for (int m = 0; m < 4; ++m) _Pragma("unroll") for (int n = 0; n < 2; ++n) _Pragma("unroll") for (int k = 0; k < 2; ++k) \
        acc[ai][bj][m][n] = __builtin_amdgcn_mfma_f32_16x16x32_bf16(Bt[n][k], At[m][k], acc[ai][bj][m][n], 0, 0, 0); __builtin_amdgcn_s_setprio(0); } while (0)
#define PG8_WAIT_V(n) asm volatile("s_waitcnt vmcnt(" #n ")" ::: "memory")
#define PG8_WAIT_L(n) asm volatile("s_waitcnt lgkmcnt(" #n ")" ::: "memory")
#define PG8_BAR __builtin_amdgcn_s_barrier()
#define PG8_SCHED __builtin_amdgcn_sched_barrier(0)
    Unit cur, nxt; int ui = 0;
    if (!S.next(0, cur)) return;
    f32x4 acc[2][2][4][2];
#pragma unroll
    for (int a = 0; a < 2; ++a)
#pragma unroll
        for (int b = 0; b < 2; ++b)
#pragma unroll
            for (int m = 0; m < 4; ++m)
#pragma unroll
                for (int n = 0; n < 2; ++n) acc[a][b][m][n] = (f32x4){0.f, 0.f, 0.f, 0.f};
    bf16x8 At[4][2], B0[2][2], B1[2][2];
    const char* cA = (const char*)g.A + (size_t)cur.pm * tstep; const char* cB = (const char*)g.Bt + (size_t)cur.pn * tstep;
    S.a_ready(cur);
    if constexpr (SP2) {
        PG8_STAGE(PG8_SB(0, 0), cB, voffB); PG8_STAGE(PG8_SB(0, 1), cB + hstep, voffB); PG8_STAGE(PG8_SA(0, 0), cA, voffA); PG8_STAGE(PG8_SA(0, 1), cA + hstep, voffA);
        if (wr == 1) PG8_BAR;
        PG8_WAIT_V(2); PG8_BAR;
        PG8_STAGE(PG8_SB(1, 0), cB + kstep, voffB); PG8_STAGE(PG8_SA(1, 0), cA + kstep, voffA); PG8_STAGE(PG8_SB(1, 1), cB + hstep + kstep, voffB);
        PG8_WAIT_V(6); PG8_BAR;
    } else {
        PG8_STAGE(PG8_SB(0, 0), cB, voffB); PG8_STAGE(PG8_SA(0, 0), cA, voffA); PG8_STAGE(PG8_SB(0, 1), cB + hstep, voffB); PG8_STAGE(PG8_SA(0, 1), cA + hstep, voffA);
        if (wr == 1) PG8_BAR;
        PG8_WAIT_V(4); PG8_BAR;
        PG8_STAGE(PG8_SB(1, 0), cB + kstep, voffB); PG8_STAGE(PG8_SA(1, 0), cA + kstep, voffA); PG8_STAGE(PG8_SB(1, 1), cB + hstep + kstep, voffB);
        PG8_WAIT_V(6); PG8_BAR;
    }
    for (;;) {
        const bool has_next = S.next(ui + 1, nxt);
        const char* nA = has_next ? (const char*)g.A + (size_t)nxt.pm * tstep : cA; const char* nB = has_next ? (const char*)g.Bt + (size_t)nxt.pn * tstep : cB;
        for (int t = 0; t < nt; t += 2) {
            const bool last = (t == nt - 2);
            const char* a1 = cA + (size_t)(t + 1) * kstep;
            const char* a2 = last ? nA : cA + (size_t)(t + 2) * kstep; const char* b2 = last ? nB : cB + (size_t)(t + 2) * kstep;
            const char* a3 = a2 + kstep; const char* b3 = b2 + kstep;
            if (last && has_next) S.a_ready(nxt);
            if constexpr (SP2) {
            PG8_LDB(B0, 0, 0); PG8_LDB(B1, 0, 1); PG8_SCHED; PG8_LDA(At, 0, 0); PG8_STAGE(PG8_SA(1, 1), a1 + hstep, voffA);
            PG8_WAIT_V(8); PG8_WAIT_L(0); PG8_BAR; PG8_MMA(0, 0, At, B0); PG8_MMA(0, 1, At, B1); PG8_BAR; PG8_SCHED;
            PG8_LDA(At, 0, 1); PG8_STAGE(PG8_SB(0, 0), b2, voffB); PG8_STAGE(PG8_SB(0, 1), b2 + hstep, voffB); PG8_STAGE(PG8_SA(0, 0), a2, voffA);
            PG8_WAIT_V(8); PG8_WAIT_L(0); PG8_BAR; PG8_MMA(1, 0, At, B0); PG8_MMA(1, 1, At, B1); PG8_BAR; PG8_SCHED;
            PG8_LDB(B0, 1, 0); PG8_LDB(B1, 1, 1); PG8_SCHED; PG8_LDA(At, 1, 0); PG8_STAGE(PG8_SA(0, 1), a2 + hstep, voffA);
            PG8_WAIT_V(8); PG8_WAIT_L(0); PG8_BAR; PG8_MMA(0, 0, At, B0); PG8_MMA(0, 1, At, B1); PG8_BAR; PG8_SCHED;
            PG8_LDA(At, 1, 1); PG8_STAGE(PG8_SB(1, 0), b3, voffB); PG8_STAGE(PG8_SB(1, 1), b3 + hstep, voffB); PG8_STAGE(PG8_SA(1, 0), a3, voffA);
            PG8_WAIT_V(8); PG8_WAIT_L(0); PG8_BAR; PG8_MMA(1, 0, At, B0); PG8_MMA(1, 1, At, B1); PG8_BAR; PG8_SCHED;
            } else {
            PG8_LDB(B0, 0, 0); PG8_SCHED; PG8_LDA(At, 0, 0); PG8_STAGE(PG8_SA(1, 1), a1 + hstep, voffA);
            PG8_WAIT_L(8); PG8_BAR; PG8_WAIT_L(0); PG8_MMA(0, 0, At, B0); PG8_BAR; PG8_SCHED;
            PG8_LDB(B1, 0, 1); PG8_STAGE(PG8_SB(0, 0), b2, voffB);
            PG8_BAR; PG8_WAIT_L(0); PG8_MMA(0, 1, At, B1); PG8_BAR;
            PG8_LDA(At, 0, 1); PG8_STAGE(PG8_SA(0, 0), a2, voffA);
            PG8_BAR; PG8_WAIT_L(0); PG8_MMA(1, 0, At, B0); PG8_BAR; PG8_SCHED;
            PG8_STAGE(PG8_SB(0, 1), b2 + hstep, voffB);
            PG8_WAIT_V(6); PG8_BAR; PG8_MMA(1, 1, At, B1); PG8_BAR;
            PG8_LDB(B0, 1, 0); PG8_SCHED; PG8_LDA(At, 1, 0); PG8_STAGE(PG8_SA(0, 1), a2 + hstep, voffA);
            PG8_WAIT_L(8); PG8_BAR; PG8_WAIT_L(0); PG8_MMA(0, 0, At, B0); PG8_BAR; PG8_SCHED;
            PG8_LDB(B1, 1, 1); PG8_STAGE(PG8_SB(1, 0), b3, voffB);
            PG8_BAR; PG8_WAIT_L(0); PG8_MMA(0, 1, At, B1); PG8_BAR;
            PG8_LDA(At, 1, 1); PG8_STAGE(PG8_SA(1, 0), a3, voffA);
            PG8_BAR; PG8_WAIT_L(0); PG8_MMA(1, 0, At, B0); PG8_BAR; PG8_SCHED;
            PG8_STAGE(PG8_SB(1, 1), b3 + hstep, voffB);
            PG8_WAIT_V(6); PG8_BAR; PG8_MMA(1, 1, At, B1); PG8_BAR;
            }
        }
        if constexpr (ALIGN_EPI) { if (wr == 0) PG8_BAR; }
        if constexpr (!Epi::AFTER_DRAIN) { E(acc, cur, wr, wc, fr, fq); S.done(cur); }
        if (!has_next) break;
#pragma unroll
        for (int a = 0; a < 2; ++a)
#pragma unroll
            for (int b = 0; b < 2; ++b)
#pragma unroll
                for (int m = 0; m < 4; ++m)
#pragma unroll
                    for (int n = 0; n < 2; ++n) acc[a][b][m][n] = (f32x4){0.f, 0.f, 0.f, 0.f};
        cur = nxt; cA = nA; cB = nB; ++ui;
        if constexpr (ALIGN_EPI) { if (wr == 1) PG8_BAR; }
    }
    PG8_WAIT_V(0);
    if constexpr (!ALIGN_EPI) { if (wr == 0) PG8_BAR; }
    PG8_BAR;
    if constexpr (Epi::AFTER_DRAIN) { E.fused(acc, cur, wr, wc, fr, fq, lds, wid, lane); S.done(cur); }
#undef PG8_SA
#undef PG8_SB
#undef PG8_STAGE
#undef PG8_LDA
#undef PG8_LDB
#undef PG8_MMA
#undef PG8_WAIT_V
#undef PG8_WAIT_L
#undef PG8_BAR
#undef PG8_SCHED
}
}
#define GAS __attribute__((address_space(1)))
#define LAS __attribute__((address_space(3)))
#define RLX_AGENT __ATOMIC_RELAXED, __HIP_MEMORY_SCOPE_AGENT
#define XB_TMO      128
#define XB_XCNT(j)  (256  + 64 * (j))
#define XB_XSUB(j)  (1280 + 64 * (j))
#define XB_XGEN(j)  (2304 + 64 * (j))
#define XB_TOP      3328
#define XB_TOPGEN   3392
#define XCD_BAR_WORDS 3456
#define XB_SPIN_CAP (1u << 21)

__device__ __forceinline__ unsigned xb_ld(unsigned* p)              { return __hip_atomic_load(p, __ATOMIC_RELAXED, __HIP_MEMORY_SCOPE_AGENT); }
__device__ __forceinline__ unsigned xb_add(unsigned* p, unsigned v) { return __hip_atomic_fetch_add(p, v, __ATOMIC_RELAXED, __HIP_MEMORY_SCOPE_AGENT); }
__device__ __forceinline__ unsigned xb_xcc_id() { return (unsigned)__builtin_amdgcn_s_getreg((3 << 11) | 20) & 0xFu; }
#define XB_SPIN(cond, bar) do { unsigned _sp = 0; while (cond) { __builtin_amdgcn_s_sleep(1); \
    if ((++_sp & 255u) == 0u) { if (xb_ld(&(bar)[XB_TMO])) break; if (_sp > XB_SPIN_CAP) { atomicAdd(&(bar)[XB_TMO], 1u); break; } } } } while (0)

struct XcdBarrier {
    unsigned* bar; unsigned x; int wv;
    volatile LAS unsigned* st;
};

__device__ __forceinline__ XcdBarrier xcd_barrier_post(unsigned* bar, volatile LAS unsigned* st) {
    XcdBarrier b; b.bar = bar; b.x = xb_xcc_id(); b.st = st;
    if (threadIdx.x == 0) (void)xb_add(&bar[XB_XCNT(b.x)], 1u);
    return b;
}
__device__ __forceinline__ void xcd_barrier_complete(unsigned* bar, unsigned x, unsigned& nloc, unsigned& nx) {
    const unsigned G = gridDim.x * gridDim.y * gridDim.z;
    unsigned sum, cnt, mine, sp = 0u;
    for (;;) {
        sum = 0u; cnt = 0u; mine = 0u;
#pragma unroll
        for (unsigned j = 0; j < 16; ++j) { const unsigned c = xb_ld(&bar[XB_XCNT(j)]); sum += c; cnt += (c > 0u) ? 1u : 0u; mine = (j == x) ? c : mine; }
        if (sum == G) break;
        __builtin_amdgcn_s_sleep(1);
        if ((++sp & 255u) == 0u) { if (xb_ld(&bar[XB_TMO])) break; if (sp > XB_SPIN_CAP) { atomicAdd(&bar[XB_TMO], 1u); break; } }
    }
    nloc = mine > 0u ? mine : 1u; nx = cnt > 0u ? cnt : 1u;
}

__device__ __forceinline__ void xcd_barrier(const XcdBarrier& b) {
    asm volatile("s_waitcnt vmcnt(0)" ::: "memory");
    __syncthreads();
    if (b.wv == 0 && fresh_lane() == 0) {
        unsigned* bar = b.bar;
        __builtin_amdgcn_s_waitcnt(0);
        unsigned nloc = b.st[0], nx = b.st[1];
        if (nloc == 0u) { xcd_barrier_complete(bar, b.x, nloc, nx); b.st[0] = nloc; b.st[1] = nx; }
        const unsigned old = xb_add(&bar[XB_XSUB(b.x)], 1u);
        const unsigned gen = old / nloc;
        if (old + 1u == (gen + 1u) * nloc) {
            __builtin_amdgcn_fence(__ATOMIC_RELEASE, "agent");
            asm volatile("s_waitcnt vmcnt(0)" ::: "memory");
            const unsigned og = xb_add(&bar[XB_TOP], 1u);
            const unsigned tg = og / nx;
            if (og + 1u == (tg + 1u) * nx) xb_add(&bar[XB_TOPGEN], 1u);
            else XB_SPIN(xb_ld(&bar[XB_TOPGEN]) == tg, bar);
            __builtin_amdgcn_fence(__ATOMIC_ACQUIRE, "agent");
            xb_add(&bar[XB_XGEN(b.x)], 1u);
            asm volatile("s_waitcnt vmcnt(0)" ::: "memory");
        } else {
            XB_SPIN(xb_ld(&bar[XB_XGEN(b.x)]) == gen, bar);
            __builtin_amdgcn_fence(__ATOMIC_ACQUIRE, "agent");
            asm volatile("s_waitcnt vmcnt(0)" ::: "memory");
        }
    }
    __syncthreads();
}
#ifndef PROBE_DUP
#define PROBE_DUP -1
#endif
using pg8::bf16_t; using pg8::f32x4; using pg8::u32x4; using pg8::Unit; using pg8::cvt_pk_bf16;
typedef unsigned long long u64;
constexpr int DM = 1024, SEQ = 8192, NB = 2, MP = NB * SEQ, DB = 128, DS = 8, MS = DB * DS, MT = MP + MS;
constexpr int PAST = 2048, PAGE = 128, NPAGES = 16;
constexpr int DCONV = 512, NH = 8, HD = 64, TOPK = 256;
constexpr int NMEM = 256, MH = 4, MHD = 256, DFF = 2816;
constexpr int DIN = 3656, DINP = 3840;
constexpr float EPS = 1e-6f;
constexpr int SPITCH = 2112;
constexpr int NWAVES = 8, NTHREADS = 512;
constexpr int NPHASE = 12;
constexpr int N_LAUNCHES = MK_N_LAUNCHES;

constexpr size_t OFF_Y_P = 0, OFF_Y_S = 16777216, OFF_K_P = 17825792, OFF_V_P = 26214400, OFF_IK_P = 34603008, OFF_CM_P = 35651584, OFF_CF_P = 35653632,
                 OFF_MK_P = 35664896, OFF_MV_P = 36189184, OFF_K_S = 36713472, OFF_V_S = 37237760, OFF_IK_S = 37762048, OFF_CM_S = 37827584, OFF_CF_S = 37958656, OUT_TOTAL = 38679552;

constexpr size_t MiB = 1u << 20;
constexpr size_t WS_CTL = 0, CTL_ZERO_BYTES = 1 * MiB;
constexpr size_t ACC_SS1 = 65536, ACC_SS2 = 139264, ACC_SSQ = 212992, ACC_SSK = 491520;
constexpr size_t WS_WIN = 1 * MiB, WS_WOUT = 9 * MiB, WS_WQ = 11 * MiB, WS_WKV = 13 * MiB, WS_WO = 17 * MiB, WS_WGU = 19 * MiB, WS_WDOWN = 30 * MiB;
constexpr size_t WS_COS = 36 * MiB, WS_SIN = 37 * MiB, WS_RSTD = 38 * MiB, WS_IW = 39 * MiB;
constexpr size_t WS_XB = 40 * MiB, WS_MEMB = 74 * MiB, WS_QIF = 75 * MiB  , WS_CB = 78 * MiB, WS_U = 95 * MiB;
constexpr size_t WS_Q = 112 * MiB, WS_K = 129 * MiB, WS_V = 146 * MiB, WS_QI = 163 * MiB, WS_KI = 180 * MiB, WS_AMIX = 183 * MiB;
constexpr size_t WS_H1 = 217 * MiB, WS_H1B = 285 * MiB, WS_QMEM = 319 * MiB, WS_OMEM = 353 * MiB, WS_H2 = 387 * MiB, WS_H2B = 455 * MiB;
constexpr size_t WS_SIDEG = 489 * MiB, WS_SIDEU = 491 * MiB, WS_LASTG = 493 * MiB, WS_G = 496 * MiB, WS_UP = 676 * MiB, WS_AFF = 770 * MiB, WS_SC = 864 * MiB, WS_SCS = 1376 * MiB, WS_SEL = 1385 * MiB, WS_CNT = 1403 * MiB, WS_MASK = 1404 * MiB, WS_MKF = 1420 * MiB, WS_MVF = 1421 * MiB, WS_END = 1422 * MiB;

constexpr int CW_BAR = 4096;
constexpr int CQ_PH2 = 1024, CQ_PH7 = 1536;
constexpr int RING_BYTES = 131072, MISC_OFF = RING_BYTES + 320, HALO_OFF = RING_BYTES + 1024, LDS_BYTES = 147456;

#define GAS __attribute__((address_space(1)))
#define LAS __attribute__((address_space(3)))
#define LDS_WAIT() asm volatile("s_waitcnt lgkmcnt(0)" ::: "memory")
typedef short bf16x8 __attribute__((ext_vector_type(8)));
typedef float f32x16 __attribute__((ext_vector_type(16)));

__device__ __forceinline__ float bf2f(unsigned b) { return __uint_as_float(b << 16); }
__device__ __forceinline__ float wave_sum(float v) {
#pragma unroll
    for (int o = 1; o < 64; o <<= 1) v += __shfl_xor(v, o);
    return v;
}
__device__ __forceinline__ float wave_max(float v) {
#pragma unroll
    for (int o = 1; o < 64; o <<= 1) v = fmaxf(v, __shfl_xor(v, o));
    return v;
}
__device__ __forceinline__ void store8_bf16(bf16_t* p, const float* v) {
    u32x4 w; w.x = cvt_pk_bf16(v[0], v[1]); w.y = cvt_pk_bf16(v[2], v[3]); w.z = cvt_pk_bf16(v[4], v[5]); w.w = cvt_pk_bf16(v[6], v[7]);
    *(u32x4*)p = w;
}
__device__ __forceinline__ void store8_f32(float* p, const float* v) {
    *(f32x4*)p = (f32x4){v[0], v[1], v[2], v[3]}; *(f32x4*)(p + 4) = (f32x4){v[4], v[5], v[6], v[7]};
}
__device__ __forceinline__ void load8_f32(const float* p, float* v) {
    const f32x4 a = *(const f32x4*)p, b = *(const f32x4*)(p + 4);
    v[0] = a.x; v[1] = a.y; v[2] = a.z; v[3] = a.w; v[4] = b.x; v[5] = b.y; v[6] = b.z; v[7] = b.w;
}
__device__ __forceinline__ void load8_bf16(const bf16_t* p, float* v) {
    const u32x4 w = *(const u32x4*)p;
    v[0] = bf2f(w.x & 0xffffu); v[1] = bf2f(w.x >> 16); v[2] = bf2f(w.y & 0xffffu); v[3] = bf2f(w.y >> 16);
    v[4] = bf2f(w.z & 0xffffu); v[5] = bf2f(w.z >> 16); v[6] = bf2f(w.w & 0xffffu); v[7] = bf2f(w.w >> 16);
}

struct Args { const void* in[29]; float* out; unsigned char* ws; int ph_lo, ph_hi; };
struct Ctx {
    const float *x_p, *x_s, *cache_k, *cache_v, *cache_ik, *st_mix, *st_ffn, *cmem_k, *cmem_v; const int* page_table; const float* mem_p;
    const float *g_mix, *w_in, *conv_mix_w, *q_g, *k_g, *w_out, *g_mem, *g_mem_src, *w_q, *w_kv, *mq_g, *mk_g, *w_o, *g_ffn, *w_gu, *conv_ffn_w, *conv_ffn_b, *w_down;
    float* out; unsigned char* ws;
    int tid, lane, wave, G, bid;
};

#define EPI_ROWS(ai, m) (u.pm * 256 + (ai) * 128 + wr * 64 + (m) * 16 + fr)
#define EPI_GET(dst, ai, bj, m, s) do { _Pragma("unroll") for (int e_ = 0; e_ < 4; ++e_) { (dst)[e_] = acc[ai][bj][m][0][e_] * (s); (dst)[4 + e_] = acc[ai][bj][m][1][e_] * (s); } } while (0)

struct EpiIn {
    static constexpr bool PERM = true, AFTER_DRAIN = false;
    const float* rstd; const float* cosT; const float* sinT; const float* qg; const float* kg;
    bf16_t *cbb, *ub, *qb, *kb, *vb, *qib, *kib; float* iwf; float* qif; float* out;
    __device__ __forceinline__ void operator()(const f32x4 (&acc)[2][2][4][2], const Unit& u, int wr, int wc, int fr, int fq) const {
        const int pn = u.pn; const int c8 = wc * 32 + 8 * fq; const bool samp = (u.pm >= 64);
#pragma unroll
        for (int ai = 0; ai < 2; ++ai) {
            float rsa[4];
#pragma unroll
            for (int m = 0; m < 4; ++m) rsa[m] = rstd[EPI_ROWS(ai, m)];
#pragma unroll
            for (int m = 0; m < 4; ++m) {
                const int r = EPI_ROWS(ai, m); const float rs = rsa[m];
                float lo[8], hi[8]; EPI_GET(lo, ai, 0, m, rs); EPI_GET(hi, ai, 1, m, rs);
                const int rl = samp ? r - MP : r; const int pos = samp ? PAST + (rl & 7) : (rl & (SEQ - 1));
                if (pn < 2) {
                    store8_bf16(cbb + (size_t)r * 512 + pn * 256 + c8, lo); store8_bf16(cbb + (size_t)r * 512 + pn * 256 + 128 + c8, hi);
                } else if (pn < 6) {
                    const int ch = 128 * (pn - 2) + c8; float uu[8];
#pragma unroll
                    for (int e = 0; e < 8; ++e) uu[e] = lo[e] * hi[e];
                    store8_bf16(ub + (size_t)r * 512 + ch, uu);
                    if (!samp) { const int t = rl & (SEQ - 1); if (t >= SEQ - 2) store8_f32(out + OFF_CM_P + (size_t)((rl >> 13) * 2 + (t - (SEQ - 2))) * 512 + ch, uu); }
                    else { const int tt = rl & 7; if (tt >= 6) store8_f32(out + OFF_CM_S + (size_t)((rl >> 3) * 2 + (tt - 6)) * 512 + ch, uu); }
                } else if (pn < 10 || pn == 12 || pn == 13) {
                    const int head = 4 * (pn & 1) + wc; const int d0 = 8 * fq;
                    if (pn < 10) {
                        float ss = 0.f;
#pragma unroll
                        for (int e = 0; e < 8; ++e) ss += lo[e] * lo[e] + hi[e] * hi[e];
                        ss += __shfl_xor(ss, 16); ss += __shfl_xor(ss, 32);
                        const float rn = 1.0f / sqrtf(ss * (1.f / 64.f) + EPS);
                        const float* g = (pn < 8) ? qg : kg; float gl[8], gh[8]; load8_f32(g + d0, gl); load8_f32(g + 32 + d0, gh);
#pragma unroll
                        for (int e = 0; e < 8; ++e) { lo[e] *= rn * gl[e]; hi[e] *= rn * gh[e]; }
                    }
                    float cs[8], sn[8]; load8_f32(cosT + (size_t)pos * 32 + d0, cs); load8_f32(sinT + (size_t)pos * 32 + d0, sn);
                    float ol[8], oh[8];
#pragma unroll
                    for (int e = 0; e < 8; ++e) { ol[e] = lo[e] * cs[e] - hi[e] * sn[e]; oh[e] = hi[e] * cs[e] + lo[e] * sn[e]; }
                    const size_t o512 = (size_t)r * 512 + head * 64 + d0;
                    if (pn < 8) {
#pragma unroll
                        for (int e = 0; e < 8; ++e) { ol[e] *= 0.18033688011112042f; oh[e] *= 0.18033688011112042f; }
                        store8_bf16(qb + o512, ol); store8_bf16(qb + o512 + 32, oh);
                    } else if (pn < 10) {
                        store8_bf16(kb + o512, ol); store8_bf16(kb + o512 + 32, oh);
                        float* ko = out + (samp ? OFF_K_S : OFF_K_P) + (size_t)rl * 512 + head * 64 + d0; store8_f32(ko, ol); store8_f32(ko + 32, oh);
                    } else {
                        store8_bf16(qib + o512, ol); store8_bf16(qib + o512 + 32, oh);
                    }
                } else if (pn < 12) {
                    const int c = 256 * (pn - 10) + c8;
                    store8_bf16(vb + (size_t)r * 512 + c, lo); store8_bf16(vb + (size_t)r * 512 + c + 128, hi);
                    float* vo = out + (samp ? OFF_V_S : OFF_V_P) + (size_t)rl * 512 + c; store8_f32(vo, lo); store8_f32(vo + 128, hi);
                } else {
                    if (wc == 0) {
                        const int d0 = 8 * fq; float cs[8], sn[8]; load8_f32(cosT + (size_t)pos * 32 + d0, cs); load8_f32(sinT + (size_t)pos * 32 + d0, sn);
                        float ol[8], oh[8];
#pragma unroll
                        for (int e = 0; e < 8; ++e) { ol[e] = lo[e] * cs[e] - hi[e] * sn[e]; oh[e] = hi[e] * cs[e] + lo[e] * sn[e]; }
                        store8_bf16(kib + (size_t)r * 64 + d0, ol); store8_bf16(kib + (size_t)r * 64 + 32 + d0, oh);
                        float* io = out + (samp ? OFF_IK_S : OFF_IK_P) + (size_t)rl * 64 + d0; store8_f32(io, ol); store8_f32(io + 32, oh);
                    } else if (wc == 1 && fq == 0) {
                        store8_f32(iwf + (size_t)r * 8, lo);
                    }
                }
            }
        }
    }
};

struct EpiKv {
    static constexpr bool PERM = true, AFTER_DRAIN = false;
    const float* rstd; float* ssk; float* out;
    __device__ __forceinline__ void operator()(const f32x4 (&acc)[2][2][4][2], const Unit& u, int wr, int wc, int fr, int fq) const {
        const int pn = u.pn; const int c8 = wc * 32 + 8 * fq;
        float rsv[2][4];
#pragma unroll
        for (int ai = 0; ai < 2; ++ai)
#pragma unroll
            for (int m = 0; m < 4; ++m) rsv[ai][m] = rstd[EPI_ROWS(ai, m)];
#pragma unroll
        for (int ai = 0; ai < 2; ++ai)
#pragma unroll
            for (int m = 0; m < 4; ++m) {
                const int r = EPI_ROWS(ai, m); const float rs = rsv[ai][m];
                float lo[8], hi[8]; EPI_GET(lo, ai, 0, m, rs); EPI_GET(hi, ai, 1, m, rs);
                if (pn < 4) {
                    float* o = out + OFF_MK_P + (size_t)r * 1024 + pn * 256 + c8; store8_f32(o, lo); store8_f32(o + 128, hi);
                    float ss = 0.f;
#pragma unroll
                    for (int e = 0; e < 8; ++e) ss += lo[e] * lo[e] + hi[e] * hi[e];
                    ss += __shfl_xor(ss, 16); ss += __shfl_xor(ss, 32);
                    if (fq == 0) atomicAdd(ssk + r * 4 + pn, ss);
                } else {
                    float* o = out + OFF_MV_P + (size_t)r * 1024 + (pn - 4) * 256 + c8; store8_f32(o, lo); store8_f32(o + 128, hi);
                }
            }
    }
    __device__ __forceinline__ void small8(int r, int c, const f32x4& v0, const f32x4& v1) const {
        const float rs = rstd[r];
        float v[8] = {v0.x * rs, v0.y * rs, v0.z * rs, v0.w * rs, v1.x * rs, v1.y * rs, v1.z * rs, v1.w * rs};
        if (c < 1024) {
            store8_f32(out + OFF_MK_P + (size_t)r * 1024 + c, v);
            float ss = 0.f;
#pragma unroll
            for (int e = 0; e < 8; ++e) ss += v[e] * v[e];
            ss += __shfl_xor(ss, 1); ss += __shfl_xor(ss, 2); ss += __shfl_xor(ss, 4);
            if ((fresh_lane() & 7) == 0) atomicAdd(ssk + r * 4 + (c >> 8), ss);
        } else store8_f32(out + OFF_MV_P + (size_t)r * 1024 + (c - 1024), v);
    }
};

struct EpiRes {
    static constexpr bool PERM = true, AFTER_DRAIN = false;
    const float* resP; const float* resS; const bf16_t* resB; float* dstP; float* dstS; bf16_t* dstB; float* ss;
    __device__ __forceinline__ void row(const f32x4 (&acc)[2][2][4][2], int ai, int m, int r, int rl, bool samp, int c8, int fq, const float* a, const float* b) const {
        float lo[8], hi[8]; EPI_GET(lo, ai, 0, m, 1.f); EPI_GET(hi, ai, 1, m, 1.f);
        float s2 = 0.f;
#pragma unroll
        for (int e = 0; e < 8; ++e) { lo[e] += a[e]; hi[e] += b[e]; s2 += lo[e] * lo[e] + hi[e] * hi[e]; }
        if (dstP) { float* dp = (samp ? dstS : dstP) + (size_t)rl * 1024 + c8; store8_f32(dp, lo); store8_f32(dp + 128, hi); }
        if (dstB) { store8_bf16(dstB + (size_t)r * 1024 + c8, lo); store8_bf16(dstB + (size_t)r * 1024 + c8 + 128, hi); }
        if (ss) { s2 += __shfl_xor(s2, 16); s2 += __shfl_xor(s2, 32); if (fq == 0) atomicAdd(ss + r, s2); }
    }
    __device__ __forceinline__ void operator()(const f32x4 (&acc)[2][2][4][2], const Unit& u, int wr, int wc, int fr, int fq) const {
        const bool samp = (u.pm >= 64); const int c8 = u.pn * 256 + wc * 32 + 8 * fq;
        if (resB) {
#pragma unroll
            for (int ai = 0; ai < 2; ++ai) {
                u32x4 ra[4], rb[4];
#pragma unroll
                for (int m = 0; m < 4; ++m) { const int r = EPI_ROWS(ai, m); ra[m] = *(const u32x4*)(resB + (size_t)r * 1024 + c8); rb[m] = *(const u32x4*)(resB + (size_t)r * 1024 + c8 + 128); }
#pragma unroll
                for (int m = 0; m < 4; ++m) { const int r = EPI_ROWS(ai, m); const int rl = samp ? r - MP : r; float a[8], b[8];
                    const u32x4 wa = ra[m], wb = rb[m];
                    a[0] = bf2f(wa.x & 0xffffu); a[1] = bf2f(wa.x >> 16); a[2] = bf2f(wa.y & 0xffffu); a[3] = bf2f(wa.y >> 16); a[4] = bf2f(wa.z & 0xffffu); a[5] = bf2f(wa.z >> 16); a[6] = bf2f(wa.w & 0xffffu); a[7] = bf2f(wa.w >> 16);
                    b[0] = bf2f(wb.x & 0xffffu); b[1] = bf2f(wb.x >> 16); b[2] = bf2f(wb.y & 0xffffu); b[3] = bf2f(wb.y >> 16); b[4] = bf2f(wb.z & 0xffffu); b[5] = bf2f(wb.z >> 16); b[6] = bf2f(wb.w & 0xffffu); b[7] = bf2f(wb.w >> 16);
                    row(acc, ai, m, r, rl, samp, c8, fq, a, b); }
            }
        } else {
#pragma unroll
            for (int ai = 0; ai < 2; ++ai) {
                f32x4 fa[4][2], fb[4][2];
#pragma unroll
                for (int m = 0; m < 4; ++m) { const int r = EPI_ROWS(ai, m); const int rl = samp ? r - MP : r; const float* rp = (samp ? resS : resP) + (size_t)rl * 1024 + c8;
                    fa[m][0] = *(const f32x4*)rp; fa[m][1] = *(const f32x4*)(rp + 4); fb[m][0] = *(const f32x4*)(rp + 128); fb[m][1] = *(const f32x4*)(rp + 132); }
#pragma unroll
                for (int m = 0; m < 4; ++m) { const int r = EPI_ROWS(ai, m); const int rl = samp ? r - MP : r;
                    const float a[8] = {fa[m][0].x, fa[m][0].y, fa[m][0].z, fa[m][0].w, fa[m][1].x, fa[m][1].y, fa[m][1].z, fa[m][1].w};
                    const float b[8] = {fb[m][0].x, fb[m][0].y, fb[m][0].z, fb[m][0].w, fb[m][1].x, fb[m][1].y, fb[m][1].z, fb[m][1].w};
                    row(acc, ai, m, r, rl, samp, c8, fq, a, b); }
            }
        }
    }
    __device__ __forceinline__ void small8(int r, int c, const f32x4& v0, const f32x4& v1) const {
        const int rl = r - MP; f32x4 a, b;
        if (resB) { const u32x4 w = *(const u32x4*)(resB + (size_t)r * 1024 + c);
            a = (f32x4){bf2f(w.x & 0xffffu), bf2f(w.x >> 16), bf2f(w.y & 0xffffu), bf2f(w.y >> 16)}; b = (f32x4){bf2f(w.z & 0xffffu), bf2f(w.z >> 16), bf2f(w.w & 0xffffu), bf2f(w.w >> 16)}; }
        else { const float* rp = resS + (size_t)rl * 1024 + c; a = *(const f32x4*)rp; b = *(const f32x4*)(rp + 4); }
        a = a + v0; b = b + v1;
        if (dstS) { float* dp = dstS + (size_t)rl * 1024 + c; *(f32x4*)dp = a; *(f32x4*)(dp + 4) = b; }
        if (dstB) { u32x4 w; w.x = cvt_pk_bf16(a.x, a.y); w.y = cvt_pk_bf16(a.z, a.w); w.z = cvt_pk_bf16(b.x, b.y); w.w = cvt_pk_bf16(b.z, b.w); *(u32x4*)(dstB + (size_t)r * 1024 + c) = w; }
        if (ss) { float s2 = (a.x * a.x + a.y * a.y) + (a.z * a.z + a.w * a.w) + (b.x * b.x + b.y * b.y) + (b.z * b.z + b.w * b.w);
            s2 += __shfl_xor(s2, 1); s2 += __shfl_xor(s2, 2); s2 += __shfl_xor(s2, 4); if ((c & 63) == 0) atomicAdd(ss + r, s2); }
    }
    __device__ __forceinline__ void small(int r, int c, int q, const f32x4& v0, const f32x4& v1) const {
        const int rl = r - MP; f32x4 a, b;
        if (resB) { const u64 w0 = *(const u64*)(resB + (size_t)r * 1024 + c), w1 = *(const u64*)(resB + (size_t)r * 1024 + c + 16);
            a = (f32x4){bf2f((unsigned)w0 & 0xffffu), bf2f(((unsigned)w0) >> 16), bf2f((unsigned)(w0 >> 32) & 0xffffu), bf2f((unsigned)(w0 >> 48))};
            b = (f32x4){bf2f((unsigned)w1 & 0xffffu), bf2f(((unsigned)w1) >> 16), bf2f((unsigned)(w1 >> 32) & 0xffffu), bf2f((unsigned)(w1 >> 48))}; }
        else { const float* rp = resS + (size_t)rl * 1024 + c; a = *(const f32x4*)rp; b = *(const f32x4*)(rp + 16); }
        a = a + v0; b = b + v1;
        if (dstS) { float* dp = dstS + (size_t)rl * 1024 + c; *(f32x4*)dp = a; *(f32x4*)(dp + 16) = b; }
        if (dstB) { bf16_t* bp = dstB + (size_t)r * 1024 + c; *(u64*)bp = (u64)cvt_pk_bf16(a.x, a.y) | ((u64)cvt_pk_bf16(a.z, a.w) << 32); *(u64*)(bp + 16) = (u64)cvt_pk_bf16(b.x, b.y) | ((u64)cvt_pk_bf16(b.z, b.w) << 32); }
        if (ss) { float s2 = (a.x * a.x + a.y * a.y) + (a.z * a.z + a.w * a.w) + (b.x * b.x + b.y * b.y) + (b.z * b.z + b.w * b.w); s2 += __shfl_xor(s2, 16); s2 += __shfl_xor(s2, 32); if (q == 0) atomicAdd(ss + r, s2); }
    }
};

struct EpiQm {
    static constexpr bool PERM = true, AFTER_DRAIN = false;
    const float* ss1; const float* mqg; bf16_t* qmem; float* ssq;
    __device__ __forceinline__ void operator()(const f32x4 (&acc)[2][2][4][2], const Unit& u, int wr, int wc, int fr, int fq) const {
        const int c8 = wc * 32 + 8 * fq; float gl[8], gh[8]; load8_f32(mqg + c8, gl); load8_f32(mqg + 128 + c8, gh);
        float rsv[2][4];
#pragma unroll
        for (int ai = 0; ai < 2; ++ai)
#pragma unroll
            for (int m = 0; m < 4; ++m) rsv[ai][m] = __builtin_amdgcn_rsqf(ss1[EPI_ROWS(ai, m)] * (1.f / 1024.f) + EPS);
#pragma unroll
        for (int ai = 0; ai < 2; ++ai)
#pragma unroll
            for (int m = 0; m < 4; ++m) {
                const int r = EPI_ROWS(ai, m); const float rs = rsv[ai][m];
                float lo[8], hi[8]; EPI_GET(lo, ai, 0, m, rs); EPI_GET(hi, ai, 1, m, rs);
                float s2 = 0.f;
#pragma unroll
                for (int e = 0; e < 8; ++e) { s2 += lo[e] * lo[e] + hi[e] * hi[e]; lo[e] *= gl[e]; hi[e] *= gh[e]; }
                s2 += __shfl_xor(s2, 16); s2 += __shfl_xor(s2, 32); if (fq == 0) atomicAdd(ssq + r * 4 + u.pn, s2);
                bf16_t* o = qmem + (size_t)r * 1024 + u.pn * 256 + c8; store8_bf16(o, lo); store8_bf16(o + 128, hi);
            }
    }
    __device__ __forceinline__ void small8(int r, int c, const f32x4& v0, const f32x4& v1) const {
        const float rs = __builtin_amdgcn_rsqf(ss1[r] * (1.f / 1024.f) + EPS); const f32x4 a = v0 * rs, b = v1 * rs;
        float s2 = (a.x * a.x + a.y * a.y) + (a.z * a.z + a.w * a.w) + (b.x * b.x + b.y * b.y) + (b.z * b.z + b.w * b.w); s2 += __shfl_xor(s2, 1); s2 += __shfl_xor(s2, 2); s2 += __shfl_xor(s2, 4);
        if ((c & 63) == 0) atomicAdd(ssq + r * 4 + (c >> 8), s2);
        const f32x4 g0 = *(const f32x4*)(mqg + (c & 255)), g1 = *(const f32x4*)(mqg + (c & 255) + 4); const f32x4 x = a * g0, y = b * g1;
        u32x4 w; w.x = cvt_pk_bf16(x.x, x.y); w.y = cvt_pk_bf16(x.z, x.w); w.z = cvt_pk_bf16(y.x, y.y); w.w = cvt_pk_bf16(y.z, y.w); *(u32x4*)(qmem + (size_t)r * 1024 + c) = w;
    }
    __device__ __forceinline__ void small(int r, int c, int q, const f32x4& v0, const f32x4& v1) const {
        const float rs = 1.0f / sqrtf(ss1[r] * (1.f / 1024.f) + EPS); const f32x4 a = v0 * rs, b = v1 * rs;
        float s2 = (a.x * a.x + a.y * a.y) + (a.z * a.z + a.w * a.w) + (b.x * b.x + b.y * b.y) + (b.z * b.z + b.w * b.w); s2 += __shfl_xor(s2, 16); s2 += __shfl_xor(s2, 32);
        if (q == 0) atomicAdd(ssq + r * 4 + (c >> 8), s2);
        const f32x4 g0 = *(const f32x4*)(mqg + (c & 255)), g1 = *(const f32x4*)(mqg + (c & 255) + 16); const f32x4 x = a * g0, y = b * g1;
        bf16_t* bp = qmem + (size_t)r * 1024 + c; *(u64*)bp = (u64)cvt_pk_bf16(x.x, x.y) | ((u64)cvt_pk_bf16(x.z, x.w) << 32); *(u64*)(bp + 16) = (u64)cvt_pk_bf16(y.x, y.y) | ((u64)cvt_pk_bf16(y.z, y.w) << 32);
    }
};

#define DPP_SHR1(old, x) __builtin_bit_cast(float, __builtin_amdgcn_update_dpp(__builtin_bit_cast(int, (old)), __builtin_bit_cast(int, (x)), 0x111, 0xF, 0xF, false))
#define DPP_SHR2(old, x) __builtin_bit_cast(float, __builtin_amdgcn_update_dpp(__builtin_bit_cast(int, (old)), __builtin_bit_cast(int, (x)), 0x112, 0xF, 0xF, false))
#define DPP_ROR1(x) __builtin_bit_cast(float, __builtin_amdgcn_update_dpp(0, __builtin_bit_cast(int, (x)), 0x121, 0xF, 0xF, true))
#define DPP_ROR2(x) __builtin_bit_cast(float, __builtin_amdgcn_update_dpp(0, __builtin_bit_cast(int, (x)), 0x122, 0xF, 0xF, true))
struct EpiGu {
    static constexpr bool PERM = true, AFTER_DRAIN = false;
    const float* ss2; const float* cw; const float* cb; const float* st; bf16_t* aff; float* sideg; float* sideu; float* lastg; float* out; float* halo;
    __device__ __forceinline__ void operator()(const f32x4 (&acc)[2][2][4][2], const Unit& u, int wr, int wc, int fr, int fq) const {
        const int ch = 128 * u.pn + wc * 32 + 8 * fq; const bool samp = (u.pm >= 64);
        float w0[8], w1[8], w2[8], bb[8]; load8_f32(cw + ch, w0); load8_f32(cw + DFF + ch, w1); load8_f32(cw + 2 * DFF + ch, w2); load8_f32(cb + ch, bb);
        float* hme = halo + (((wr * 4 + wc) * 4 + fq) * 2) * 8;
        float rsv[2][4];
#pragma unroll
        for (int ai = 0; ai < 2; ++ai)
#pragma unroll
            for (int m = 0; m < 4; ++m) rsv[ai][m] = __builtin_amdgcn_rsqf(ss2[EPI_ROWS(ai, m)] * (1.f / 1024.f) + EPS);
#pragma unroll
        for (int ai = 0; ai < 2; ++ai) {
            const int r = EPI_ROWS(ai, 3); const float rs = rsv[ai][3];
            float g[8]; EPI_GET(g, ai, 0, 3, rs);
            if (fr >= 14) { store8_f32(hme + ai * 512 + (fr - 14) * 8, g); if (ai == 1 && wr == 1 && !samp) store8_f32(lastg + (size_t)(u.pm * 2 + (fr - 14)) * DFF + ch, g); }
        }
        asm volatile("s_waitcnt lgkmcnt(0)" ::: "memory"); __builtin_amdgcn_s_barrier();
#pragma unroll
        for (int ai = 0; ai < 2; ++ai) {
            float prev[8];
#pragma unroll
            for (int m = 0; m < 4; ++m) {
                const int r = EPI_ROWS(ai, m); const float rs = rsv[ai][m];
                float g[8], up[8], p1[8], p2[8]; EPI_GET(g, ai, 0, m, rs); EPI_GET(up, ai, 1, m, rs);
                if (m == 0) {
                    float x1[8], x2[8];
#pragma unroll
                    for (int e = 0; e < 8; ++e) { x1[e] = 0.f; x2[e] = 0.f; }
                    if (!(ai == 0 && wr == 0) && !samp) {
                        const float* hp = halo + (wr == 1 ? ai * 512 : (ai - 1) * 512) + ((((wr ^ 1) * 4 + wc) * 4 + fq) * 2) * 8;
                        if (fr == 0) { load8_f32(hp, x2); load8_f32(hp + 8, x1); } else if (fr == 1) { load8_f32(hp + 8, x2); }
                    }
#pragma unroll
                    for (int e = 0; e < 8; ++e) { p1[e] = DPP_SHR1(x1[e], g[e]); p2[e] = DPP_SHR2(x2[e], g[e]); }
                    if (ai == 0 && wr == 0 && !samp && (u.pm & 31) != 0 && fr < 2) {
                        store8_f32(sideg + (size_t)(u.pm * 2 + fr) * DFF + ch, g); store8_f32(sideu + (size_t)(u.pm * 2 + fr) * DFF + ch, up);
                    }
                } else {
#pragma unroll
                    for (int e = 0; e < 8; ++e) { const float x1 = DPP_ROR1(prev[e]), x2 = DPP_ROR2(prev[e]); p1[e] = DPP_SHR1(x1, g[e]); p2[e] = DPP_SHR2(x2, g[e]); }
                }
                if (samp) {
                    const int rl = r - MP, b = rl >> 3, tt = rl & 7;
                    if (tt == 0) { load8_f32(st + (size_t)(b * 2 + 1) * DFF + ch, p1); load8_f32(st + (size_t)(b * 2) * DFF + ch, p2); }
                    else if (tt == 1) { load8_f32(st + (size_t)(b * 2 + 1) * DFF + ch, p2); }
                    if (tt >= 6) store8_f32(out + OFF_CF_S + (size_t)(b * 2 + (tt - 6)) * DFF + ch, g);
                } else {
                    const int t = r & (SEQ - 1); if (t >= SEQ - 2) store8_f32(out + OFF_CF_P + (size_t)((r >> 13) * 2 + (t - (SEQ - 2))) * DFF + ch, g);
                }
                float y[8];
#pragma unroll
                for (int e = 0; e < 8; ++e) { const float z = w0[e] * p2[e] + w1[e] * p1[e] + w2[e] * g[e] + bb[e]; y[e] = (z * __builtin_amdgcn_rcpf(1.0f + __builtin_amdgcn_exp2f(-1.4426950408889634f * z))) * up[e]; prev[e] = g[e]; }
                store8_bf16(aff + (size_t)r * DFF + ch, y);
            }
        }
    }
};
__device__ __forceinline__ void ffn_fixup_rows(const Ctx& C, int pm) {
    if (pm >= 64 || (pm & 31) == 0) return;
    const float* sideg = (const float*)(C.ws + WS_SIDEG); const float* sideu = (const float*)(C.ws + WS_SIDEU); const float* lastg = (const float*)(C.ws + WS_LASTG);
    bf16_t* aff = (bf16_t*)(C.ws + WS_AFF);
    constexpr int NC = (DFF + NTHREADS - 1) / NTHREADS;
    float g0[NC], g1[NC], u0[NC], u1[NC], l0[NC], l1[NC], w0[NC], w1[NC], w2[NC], bb[NC];
#pragma unroll
    for (int i = 0; i < NC; ++i) { const int c = C.tid + i * NTHREADS; const int cc = (c < DFF) ? c : 0;
        g0[i] = sideg[(size_t)(pm * 2) * DFF + cc]; g1[i] = sideg[(size_t)(pm * 2 + 1) * DFF + cc]; u0[i] = sideu[(size_t)(pm * 2) * DFF + cc]; u1[i] = sideu[(size_t)(pm * 2 + 1) * DFF + cc];
        l0[i] = lastg[(size_t)((pm - 1) * 2) * DFF + cc]; l1[i] = lastg[(size_t)((pm - 1) * 2 + 1) * DFF + cc];
        w0[i] = C.conv_ffn_w[cc]; w1[i] = C.conv_ffn_w[DFF + cc]; w2[i] = C.conv_ffn_w[2 * DFF + cc]; bb[i] = C.conv_ffn_b[cc]; }
#pragma unroll
    for (int i = 0; i < NC; ++i) { const int c = C.tid + i * NTHREADS;
        const float z0 = w0[i] * l0[i] + w1[i] * l1[i] + w2[i] * g0[i] + bb[i], z1 = w0[i] * l1[i] + w1[i] * g0[i] + w2[i] * g1[i] + bb[i];
        if (c < DFF) {
            aff[(size_t)(256 * pm) * DFF + c] = (bf16_t)(cvt_pk_bf16((z0 * __builtin_amdgcn_rcpf(1.0f + __builtin_amdgcn_exp2f(-1.4426950408889634f * z0))) * u0[i], 0.f) & 0xffffu);
            aff[(size_t)(256 * pm + 1) * DFF + c] = (bf16_t)(cvt_pk_bf16((z1 * __builtin_amdgcn_rcpf(1.0f + __builtin_amdgcn_exp2f(-1.4426950408889634f * z1))) * u1[i], 0.f) & 0xffffu); } }
    asm volatile("s_waitcnt vmcnt(0)" ::: "memory");
    __syncthreads();
}

template <class Epi> __device__ __forceinline__ void gemm_small(const bf16_t* A, const bf16_t* Bt, int K, int tile, int wave, int lane, const Epi& E) {
    const int i = lane & 15, q = lane >> 4, wm = wave & 3, wn = wave >> 2;
    const int row = MP + (tile >> 4) * 64 + wm * 16 + i, col0 = (tile & 15) * 64 + wn * 32;
    const bf16_t* ap = A + (size_t)row * K + 8 * q; const bf16_t* bp0 = Bt + (size_t)(col0 + i) * K + 8 * q; const bf16_t* bp1 = bp0 + (size_t)16 * K;
    f32x4 c0 = {0.f, 0.f, 0.f, 0.f}, c1 = {0.f, 0.f, 0.f, 0.f};
    for (int k0 = 0; k0 < K; k0 += 256) {
        bf16x8 a[8], b0[8], b1[8];
#pragma unroll
        for (int u = 0; u < 8; ++u) { a[u] = *(const bf16x8*)(ap + k0 + 32 * u); b0[u] = *(const bf16x8*)(bp0 + k0 + 32 * u); b1[u] = *(const bf16x8*)(bp1 + k0 + 32 * u); }
#pragma unroll
        for (int u = 0; u < 8; ++u) { c0 = __builtin_amdgcn_mfma_f32_16x16x32_bf16(b0[u], a[u], c0, 0, 0, 0); c1 = __builtin_amdgcn_mfma_f32_16x16x32_bf16(b1[u], a[u], c1, 0, 0, 0); }
    }
    E.small(row, col0 + 4 * q, q, c0, c1);
}

template <int K, class Epi> __device__ __forceinline__ void gemm_small2_rc(const bf16_t* A, const bf16_t* Bt, int row0, int col0, int wave, int lane, const Epi& E, unsigned char* lds) {
    constexpr int KW = K / 8, NS = KW / 32;
    const int i = lane & 15, q = lane >> 4;
    const bf16_t* ap = A + (size_t)(row0 + i) * K + wave * KW + 8 * q; const bf16_t* bp = Bt + (size_t)(col0 + i) * K + wave * KW + 8 * q;
    f32x4 acc[4][4];
#pragma unroll
    for (int cb = 0; cb < 4; ++cb)
#pragma unroll
        for (int rb = 0; rb < 4; ++rb) acc[cb][rb] = (f32x4){0.f, 0.f, 0.f, 0.f};
#pragma unroll
    for (int s0 = 0; s0 < NS; s0 += 4) {
        bf16x8 a[4][4], b[4][4];
#pragma unroll
        for (int s = 0; s < 4; ++s) if (s0 + s < NS) {
#pragma unroll
            for (int x = 0; x < 4; ++x) { a[s][x] = *(const bf16x8*)(ap + (size_t)(16 * x) * K + 32 * (s0 + s)); b[s][x] = *(const bf16x8*)(bp + (size_t)(16 * x) * K + 32 * (s0 + s)); } }
#pragma unroll
        for (int s = 0; s < 4; ++s) if (s0 + s < NS) {
#pragma unroll
            for (int cb = 0; cb < 4; ++cb)
#pragma unroll
                for (int rb = 0; rb < 4; ++rb) acc[cb][rb] = __builtin_amdgcn_mfma_f32_16x16x32_bf16(b[s][cb], a[s][rb], acc[cb][rb], 0, 0, 0); }
    }
    float* slab = (float*)lds + wave * 4096;
    __syncthreads();
#pragma unroll
    for (int cb = 0; cb < 4; ++cb)
#pragma unroll
        for (int rb = 0; rb < 4; ++rb) *(f32x4*)(slab + (16 * rb + i) * 64 + 4 * ((4 * cb + q) ^ i)) = acc[cb][rb];
    __syncthreads();
    {
        const int t = wave * 64 + lane, r = t >> 3, c8 = t & 7;
        f32x4 v0 = {0.f, 0.f, 0.f, 0.f}, v1 = {0.f, 0.f, 0.f, 0.f};
#pragma unroll
        for (int w = 0; w < 8; ++w) { const float* sp = (const float*)lds + w * 4096 + r * 64;
            v0 += *(const f32x4*)(sp + 4 * ((2 * c8) ^ (r & 15))); v1 += *(const f32x4*)(sp + 4 * ((2 * c8 + 1) ^ (r & 15))); }
        E.small8(row0 + r, col0 + 8 * c8, v0, v1);
    }
    __syncthreads();
}
template <int K, class Epi> __device__ __forceinline__ void gemm_small2(const bf16_t* A, const bf16_t* Bt, int tile, int wave, int lane, const Epi& E, unsigned char* lds) {
    gemm_small2_rc<K, Epi>(A, Bt, MP + (tile >> 4) * 64, (tile & 15) * 64, wave, lane, E, lds);
}

__device__ __forceinline__ int orig_win(int np) {
    const int T = np >> 8, cl = np & 255, bj = cl >> 7, wc = (cl >> 5) & 3, i = cl & 31;
    if (T < 2) return np;
    if (T < 6) return (bj ? 1024 : 512) + 128 * (T - 2) + (cl & 127);
    if (T < 8) return 1536 + (4 * (T - 6) + wc) * 64 + 32 * bj + i;
    if (T < 10) return 2048 + (4 * (T - 8) + wc) * 64 + 32 * bj + i;
    if (T < 12) return 2560 + 256 * (T - 10) + cl;
    if (T < 14) return 3072 + (4 * (T - 12) + wc) * 64 + 32 * bj + i;
    if (wc == 0) return 3584 + 32 * bj + i;
    if (wc == 1 && bj == 0 && i < 8) return 3648 + i;
    return -1;
}
__device__ __forceinline__ int orig_wgu(int np) { const int T = np >> 8, cl = np & 255; return ((cl >> 7) ? DFF : 0) + 128 * T + (cl & 127); }

template <int MODE> __device__ __forceinline__ void wt_item(const float* W, int K, int N, int Np, const float* gain, bf16_t* WT, int item, float* scr, int lane) {
    const int nblk = Np / 32, kb = item / nblk, nb = item - kb * nblk, k0 = 64 * kb, n0 = 32 * nb;
    const int np = n0 + (lane & 31); const int o = (MODE == 1) ? orig_win(np) : (MODE == 2) ? orig_wgu(np) : np;
    float wv[32];
#pragma unroll
    for (int i = 0; i < 32; ++i) { const int kk = 2 * i + (lane >> 5); wv[i] = (o >= 0) ? W[(size_t)(k0 + kk) * N + o] : 0.f; }
    if (gain) {
        float gv[32];
#pragma unroll
        for (int i = 0; i < 32; ++i) gv[i] = gain[k0 + 2 * i + (lane >> 5)];
#pragma unroll
        for (int i = 0; i < 32; ++i) wv[i] *= gv[i];
    }
#pragma unroll
    for (int i = 0; i < 32; ++i) scr[(2 * i + (lane >> 5)) * 33 + (lane & 31)] = wv[i];
    LDS_WAIT();
    const int c = lane & 7;
#pragma unroll
    for (int j = 0; j < 4; ++j) { const int n = (lane >> 3) + 8 * j; const float* s = scr + (8 * c) * 33 + n;
        u32x4 ov; ov.x = cvt_pk_bf16(s[0 * 33], s[1 * 33]); ov.y = cvt_pk_bf16(s[2 * 33], s[3 * 33]); ov.z = cvt_pk_bf16(s[4 * 33], s[5 * 33]); ov.w = cvt_pk_bf16(s[6 * 33], s[7 * 33]);
        *(u32x4*)(WT + (size_t)(n0 + n) * K + k0 + 8 * c) = ov; }
    LDS_WAIT();
}
__device__ __forceinline__ void row_to_bf16(const float* xrow, bf16_t* orow, float* rstd_out, int lane) {
    const f32x4* xr = (const f32x4*)xrow + lane; f32x4 v[4]; float s = 0.f;
#pragma unroll
    for (int j = 0; j < 4; ++j) { v[j] = xr[64 * j]; s += (v[j].x * v[j].x + v[j].y * v[j].y) + (v[j].z * v[j].z + v[j].w * v[j].w); }
    s = wave_sum(s); if (lane == 0) *rstd_out = 1.0f / sqrtf(s * (1.f / 1024.f) + EPS);
    u64* o8 = (u64*)orow + lane;
#pragma unroll
    for (int j = 0; j < 4; ++j) o8[64 * j] = (u64)cvt_pk_bf16(v[j].x, v[j].y) | ((u64)cvt_pk_bf16(v[j].z, v[j].w) << 32);
}
__device__ __forceinline__ void sincos_d(double a, float& sn, float& cs) {
    const double n = __builtin_rint(a * 0.63661977236758134308); const int q = ((int)n) & 3;
    double r = __builtin_fma(-n, 1.57079632679489655800e+00, a); r = __builtin_fma(-n, 6.12323399573676603587e-17, r);
    const double r2 = r * r;
    double ps = 1.0 / 6227020800.0; ps = ps * r2 - 1.0 / 39916800.0; ps = ps * r2 + 1.0 / 362880.0; ps = ps * r2 - 1.0 / 5040.0; ps = ps * r2 + 1.0 / 120.0; ps = ps * r2 - 1.0 / 6.0; ps = ps * r2 * r + r;
    double pc = -1.0 / 87178291200.0; pc = pc * r2 + 1.0 / 479001600.0; pc = pc * r2 - 1.0 / 3628800.0; pc = pc * r2 + 1.0 / 40320.0; pc = pc * r2 - 1.0 / 720.0; pc = pc * r2 + 1.0 / 24.0; pc = pc * r2 - 0.5; pc = pc * r2 + 1.0;
    const double s = (q == 0) ? ps : (q == 1) ? pc : (q == 2) ? -ps : -pc;
    const double c = (q == 0) ? pc : (q == 1) ? -ps : (q == 2) ? -pc : ps;
    sn = (float)s; cs = (float)c;
}
__device__ __forceinline__ void ph0_prologue(const Ctx& C, unsigned char* lds) {
    float* scr = (float*)lds + C.wave * (64 * 33);
    const int gw = C.bid * NWAVES + C.wave, NGW = C.G * NWAVES;
    constexpr int I_IN = 16 * (DINP / 32), I_OUT = 16 * 32, I_Q = 16 * 32, I_KV = 16 * 64, I_O = 16 * 32, I_GU = 16 * (2 * DFF / 32), I_DN = (DFF / 64) * 32;
    constexpr int NIT = I_IN + I_OUT + I_Q + I_KV + I_O + I_GU + I_DN;
    for (int it = gw; it < NIT; it += NGW) {
        int r = __builtin_amdgcn_readfirstlane(it);
        if (r < I_IN) { wt_item<1>(C.w_in, DM, DIN, DINP, C.g_mix, (bf16_t*)(C.ws + WS_WIN), r, scr, C.lane); continue; } r -= I_IN;
        if (r < I_OUT) { wt_item<0>(C.w_out, DM, DM, DM, nullptr, (bf16_t*)(C.ws + WS_WOUT), r, scr, C.lane); continue; } r -= I_OUT;
        if (r < I_Q) { wt_item<0>(C.w_q, DM, DM, DM, C.g_mem, (bf16_t*)(C.ws + WS_WQ), r, scr, C.lane); continue; } r -= I_Q;
        if (r < I_KV) { wt_item<0>(C.w_kv, DM, 2 * DM, 2 * DM, C.g_mem_src, (bf16_t*)(C.ws + WS_WKV), r, scr, C.lane); continue; } r -= I_KV;
        if (r < I_O) { wt_item<0>(C.w_o, DM, DM, DM, nullptr, (bf16_t*)(C.ws + WS_WO), r, scr, C.lane); continue; } r -= I_O;
        if (r < I_GU) { wt_item<2>(C.w_gu, DM, 2 * DFF, 2 * DFF, C.g_ffn, (bf16_t*)(C.ws + WS_WGU), r, scr, C.lane); continue; } r -= I_GU;
        wt_item<0>(C.w_down, DFF, DM, DM, nullptr, (bf16_t*)(C.ws + WS_WDOWN), r, scr, C.lane);
    }
    float* rstd = (float*)(C.ws + WS_RSTD);
    for (int m0 = gw; m0 < MT + 512; m0 += 4 * NGW) {
        const float* src[4]; bf16_t* dst[4]; bool ok[4]; f32x4 v[4][4];
#pragma unroll
        for (int u = 0; u < 4; ++u) { const int m = m0 + u * NGW; ok[u] = m < MT + 512; const int mm = ok[u] ? m : 0;
            if (mm < MP) { src[u] = C.x_p + (size_t)mm * DM; dst[u] = (bf16_t*)(C.ws + WS_XB) + (size_t)mm * DM; }
            else if (mm < MT) { src[u] = C.x_s + (size_t)(mm - MP) * DM; dst[u] = (bf16_t*)(C.ws + WS_XB) + (size_t)mm * DM; }
            else { src[u] = C.mem_p + (size_t)(mm - MT) * DM; dst[u] = (bf16_t*)(C.ws + WS_MEMB) + (size_t)(mm - MT) * DM; }
#pragma unroll
            for (int j = 0; j < 4; ++j) v[u][j] = ((const f32x4*)src[u] + C.lane)[64 * j]; }
#pragma unroll
        for (int u = 0; u < 4; ++u) { const int m = m0 + u * NGW; float s = 0.f;
#pragma unroll
            for (int j = 0; j < 4; ++j) s += (v[u][j].x * v[u][j].x + v[u][j].y * v[u][j].y) + (v[u][j].z * v[u][j].z + v[u][j].w * v[u][j].w);
            s = wave_sum(s);
            if (ok[u]) { if (C.lane == 0) rstd[m] = 1.0f / sqrtf(s * (1.f / 1024.f) + EPS);
                u64* o8 = (u64*)dst[u] + C.lane;
#pragma unroll
                for (int j = 0; j < 4; ++j) o8[64 * j] = (u64)cvt_pk_bf16(v[u][j].x, v[u][j].y) | ((u64)cvt_pk_bf16(v[u][j].z, v[u][j].w) << 32); } }
    }
    const int gt = C.bid * NTHREADS + C.tid, NGT = C.G * NTHREADS;
    float* cosT = (float*)(C.ws + WS_COS); float* sinT = (float*)(C.ws + WS_SIN);
    for (int i = gt; i < SEQ * 32; i += NGT) {
        const int pos = i >> 5, d = i & 31;
        const float inv = expf((float)d * (float)(-2.0 * 9.210340371976184 / 64.0));
        const float ang = (float)pos * inv;
        float sn, cs; sincos_d((double)ang, sn, cs); cosT[i] = cs; sinT[i] = sn;
    }
}

constexpr int MEMP_CHUNK = 2048, NMEMP = 65536 / MEMP_CHUNK;
__device__ __forceinline__ void ph2_memprep(const Ctx& C, int chunk) {
    const int gt = chunk * MEMP_CHUNK + C.wave * 64 + fresh_lane(), NGT = NTHREADS, cEnd = (chunk + 1) * MEMP_CHUNK;
    const float* ssk = (const float*)(C.ws + ACC_SSK); float* mk = C.out + OFF_MK_P; const float* mv = C.out + OFF_MV_P;
    bf16_t* mkF = (bf16_t*)(C.ws + WS_MKF); bf16_t* mvF = (bf16_t*)(C.ws + WS_MVF);
    for (int c = gt; c < cEnd; c += NGT) {
        const int lane = c & 63, ks = (c >> 6) & 15, mb = (c >> 10) & 7, h = (c >> 13) & 3, b = c >> 15; const int r32 = lane & 31, hi = lane >> 5;
        const int r = b * 256 + 32 * mb + r32, d0 = 16 * ks + 8 * hi;
        const float rn = 1.0f / sqrtf(ssk[r * 4 + h] * (1.f / 256.f) + EPS);
        float v[8], g[8]; float* p = mk + (size_t)r * 1024 + h * 256 + d0; load8_f32(p, v); load8_f32(C.mk_g + d0, g);
#pragma unroll
        for (int e = 0; e < 8; ++e) v[e] = v[e] * rn * g[e];
        store8_f32(p, v); store8_bf16(mkF + (size_t)c * 8, v);
    }
    for (int c = gt; c < cEnd; c += NGT) {
        const int lane = c & 63, s = (c >> 6) & 1, mb = (c >> 7) & 7, db = (c >> 10) & 7, h = (c >> 13) & 3, b = c >> 15; const int r32 = lane & 31, hi = lane >> 5;
        float v[8];
#pragma unroll
        for (int j = 0; j < 8; ++j) { const int m = 32 * mb + 16 * s + 8 * (j >> 2) + 4 * hi + (j & 3); v[j] = mv[(size_t)(b * 256 + m) * 1024 + h * 256 + 32 * db + r32]; }
        store8_bf16(mvF + (size_t)c * 8, v);
    }
}
__device__ __forceinline__ void score_unit_prompt(const Ctx& C, int b, int g, unsigned char* lds) {
    const int lane = fresh_lane(), tid = C.wave * 64 + lane, r32 = lane & 31, hi = lane >> 5;
    const bf16_t* qib = (const bf16_t*)(C.ws + WS_QI); const bf16_t* kib = (const bf16_t*)(C.ws + WS_KI);
#pragma unroll
    for (int j = 0; j < 4; ++j) { const int id = tid + 512 * j, c = id >> 5, r = id & 31;
        *(u32x4*)(lds + id * 16) = *(const u32x4*)(qib + (size_t)(b * SEQ + 32 * g + r) * 512 + c * 8); }
    __syncthreads();
    const int qrow0 = b * SEQ + 32 * g;
    float w[8]; load8_f32((const float*)(C.ws + WS_IW) + (size_t)(qrow0 + r32) * 8, w);
    float* stg = (float*)(lds + 32768 + C.wave * 8704);
    float* sout = (float*)(C.ws + WS_SC) + (size_t)(qrow0 + (lane >> 4)) * SEQ + (lane & 15) * 4;
    const int nt = (g >> 1) + 1;
    const int ntp = ((32 * g + 32 + 511) >> 9) << 3;
    const int tq = 32 * g + r32;
    const unsigned char* qbase = lds + hi * 512 + r32 * 16;
    const bf16_t* kp0 = kib + (size_t)(b * SEQ + r32) * 64 + hi * 8;
    bf16x8 kf[4][2];
    { const bf16_t* kp = kp0 + (size_t)((C.wave < nt) ? C.wave : 0) * 4096;
#pragma unroll
      for (int d0 = 0; d0 < 4; ++d0) { kf[d0][0] = *(const bf16x8*)(kp + d0 * 16); kf[d0][1] = *(const bf16x8*)(kp + 32 * 64 + d0 * 16); } }
    for (int kt = C.wave; kt < ntp; kt += NWAVES) {
        bf16x8 kn[4][2];
        { const bf16_t* kp = kp0 + (size_t)((kt + NWAVES < nt) ? kt + NWAVES : kt) * 4096;
#pragma unroll
          for (int d0 = 0; d0 < 4; ++d0) { kn[d0][0] = *(const bf16x8*)(kp + d0 * 16); kn[d0][1] = *(const bf16x8*)(kp + 32 * 64 + d0 * 16); } }
        float a0[16], a1[16];
#pragma unroll
        for (int r = 0; r < 16; ++r) { a0[r] = 0.f; a1[r] = 0.f; }
        if (kt < nt) {
#pragma unroll
        for (int h = 0; h < 8; ++h) {
            bf16x8 qf[4];
#pragma unroll
            for (int d0 = 0; d0 < 4; ++d0) qf[d0] = *(const bf16x8*)(qbase + (h * 8 + d0 * 2) * 512);
            f32x16 p = {};
#pragma unroll
            for (int d0 = 0; d0 < 4; ++d0) p = __builtin_amdgcn_mfma_f32_32x32x16_bf16(kf[d0][0], qf[d0], p, 0, 0, 0);
#pragma unroll
            for (int r = 0; r < 16; ++r) a0[r] = __builtin_fmaf(w[h], __builtin_amdgcn_fmed3f(p[r], 0.f, 3.0e38f), a0[r]);
            f32x16 p2 = {};
#pragma unroll
            for (int d0 = 0; d0 < 4; ++d0) p2 = __builtin_amdgcn_mfma_f32_32x32x16_bf16(kf[d0][1], qf[d0], p2, 0, 0, 0);
#pragma unroll
            for (int r = 0; r < 16; ++r) a1[r] = __builtin_fmaf(w[h], __builtin_amdgcn_fmed3f(p2[r], 0.f, 3.0e38f), a1[r]);
#pragma unroll
            for (int r = 0; r < 16; ++r) { asm volatile("" : "+v"(a0[r])); asm volatile("" : "+v"(a1[r])); }
        }
        }
        if (kt * 64 + 63 > 32 * g) {
#pragma unroll
            for (int r = 0; r < 16; ++r) { const int key = kt * 64 + (r & 3) + 8 * (r >> 2) + 4 * hi; if (key > tq) a0[r] = -INFINITY; if (key + 32 > tq) a1[r] = -INFINITY; }
        }
#pragma unroll
        for (int r = 0; r < 16; ++r) { const unsigned u0 = __float_as_uint(a0[r]), u1 = __float_as_uint(a1[r]);
            a0[r] = __uint_as_float(u0 ^ ((unsigned)((int)u0 >> 31) | 0x80000000u)); a1[r] = __uint_as_float(u1 ^ ((unsigned)((int)u1 >> 31) | 0x80000000u)); }
#pragma unroll
        for (int rq = 0; rq < 4; ++rq) {
            *(f32x4*)(stg + r32 * 68 + 8 * rq + 4 * hi) = (f32x4){a0[4 * rq], a0[4 * rq + 1], a0[4 * rq + 2], a0[4 * rq + 3]};
            *(f32x4*)(stg + r32 * 68 + 32 + 8 * rq + 4 * hi) = (f32x4){a1[4 * rq], a1[4 * rq + 1], a1[4 * rq + 2], a1[4 * rq + 3]};
        }
#pragma unroll
        for (int i = 0; i < 8; ++i) { const f32x4 v = *(const f32x4*)(stg + (i * 4 + (lane >> 4)) * 68 + (lane & 15) * 4); *(f32x4*)(sout + (size_t)(i * 4) * SEQ + kt * 64) = v; }
#pragma unroll
        for (int d0 = 0; d0 < 4; ++d0) { kf[d0][0] = kn[d0][0]; kf[d0][1] = kn[d0][1]; }
    }
    asm volatile("s_waitcnt vmcnt(0)" ::: "memory");
    __syncthreads();
}
__device__ __forceinline__ float dpp_sum8s(float x) {
    x += __builtin_bit_cast(float, __builtin_amdgcn_update_dpp(0, __builtin_bit_cast(int, x), 0xB1, 0xF, 0xF, true));
    x += __builtin_bit_cast(float, __builtin_amdgcn_update_dpp(0, __builtin_bit_cast(int, x), 0x4E, 0xF, 0xF, true));
    x += __builtin_bit_cast(float, __builtin_amdgcn_update_dpp(0, __builtin_bit_cast(int, x), 0x141, 0xF, 0xF, true));
    return x;
}
__device__ __forceinline__ void score_unit_sample(const Ctx& C, int b, int c) {
    const int lane = fresh_lane(), r32 = lane & 31, hi = lane >> 5;
    const bf16_t* qib = (const bf16_t*)(C.ws + WS_QI);
    bf16x8 qf[2][4]; float w2[2];
#pragma unroll
    for (int nb = 0; nb < 2; ++nb) { const int row = MP + b * DS + 4 * nb + (r32 >> 3), h = r32 & 7;
        w2[nb] = ((const float*)(C.ws + WS_IW))[(size_t)row * 8 + h];
#pragma unroll
        for (int d0 = 0; d0 < 4; ++d0) qf[nb][d0] = *(const bf16x8*)(qib + (size_t)row * 512 + h * 64 + d0 * 16 + hi * 8); }
    const int kb0 = 4 * c, kb1 = (c == 15) ? 65 : 4 * c + 4;
    float* scs = (float*)(C.ws + WS_SCS) + (size_t)(b * DS) * SPITCH;
#define SKP(kb_) (((kb_) < 64) ? (C.cache_ik + ((size_t)C.page_table[b * NPAGES + ((kb_) >> 2)] * PAGE + ((kb_) & 3) * 32 + r32) * 64 + 8 * hi) : (C.out + OFF_IK_S + (size_t)(b * DS + (r32 & 7)) * 64 + 8 * hi))
    f32x4 kr[4][2];
    { const float* kp = SKP(kb0);
#pragma unroll
      for (int d0 = 0; d0 < 4; ++d0) { kr[d0][0] = *(const f32x4*)(kp + 16 * d0); kr[d0][1] = *(const f32x4*)(kp + 16 * d0 + 4); } }
    for (int kb = kb0; kb < kb1; ++kb) {
        f32x4 kn[4][2];
        { const int kbn = (kb + 1 < kb1) ? kb + 1 : kb; const float* kp = SKP(kbn);
#pragma unroll
          for (int d0 = 0; d0 < 4; ++d0) { kn[d0][0] = *(const f32x4*)(kp + 16 * d0); kn[d0][1] = *(const f32x4*)(kp + 16 * d0 + 4); } }
        bf16x8 kf[4];
#pragma unroll
        for (int d0 = 0; d0 < 4; ++d0) {
            const u32x4 pk = (u32x4){cvt_pk_bf16(kr[d0][0].x, kr[d0][0].y), cvt_pk_bf16(kr[d0][0].z, kr[d0][0].w), cvt_pk_bf16(kr[d0][1].x, kr[d0][1].y), cvt_pk_bf16(kr[d0][1].z, kr[d0][1].w)}; kf[d0] = __builtin_bit_cast(bf16x8, pk); }
#pragma unroll
        for (int nb = 0; nb < 2; ++nb) {
            f32x16 D = {};
#pragma unroll
            for (int d0 = 0; d0 < 4; ++d0) D = __builtin_amdgcn_mfma_f32_32x32x16_bf16(kf[d0], qf[nb][d0], D, 0, 0, 0);
            float s[16];
#pragma unroll
            for (int r = 0; r < 16; ++r) s[r] = dpp_sum8s(w2[nb] * __builtin_amdgcn_fmed3f(D[r], 0.f, 3.0e38f));
            if ((r32 & 7) == 0) {
                float* dst = scs + (size_t)(4 * nb + (r32 >> 3)) * SPITCH + 32 * kb + 4 * hi;
#pragma unroll
                for (int rq = 0; rq < 4; ++rq) if (32 * kb + 8 * rq + 4 * hi < PAST + DS) *(f32x4*)(dst + 8 * rq) = (f32x4){s[4 * rq], s[4 * rq + 1], s[4 * rq + 2], s[4 * rq + 3]};
            }
        }
#pragma unroll
        for (int d0 = 0; d0 < 4; ++d0) { kr[d0][0] = kn[d0][0]; kr[d0][1] = kn[d0][1]; }
    }
#undef SKP
}
__device__ __forceinline__ int mask_col(int lane) { const int p = lane >> 5, k5 = lane & 31, hi = (k5 >> 2) & 1, r = (k5 & 3) | ((k5 >> 3) << 2); return (p * 16 + r) * 2 + hi; }
template <int NI, int SHIFT, int BITS, int PSHIFT>
__device__ __forceinline__ void radix_pass(const unsigned (&v)[NI], int n, unsigned prefix, unsigned* hist, int lane, unsigned& bin_out, int& k) {
    constexpr int NBINS = 1 << BITS, BPL = NBINS / 64;
    lane = fresh_lane();
#pragma unroll
    for (int j = 0; j < BPL; ++j) hist[j * 64 + lane] = 0u;
    LDS_WAIT();
    int nn = n; asm volatile("" : "+s"(nn));
#pragma unroll
    for (int c = 0; c < NI / 8; ++c) if (c * 512 < nn) {
#pragma unroll
        for (int j = 0; j < 8; ++j) { const int i = c * 8 + j;
            const bool match = (PSHIFT >= 32) ? true : ((v[i] >> (PSHIFT & 31)) == prefix);
            if (match && (lane < nn - i * 64)) atomicAdd(&hist[(v[i] >> SHIFT) & (NBINS - 1)], 1u); }
    }
    LDS_WAIT();
    unsigned cnt = 0u;
    { constexpr int NSL = BPL / 4; const u32x4* hp = (const u32x4*)(hist + BPL * lane); const int f = (lane / (16 / NSL)) & (NSL - 1);
#pragma unroll
      for (int j = 0; j < NSL; ++j) { const u32x4 h = hp[j ^ f]; cnt += (h.x + h.y) + (h.z + h.w); } }
    unsigned S = cnt;
#pragma unroll
    for (int off = 1; off < 64; off <<= 1) { const unsigned t = __shfl_down(S, off); if (lane + off < 64) S += t; }
    const u64 bal = __ballot(S >= (unsigned)k);
    const int Ls = bal ? (63 - __clzll(bal)) : 0;
    const unsigned Sn = __shfl(S, (Ls + 1) & 63); const unsigned above = (Ls < 63) ? Sn : 0u;
    const unsigned hj = hist[BPL * Ls + (lane & (BPL - 1))];
    unsigned T = (lane < BPL) ? hj : 0u;
#pragma unroll
    for (int off = 1; off < BPL; off <<= 1) { const unsigned t = __shfl_down(T, off); if (lane + off < BPL) T += t; }
    const u64 bal2 = __ballot((lane < BPL) && (above + T >= (unsigned)k));
    const int js = bal2 ? (63 - __clzll(bal2)) : 0;
    const unsigned Tj = __shfl(T, js), hjs = __shfl(hj, js);
    LDS_WAIT();
    bin_out = (unsigned)(BPL * Ls + js); k = k - (int)(above + Tj - hjs);
}
template <int NI, bool MASK> __device__ __forceinline__ void select_row(const float* sc, int n, int* list, unsigned* hist, int lane, unsigned* maskw, int qbit) {
    lane = fresh_lane();
    if (n <= TOPK) {
#pragma unroll
        for (int i = 0; i < 4; ++i) { const int s = i * 64 + lane; if (s < n) { if (MASK) atomicOr(&maskw[i * 64 + mask_col(lane)], 1u << qbit); else list[s] = s; } }
        return;
    }
    unsigned v[NI];
    {
        lane = fresh_lane();
        int nn = n; asm volatile("" : "+s"(nn));
        const float* scl = sc + lane;
#pragma unroll
        for (int c = 0; c < NI / 16; ++c) {
            if (c * 1024 < nn) {
#pragma unroll
                for (int j = 0; j < 16; ++j) { const int i = c * 16 + j; v[i] = __float_as_uint(scl[(lane < nn - i * 64) ? i * 64 : 0]); }
            } else {
#pragma unroll
                for (int j = 0; j < 16; ++j) v[c * 16 + j] = 0u;
            }
        }
#pragma unroll
        for (int c = 0; c < NI / 16; ++c) {
            if (c * 1024 < nn) {
#pragma unroll
                for (int j = 0; j < 16; ++j) { const int i = c * 16 + j; const unsigned u = v[i]; const unsigned key = (u & 0x80000000u) ? ~u : (u | 0x80000000u); v[i] = (lane < nn - i * 64) ? key : 0u; }
            }
        }
    }
    int k = TOPK; unsigned b1, b2, b3;
    radix_pass<NI, 21, 11, 32>(v, n, 0u, hist, lane, b1, k);
    radix_pass<NI, 10, 11, 21>(v, n, b1, hist, lane, b2, k);
    radix_pass<NI, 0, 10, 10>(v, n, (b1 << 11) | b2, hist, lane, b3, k);
    const unsigned tau = (b1 << 21) | (b2 << 10) | b3;
    lane = fresh_lane();
    int nn = n; asm volatile("" : "+s"(nn));
    int base = 0, eqc = 0; const u64 ltmask = (1ull << lane) - 1ull; const int mcol = mask_col(lane);
#pragma unroll
    for (int c = 0; c < NI / 8; ++c) if (c * 512 < nn) {
#pragma unroll
        for (int j = 0; j < 8; ++j) { const int i = c * 8 + j;
            const bool inb = (lane < nn - i * 64); const bool gt = inb && (v[i] > tau), eq = inb && (v[i] == tau);
            const u64 eqb = __ballot(eq); const int erank = eqc + __popcll(eqb & ltmask);
            const bool take = gt || (eq && erank < k); eqc += __popcll(eqb);
            const u64 tb = __ballot(take); const int pos = base + __popcll(tb & ltmask);
            if (take && pos < TOPK) { if (MASK) atomicOr(&maskw[i * 64 + mcol], 1u << qbit); else list[pos] = i * 64 + lane; }
            base += __popcll(tb); }
    }
}
template <int NI, int SHIFT, int BITS, int PSHIFT>
__device__ __forceinline__ void radix_pass_p(const unsigned (&v)[NI], int nch, unsigned prefix, unsigned* hist, int lane, unsigned& bin_out, int& k, int& hcnt) {
    constexpr int NBINS = 1 << BITS, BPL = NBINS / 64;
    lane = fresh_lane();
#pragma unroll
    for (int j = 0; j < BPL; ++j) hist[j * 64 + lane] = 0u;
    LDS_WAIT();
    int nc = nch; asm volatile("" : "+s"(nc));
#pragma unroll
    for (int c = 0; c < NI / 8; ++c) if (c < nc) {
#pragma unroll
        for (int j = 0; j < 8; ++j) { const int i = c * 8 + j;
            if (PSHIFT >= 32) atomicAdd(&hist[(v[i] >> SHIFT) & (NBINS - 1)], 1u);
            else if ((v[i] >> (PSHIFT & 31)) == prefix) atomicAdd(&hist[(v[i] >> SHIFT) & (NBINS - 1)], 1u); }
    }
    if (PROBE_DUP == 33 && PSHIFT >= 32) {
#pragma unroll
        for (int c = 0; c < NI / 8; ++c) if (c < nc) {
#pragma unroll
            for (int j = 0; j < 8; ++j) { const int i = c * 8 + j; atomicSub(&hist[(v[i] >> SHIFT) & (NBINS - 1)], 1u); }
        }
#pragma unroll
        for (int c = 0; c < NI / 8; ++c) if (c < nc) {
#pragma unroll
            for (int j = 0; j < 8; ++j) { const int i = c * 8 + j; atomicAdd(&hist[(v[i] >> SHIFT) & (NBINS - 1)], 1u); }
        }
    }
    LDS_WAIT();
    unsigned cnt = 0u;
    { constexpr int NSL = BPL / 4; const u32x4* hp = (const u32x4*)(hist + BPL * lane); const int f = (lane / (16 / NSL)) & (NSL - 1);
#pragma unroll
      for (int j = 0; j < NSL; ++j) { const u32x4 h = hp[j ^ f]; cnt += (h.x + h.y) + (h.z + h.w); } }
    unsigned S = cnt;
#pragma unroll
    for (int off = 1; off < 64; off <<= 1) { const unsigned t = __shfl_down(S, off); if (lane + off < 64) S += t; }
    const u64 bal = __ballot(S >= (unsigned)k);
    const int Ls = bal ? (63 - __clzll(bal)) : 0;
    const unsigned Sn = __shfl(S, (Ls + 1) & 63); const unsigned above = (Ls < 63) ? Sn : 0u;
    const unsigned hj = hist[BPL * Ls + (lane & (BPL - 1))];
    unsigned T = (lane < BPL) ? hj : 0u;
#pragma unroll
    for (int off = 1; off < BPL; off <<= 1) { const unsigned t = __shfl_down(T, off); if (lane + off < BPL) T += t; }
    const u64 bal2 = __ballot((lane < BPL) && (above + T >= (unsigned)k));
    const int js = bal2 ? (63 - __clzll(bal2)) : 0;
    const unsigned Tj = __shfl(T, js), hjs = __shfl(hj, js);
    LDS_WAIT();
    bin_out = (unsigned)(BPL * Ls + js); hcnt = (int)hjs; k = k - (int)(above + Tj - hjs);
}
template <int NI> __device__ __forceinline__ void select_row_p(const float* sc, int n, unsigned* hist, unsigned* maskw, int qbit) {
    int lane = fresh_lane();
    if (n <= TOPK) {
#pragma unroll
        for (int i = 0; i < 4; ++i) { const int s = i * 64 + lane; if (s < n) atomicOr(&maskw[i * 64 + mask_col(lane)], 1u << qbit); }
        return;
    }
    const int nch = (n + 511) >> 9;
    unsigned v[NI];
    {
        int nc = nch; asm volatile("" : "+s"(nc));
        const float* scl = sc + lane;
#pragma unroll
        for (int c = 0; c < NI / 8; ++c) {
            if (c < nc) {
#pragma unroll
                for (int j = 0; j < 8; ++j) { const int i = c * 8 + j; v[i] = __float_as_uint(scl[i * 64]); }
            } else {
#pragma unroll
                for (int j = 0; j < 8; ++j) v[c * 8 + j] = 0u;
            }
        }
    }
    int k = TOPK, hc = 0; unsigned b1, b2 = 0u, b3 = 0u; unsigned tau; bool exact;
    radix_pass_p<NI, 21, 11, 32>(v, nch, 0u, hist, lane, b1, k, hc);
    tau = b1 << 21; exact = (hc == k);
    if (!exact) {
        radix_pass_p<NI, 10, 11, 21>(v, nch, b1, hist, lane, b2, k, hc);
        tau = (b1 << 21) | (b2 << 10); exact = (hc == k);
        if (!exact) { radix_pass_p<NI, 0, 10, 10>(v, nch, (b1 << 11) | b2, hist, lane, b3, k, hc); tau = (b1 << 21) | (b2 << 10) | b3; exact = (hc == k); }
    }
    lane = fresh_lane();
    int nc = nch; asm volatile("" : "+s"(nc));
    const int mcol = mask_col(lane);
    if (exact) {
#pragma unroll
        for (int c = 0; c < NI / 8; ++c) if (c < nc) {
#pragma unroll
            for (int j = 0; j < 8; ++j) { const int i = c * 8 + j; if (v[i] >= tau) atomicOr(&maskw[i * 64 + mcol], 1u << qbit); }
        }
    } else {
        int eqc = 0; const u64 ltmask = (1ull << lane) - 1ull;
#pragma unroll
        for (int c = 0; c < NI / 8; ++c) if (c < nc) {
#pragma unroll
            for (int j = 0; j < 8; ++j) { const int i = c * 8 + j;
                const bool gt = v[i] > tau, eq = v[i] == tau;
                const u64 eqb = __ballot(eq); const int erank = eqc + __popcll(eqb & ltmask); eqc += __popcll(eqb);
                if (gt || (eq && erank < k)) atomicOr(&maskw[i * 64 + mcol], 1u << qbit); }
        }
    }
}
__device__ __forceinline__ void select_group_prompt(const Ctx& C, int b, int g, unsigned char* lds) {
    unsigned* hist = (unsigned*)lds + C.wave * 2048; unsigned* maskw = (unsigned*)(lds + 65536);
    { const int tid0 = C.wave * 64 + fresh_lane();
#pragma unroll
      for (int j = 0; j < 16; ++j) maskw[tid0 + 512 * j] = 0u; }
    __syncthreads();
#pragma unroll 1
    for (int j = 0; j < 4; ++j) {
        const int q = C.wave + 8 * j, t = 32 * g + q, ru = b * SEQ + t;
        select_row_p<128>((const float*)(C.ws + WS_SC) + (size_t)ru * SEQ, t + 1, hist, maskw, q);
    }
    __syncthreads();
    const int ntile = 4 * ((g >> 3) + 1);
    u32x4* dst = (u32x4*)((u64*)(C.ws + WS_MASK) + (size_t)(b * 256 + g) * (128 * 32));
    for (int i = C.wave * 64 + fresh_lane(); i < ntile * 16; i += NTHREADS) dst[i] = *(const u32x4*)(maskw + 4 * i);
    __syncthreads();
}
constexpr int CONV_CHUNK = 4096, NCONV = (MT * 64 + CONV_CHUNK - 1) / CONV_CHUNK;
__device__ __forceinline__ void conv_mix_branch(const Ctx& C, int chunk) {
    const int tid2 = C.wave * 64 + fresh_lane();
    const int gt = chunk * CONV_CHUNK + tid2, NGT = NTHREADS, itEnd = (chunk + 1) * CONV_CHUNK;
    const bf16_t* ub = (const bf16_t*)(C.ws + WS_U); const bf16_t* cbb = (const bf16_t*)(C.ws + WS_CB); bf16_t* amix = (bf16_t*)(C.ws + WS_AMIX);
    for (int it0 = gt; it0 < itEnd; it0 += 4 * NGT) {
        u32x4 ru0[4], rp1[4], rp2[4], rcb[4]; f32x4 fp1[4][2], fp2[4][2]; bool ok[4], s1[4], s2[4];
#pragma unroll
        for (int q = 0; q < 4; ++q) { const int it = it0 + q * NGT; ok[q] = it < MT * 64; const int itc = ok[q] ? it : 0; const int r = itc >> 6, c = (itc & 63) * 8;
            ru0[q] = *(const u32x4*)(ub + (size_t)r * 512 + c); rcb[q] = *(const u32x4*)(cbb + (size_t)r * 512 + c);
            int t; bool smp = r >= MP; int b = 0;
            if (!smp) t = r & (SEQ - 1); else { const int rl = r - MP; b = rl >> 3; t = rl & 7; }
            s1[q] = smp && t < 1; s2[q] = smp && t < 2;
            rp1[q] = (t >= 1) ? *(const u32x4*)(ub + (size_t)(r - 1) * 512 + c) : (u32x4){0u, 0u, 0u, 0u};
            rp2[q] = (t >= 2) ? *(const u32x4*)(ub + (size_t)(r - 2) * 512 + c) : (u32x4){0u, 0u, 0u, 0u};
            if (s1[q]) { const float* sp = C.st_mix + (size_t)(b * 2 + 1) * 512 + c; fp1[q][0] = *(const f32x4*)sp; fp1[q][1] = *(const f32x4*)(sp + 4); }
            if (s2[q]) { const float* sp = C.st_mix + (size_t)(b * 2 + t) * 512 + c; fp2[q][0] = *(const f32x4*)sp; fp2[q][1] = *(const f32x4*)(sp + 4); } }
#pragma unroll
        for (int q = 0; q < 4; ++q) if (ok[q]) { const int it = it0 + q * NGT; const int r = it >> 6, c = (it & 63) * 8;
            float u0[8], p1[8], p2[8], cb[8], w0[8], w1[8], w2[8], y[8];
            const u32x4 a = ru0[q], bq = rcb[q], c1 = rp1[q], c2 = rp2[q];
            u0[0] = bf2f(a.x & 0xffffu); u0[1] = bf2f(a.x >> 16); u0[2] = bf2f(a.y & 0xffffu); u0[3] = bf2f(a.y >> 16); u0[4] = bf2f(a.z & 0xffffu); u0[5] = bf2f(a.z >> 16); u0[6] = bf2f(a.w & 0xffffu); u0[7] = bf2f(a.w >> 16);
            cb[0] = bf2f(bq.x & 0xffffu); cb[1] = bf2f(bq.x >> 16); cb[2] = bf2f(bq.y & 0xffffu); cb[3] = bf2f(bq.y >> 16); cb[4] = bf2f(bq.z & 0xffffu); cb[5] = bf2f(bq.z >> 16); cb[6] = bf2f(bq.w & 0xffffu); cb[7] = bf2f(bq.w >> 16);
            p1[0] = bf2f(c1.x & 0xffffu); p1[1] = bf2f(c1.x >> 16); p1[2] = bf2f(c1.y & 0xffffu); p1[3] = bf2f(c1.y >> 16); p1[4] = bf2f(c1.z & 0xffffu); p1[5] = bf2f(c1.z >> 16); p1[6] = bf2f(c1.w & 0xffffu); p1[7] = bf2f(c1.w >> 16);
            p2[0] = bf2f(c2.x & 0xffffu); p2[1] = bf2f(c2.x >> 16); p2[2] = bf2f(c2.y & 0xffffu); p2[3] = bf2f(c2.y >> 16); p2[4] = bf2f(c2.z & 0xffffu); p2[5] = bf2f(c2.z >> 16); p2[6] = bf2f(c2.w & 0xffffu); p2[7] = bf2f(c2.w >> 16);
            if (s1[q]) { p1[0] = fp1[q][0].x; p1[1] = fp1[q][0].y; p1[2] = fp1[q][0].z; p1[3] = fp1[q][0].w; p1[4] = fp1[q][1].x; p1[5] = fp1[q][1].y; p1[6] = fp1[q][1].z; p1[7] = fp1[q][1].w; }
            if (s2[q]) { p2[0] = fp2[q][0].x; p2[1] = fp2[q][0].y; p2[2] = fp2[q][0].z; p2[3] = fp2[q][0].w; p2[4] = fp2[q][1].x; p2[5] = fp2[q][1].y; p2[6] = fp2[q][1].z; p2[7] = fp2[q][1].w; }
            load8_f32(C.conv_mix_w + c, w0); load8_f32(C.conv_mix_w + 512 + c, w1); load8_f32(C.conv_mix_w + 1024 + c, w2);
#pragma unroll
            for (int e2 = 0; e2 < 8; ++e2) y[e2] = cb[e2] * (w0[e2] * p2[e2] + w1[e2] * p1[e2] + w2[e2] * u0[e2]);
            store8_bf16(amix + (size_t)r * 1024 + c, y); }
    }
}

__device__ __forceinline__ int queue_pop(unsigned* q, volatile LAS unsigned* slot) {
    __syncthreads();
    if (threadIdx.x == 0) *slot = xb_add(q, 1u);
    __syncthreads();
    return __builtin_amdgcn_readfirstlane((int)*slot);
}
__device__ __forceinline__ void ph2_scores_select(const Ctx& C, unsigned char* lds, unsigned* q, volatile LAS unsigned* slot) {
    for (;;) {
        const int it = queue_pop(q, slot);
        if (it >= DB + 512 + NCONV + NMEMP) break;
        if (it < DB) {
            const int bt = it;
            score_unit_sample(C, bt, 2 * C.wave); score_unit_sample(C, bt, 2 * C.wave + 1);
            asm volatile("s_waitcnt vmcnt(0)" ::: "memory");
            __syncthreads();
            const int rl = bt * DS + C.wave;
            select_row<48, false>((const float*)(C.ws + WS_SCS) + (size_t)rl * SPITCH, PAST + C.wave + 1, (int*)(C.ws + WS_SEL) + (size_t)(MP + rl) * TOPK, (unsigned*)lds + C.wave * 2048, 0, nullptr, 0);
        } else if (it < DB + 512) {
            const int j = it - DB, b = j & 1, g = 255 - (j >> 1);
            score_unit_prompt(C, b, g, lds); if (PROBE_DUP == 12) score_unit_prompt(C, b, g, lds);
            select_group_prompt(C, b, g, lds); if (PROBE_DUP == 13) select_group_prompt(C, b, g, lds);
        } else if (it < DB + 512 + NCONV) conv_mix_branch(C, it - DB - 512);
        else ph2_memprep(C, it - DB - 512 - NCONV);
    }
}

template <bool SAMP> __device__ __forceinline__ void attn_gather_row(const Ctx& C, int r, int lane) {
    const int rl = SAMP ? r - MP : r; const int b = SAMP ? (rl >> 3) : (rl >> 13);
    const int n = SAMP ? PAST + (rl & 7) + 1 : (rl & (SEQ - 1)) + 1; const int cnt = n < TOPK ? n : TOPK;
    const int* __restrict__ list = (const int*)(C.ws + WS_SEL) + (size_t)r * TOPK;
    float q[8]; load8_bf16((const bf16_t*)(C.ws + WS_Q) + (size_t)r * 512 + lane * 8, q);
    float mrun = -INFINITY, l = 0.f, o[8];
#pragma unroll
    for (int e = 0; e < 8; ++e) o[e] = 0.f;
    for (int j0 = 0; j0 < cnt; j0 += 4) {
        float kk[4][8], vv[4][8];
#pragma unroll
        for (int u = 0; u < 4; ++u) {
            const int j = (j0 + u < cnt) ? j0 + u : j0; const int s = list[j];
            if (SAMP) {
                const float *kp, *vp;
                if (s < PAST) { const size_t ro = ((size_t)C.page_table[b * NPAGES + (s >> 7)] * PAGE + (s & (PAGE - 1))) * 512 + lane * 8; kp = C.cache_k + ro; vp = C.cache_v + ro; }
                else { const size_t ro = (size_t)(b * DS + (s - PAST)) * 512 + lane * 8; kp = C.out + OFF_K_S + ro; vp = C.out + OFF_V_S + ro; }
                load8_f32(kp, kk[u]); load8_f32(vp, vv[u]);
            } else {
                const size_t ro = (size_t)(b * SEQ + s) * 512 + lane * 8;
                load8_bf16((const bf16_t*)(C.ws + WS_K) + ro, kk[u]); load8_bf16((const bf16_t*)(C.ws + WS_V) + ro, vv[u]);
            }
        }
#pragma unroll
        for (int u = 0; u < 4; ++u) if (j0 + u < cnt) {
            float d = 0.f;
#pragma unroll
            for (int e = 0; e < 8; ++e) d = fmaf(q[e], kk[u][e], d);
            d += __shfl_xor(d, 1); d += __shfl_xor(d, 2); d += __shfl_xor(d, 4);
            const float mn = fmaxf(mrun, d); const float corr = __builtin_amdgcn_exp2f(mrun - mn), p = __builtin_amdgcn_exp2f(d - mn);
            l = l * corr + p;
#pragma unroll
            for (int e = 0; e < 8; ++e) o[e] = o[e] * corr + p * vv[u][e];
            mrun = mn;
        }
    }
    const float il = 1.0f / l;
#pragma unroll
    for (int e = 0; e < 8; ++e) o[e] *= il;
    store8_bf16((bf16_t*)(C.ws + WS_AMIX) + (size_t)r * 1024 + 512 + lane * 8, o);
}
__device__ __forceinline__ float dpp_sum8(float x) {
    x += __builtin_bit_cast(float, __builtin_amdgcn_update_dpp(0, __builtin_bit_cast(int, x), 0xB1, 0xF, 0xF, true));
    x += __builtin_bit_cast(float, __builtin_amdgcn_update_dpp(0, __builtin_bit_cast(int, x), 0x4E, 0xF, 0xF, true));
    x += __builtin_bit_cast(float, __builtin_amdgcn_update_dpp(0, __builtin_bit_cast(int, x), 0x141, 0xF, 0xF, true));
    return x;
}
__device__ __forceinline__ void gather_half(const Ctx& C, int r, int hf, int lane, float* part) {
    const int rl = r - MP, b = rl >> 3;
    const int* list = (const int*)(C.ws + WS_SEL) + (size_t)r * TOPK + 128 * hf;
    int rowid[2];
#pragma unroll
    for (int c = 0; c < 2; ++c) { const int s = list[64 * c + lane];
        rowid[c] = (s < PAST) ? (C.page_table[b * NPAGES + (s >> 7)] * PAGE + (s & (PAGE - 1))) : (0x40000000 | (b * DS + (s - PAST))); }
    float q[8]; load8_bf16((const bf16_t*)(C.ws + WS_Q) + (size_t)r * 512 + lane * 8, q);
    float mrun = -1e30f, l = 0.f, o[8];
#pragma unroll
    for (int e = 0; e < 8; ++e) o[e] = 0.f;
    const float* newK = C.out + OFF_K_S; const float* newV = C.out + OFF_V_S;
#define G_LOAD(KK, VV, c_, j_) do { _Pragma("unroll") for (int u = 0; u < 4; ++u) { \
        const int id = __builtin_amdgcn_readlane(rowid[c_], (j_) + u); const bool isnew = (id >> 30) != 0; const size_t ro = (size_t)(id & 0x3FFFFFFF) * 512; \
        const float* kp = (isnew ? newK : C.cache_k) + ro + lane * 8; const float* vp = (isnew ? newV : C.cache_v) + ro + lane * 8; \
        load8_f32(kp, KK[u]); load8_f32(vp, VV[u]); } } while (0)
#define G_FOLD(KK, VV) do { float d[4]; float mx = mrun; \
        _Pragma("unroll") for (int u = 0; u < 4; ++u) { float t = 0.f; _Pragma("unroll") for (int e = 0; e < 8; ++e) t = fmaf(q[e], KK[u][e], t); d[u] = dpp_sum8(t); mx = fmaxf(mx, d[u]); } \
        const float corr = __builtin_amdgcn_exp2f(mrun - mx); l *= corr; \
        _Pragma("unroll") for (int e = 0; e < 8; ++e) o[e] *= corr; \
        _Pragma("unroll") for (int u = 0; u < 4; ++u) { const float p = __builtin_amdgcn_exp2f(d[u] - mx); l += p; _Pragma("unroll") for (int e = 0; e < 8; ++e) o[e] = fmaf(p, VV[u][e], o[e]); } \
        mrun = mx; } while (0)
#pragma unroll
    for (int c = 0; c < 2; ++c) {
        float ka[4][8], va[4][8], kb[4][8], vb[4][8];
        G_LOAD(ka, va, c, 0);
#pragma unroll 1
        for (int j0 = 0; j0 < 64; j0 += 8) {
            G_LOAD(kb, vb, c, j0 + 4);
            G_FOLD(ka, va);
            if (j0 + 8 < 64) G_LOAD(ka, va, c, j0 + 8);
            G_FOLD(kb, vb);
        }
    }
#undef G_LOAD
#undef G_FOLD
    part[lane * 10] = mrun; part[lane * 10 + 1] = l;
#pragma unroll
    for (int e = 0; e < 8; ++e) part[lane * 10 + 2 + e] = o[e];
}
struct AttnOrder {
    int v, i0, n;
    __device__ __forceinline__ bool next(int i, attn_body::AttnUnit& u) const { if (i >= n) return false; const int s = v & 15; u.bh = v >> 4; u.qb = (i0 + i == 0) ? s : 31 - s; return true; }
    __device__ __forceinline__ void a_ready(const attn_body::AttnUnit&) const {}
    __device__ __forceinline__ void done(const attn_body::AttnUnit&) const {}
};
__device__ __forceinline__ void ph4_gather_unit(const Ctx& C, int u, unsigned char* lds, int lane2) {
    const int batch = (u & 7) + 8 * (u >> 4), r = MP + batch * DS + 4 * ((u >> 3) & 1) + (C.wave & 3), hf = C.wave >> 2;
    float* part = (float*)lds + C.wave * 640;
    __syncthreads();
    gather_half(C, r, hf, lane2, part);
    __syncthreads();
    if (C.wave < 4) {
        const float* p0 = part + lane2 * 10; const float* p1 = p0 + 4 * 640;
        const float m0 = p0[0], m1 = p1[0], m = fmaxf(m0, m1), c0 = __builtin_amdgcn_exp2f(m0 - m), c1 = __builtin_amdgcn_exp2f(m1 - m);
        const float il = 1.0f / (p0[1] * c0 + p1[1] * c1); float o[8];
#pragma unroll
        for (int e = 0; e < 8; ++e) o[e] = (p0[2 + e] * c0 + p1[2 + e] * c1) * il;
        store8_bf16((bf16_t*)(C.ws + WS_AMIX) + (size_t)r * 1024 + 512 + lane2 * 8, o);
    }
    __syncthreads();
}
__device__ __forceinline__ void ph4_attn_conv(const Ctx& C, unsigned char* lds) {
    const attn_body::AttnTensors AT{(const attn_body::bf16*)(C.ws + WS_Q), (const attn_body::bf16*)(C.ws + WS_K), (const attn_body::bf16*)(C.ws + WS_V),
                                    (attn_body::bf16*)(C.ws + WS_AMIX) + 512, (const u64*)(C.ws + WS_MASK), C.wave};
    const int vcu = (C.G % 8 == 0) ? (C.bid % 8) * (C.G / 8) + C.bid / 8 : C.bid;
    const int mode = (C.bid >> 4) % 3;
    for (int v = vcu, u = C.bid; v < 256; v += C.G, u += C.G) {
        if (mode == 0) ph4_gather_unit(C, u, lds, fresh_lane());
        { const AttnOrder S{v, 0, 1}; attn_body::attn_phase<AttnOrder>((char*)lds, AT, S); }
        if (mode == 1) ph4_gather_unit(C, u, lds, fresh_lane());
        { const AttnOrder S{v, 1, 1}; attn_body::attn_phase<AttnOrder>((char*)lds, AT, S); }
        if (mode == 2) ph4_gather_unit(C, u, lds, fresh_lane());
        if (PROBE_DUP == 24) ph4_gather_unit(C, u, lds, fresh_lane());
    }
}

typedef __bf16 bf16x2_t __attribute__((ext_vector_type(2)));
__device__ __forceinline__ float dot2bf(unsigned a, unsigned b, float c) { return __builtin_amdgcn_fdot2_f32_bf16(__builtin_bit_cast(bf16x2_t, a), __builtin_bit_cast(bf16x2_t, b), c, false); }
__device__ __forceinline__ float dpp_sum16(float x) {
    x += __builtin_bit_cast(float, __builtin_amdgcn_update_dpp(0, __builtin_bit_cast(int, x), 0xB1, 0xF, 0xF, true));
    x += __builtin_bit_cast(float, __builtin_amdgcn_update_dpp(0, __builtin_bit_cast(int, x), 0x4E, 0xF, 0xF, true));
    x += __builtin_bit_cast(float, __builtin_amdgcn_update_dpp(0, __builtin_bit_cast(int, x), 0x141, 0xF, 0xF, true));
    x += __builtin_bit_cast(float, __builtin_amdgcn_update_dpp(0, __builtin_bit_cast(int, x), 0x140, 0xF, 0xF, true));
    return x;
}
__device__ __forceinline__ void memattn_unit(const Ctx& C, int r0, const float* kp0, const float* vp0, unsigned char* lds, int lane) {
    const int w = C.wave, h = lane >> 4;
    float* logits = (float*)lds;
    const bf16_t* qmem = (const bf16_t*)(C.ws + WS_QMEM); const float* ssq = (const float*)(C.ws + ACC_SSQ);
    {
        unsigned q[8][8]; float rsq[8];
#pragma unroll
        for (int qi = 0; qi < 8; ++qi) { const u32x4 a = *(const u32x4*)(qmem + (size_t)(r0 + qi) * 1024 + lane * 16), bq = *(const u32x4*)(qmem + (size_t)(r0 + qi) * 1024 + lane * 16 + 8);
            q[qi][0] = a.x; q[qi][1] = a.y; q[qi][2] = a.z; q[qi][3] = a.w; q[qi][4] = bq.x; q[qi][5] = bq.y; q[qi][6] = bq.z; q[qi][7] = bq.w;
            rsq[qi] = (1.0f / sqrtf(ssq[(r0 + qi) * 4 + h] * (1.f / 256.f) + EPS)) * (0.0625f * 1.4426950408889634f); }
        const float* kbase = kp0 + (size_t)(32 * w) * 1024 + lane * 16;
#pragma unroll 1
        for (int mb = 0; mb < 8; ++mb) {
            f32x4 kr[4][4];
#pragma unroll
            for (int u = 0; u < 4; ++u)
#pragma unroll
                for (int j = 0; j < 4; ++j) kr[u][j] = *(const f32x4*)(kbase + (size_t)(mb * 4 + u) * 1024 + 4 * j);
#pragma unroll
            for (int u = 0; u < 4; ++u) {
                unsigned kb[8];
#pragma unroll
                for (int j = 0; j < 4; ++j) { kb[2 * j] = cvt_pk_bf16(kr[u][j].x, kr[u][j].y); kb[2 * j + 1] = cvt_pk_bf16(kr[u][j].z, kr[u][j].w); }
                const int m = 32 * w + mb * 4 + u;
#pragma unroll
                for (int qi = 0; qi < 8; ++qi) {
                    float p = 0.f;
#pragma unroll
                    for (int e = 0; e < 8; ++e) p = dot2bf(q[qi][e], kb[e], p);
                    p = dpp_sum16(p);
                    if ((lane & 15) == 0) logits[(qi * 4 + h) * 256 + m] = p * rsq[qi];
                }
            }
        }
    }
    __syncthreads();
#pragma unroll
    for (int rr = 0; rr < 4; ++rr) {
        float* row = logits + (4 * w + rr) * 256; float x[4]; float mx = -INFINITY;
#pragma unroll
        for (int j = 0; j < 4; ++j) { x[j] = row[lane + 64 * j]; mx = fmaxf(mx, x[j]); }
        mx = wave_max(mx); float s = 0.f;
#pragma unroll
        for (int j = 0; j < 4; ++j) { x[j] = __builtin_amdgcn_exp2f(x[j] - mx); s += x[j]; }
        s = wave_sum(s); const float is = 1.0f / s;
#pragma unroll
        for (int j = 0; j < 4; ++j) row[lane + 64 * j] = x[j] * is;
    }
    __syncthreads();
    {
        const int hw = w >> 1;
        float acc[8][2];
#pragma unroll
        for (int qi = 0; qi < 8; ++qi) { acc[qi][0] = 0.f; acc[qi][1] = 0.f; }
        const float* vbase = vp0 + 128 * w + 2 * lane;
        float2 va[16];
#pragma unroll
        for (int u = 0; u < 16; ++u) va[u] = *(const float2*)(vbase + (size_t)u * 1024);
#pragma unroll 1
        for (int m0 = 0; m0 < 256; m0 += 16) {
            float2 vb[16];
            const int mn = (m0 + 16 < 256) ? m0 + 16 : m0;
#pragma unroll
            for (int u = 0; u < 16; ++u) vb[u] = *(const float2*)(vbase + (size_t)(mn + u) * 1024);
#pragma unroll
            for (int hf = 0; hf < 2; ++hf) {
#pragma unroll
                for (int qi = 0; qi < 8; ++qi) {
                    const float* pr = logits + (qi * 4 + hw) * 256 + m0 + 8 * hf;
                    const f32x4 p0 = *(const f32x4*)pr, p1 = *(const f32x4*)(pr + 4);
                    acc[qi][0] = fmaf(p0.x, va[8 * hf + 0].x, acc[qi][0]); acc[qi][1] = fmaf(p0.x, va[8 * hf + 0].y, acc[qi][1]);
                    acc[qi][0] = fmaf(p0.y, va[8 * hf + 1].x, acc[qi][0]); acc[qi][1] = fmaf(p0.y, va[8 * hf + 1].y, acc[qi][1]);
                    acc[qi][0] = fmaf(p0.z, va[8 * hf + 2].x, acc[qi][0]); acc[qi][1] = fmaf(p0.z, va[8 * hf + 2].y, acc[qi][1]);
                    acc[qi][0] = fmaf(p0.w, va[8 * hf + 3].x, acc[qi][0]); acc[qi][1] = fmaf(p0.w, va[8 * hf + 3].y, acc[qi][1]);
                    acc[qi][0] = fmaf(p1.x, va[8 * hf + 4].x, acc[qi][0]); acc[qi][1] = fmaf(p1.x, va[8 * hf + 4].y, acc[qi][1]);
                    acc[qi][0] = fmaf(p1.y, va[8 * hf + 5].x, acc[qi][0]); acc[qi][1] = fmaf(p1.y, va[8 * hf + 5].y, acc[qi][1]);
                    acc[qi][0] = fmaf(p1.z, va[8 * hf + 6].x, acc[qi][0]); acc[qi][1] = fmaf(p1.z, va[8 * hf + 6].y, acc[qi][1]);
                    acc[qi][0] = fmaf(p1.w, va[8 * hf + 7].x, acc[qi][0]); acc[qi][1] = fmaf(p1.w, va[8 * hf + 7].y, acc[qi][1]);
                }
                __builtin_amdgcn_sched_barrier(0);
            }
#pragma unroll
            for (int u = 0; u < 16; ++u) va[u] = vb[u];
        }
        bf16_t* op = (bf16_t*)(C.ws + WS_OMEM) + (size_t)r0 * 1024 + 128 * w + 2 * lane;
#pragma unroll
        for (int qi = 0; qi < 8; ++qi) *(unsigned*)(op + (size_t)qi * 1024) = cvt_pk_bf16(acc[qi][0], acc[qi][1]);
    }
    __syncthreads();
}
__device__ __forceinline__ void memattn_unit_mfma(const Ctx& C, int qg, int h, int lane) {
    const int r32 = lane & 31, hi = lane >> 5; const int b = qg >> 8; const int row = 32 * qg + r32;
    const bf16_t* qp = (const bf16_t*)(C.ws + WS_QMEM) + (size_t)row * 1024 + h * 256 + hi * 8;
    bf16x8 qf[16];
#pragma unroll
    for (int ks = 0; ks < 16; ++ks) qf[ks] = *(const bf16x8*)(qp + ks * 16);
    const float c = (1.0f / sqrtf(((const float*)(C.ws + ACC_SSQ))[row * 4 + h] * (1.f / 256.f) + EPS)) * (0.0625f * 1.4426950408889634f);
    const bf16x8* kF = (const bf16x8*)(C.ws + WS_MKF) + (size_t)((b * 4 + h) * 8 * 16) * 64 + lane;
    f32x16 S[8];
#pragma unroll
    for (int mb = 0; mb < 8; ++mb) {
        S[mb] = f32x16{};
#pragma unroll
        for (int kh = 0; kh < 2; ++kh) {
            bf16x8 kf[8];
#pragma unroll
            for (int k8 = 0; k8 < 8; ++k8) kf[k8] = kF[(size_t)(mb * 16 + kh * 8 + k8) * 64];
            __builtin_amdgcn_sched_barrier(0);
#pragma unroll
            for (int k8 = 0; k8 < 8; ++k8) S[mb] = __builtin_amdgcn_mfma_f32_32x32x16_bf16(kf[k8], qf[kh * 8 + k8], S[mb], 0, 0, 0);
            __builtin_amdgcn_sched_barrier(0);
        }
    }
    float mx = -INFINITY;
#pragma unroll
    for (int mb = 0; mb < 8; ++mb)
#pragma unroll
        for (int r = 0; r < 16; ++r) mx = fmaxf(mx, S[mb][r]);
    mx = fmaxf(mx, __shfl_xor(mx, 32));
    const float mc = mx * c; float sum = 0.f;
    unsigned pk[8][2][4];
#pragma unroll
    for (int mb = 0; mb < 8; ++mb) {
        float p[16];
#pragma unroll
        for (int r = 0; r < 16; ++r) { p[r] = __builtin_amdgcn_exp2f(S[mb][r] * c - mc); sum += p[r]; }
#pragma unroll
        for (int s = 0; s < 2; ++s)
#pragma unroll
            for (int j = 0; j < 4; ++j) pk[mb][s][j] = cvt_pk_bf16(p[8 * s + 2 * j], p[8 * s + 2 * j + 1]);
    }
    sum += __shfl_xor(sum, 32); const float inv = 1.0f / sum;
    const bf16x8* vF = (const bf16x8*)(C.ws + WS_MVF) + (size_t)((b * 4 + h) * 8 * 16) * 64 + lane;
    bf16_t* op = (bf16_t*)(C.ws + WS_OMEM) + (size_t)row * 1024 + h * 256 + 4 * hi;
#pragma unroll
    for (int db = 0; db < 8; ++db) {
        f32x16 O = f32x16{};
#pragma unroll
        for (int mh = 0; mh < 2; ++mh) {
            bf16x8 vf[8];
#pragma unroll
            for (int k8 = 0; k8 < 8; ++k8) vf[k8] = vF[(size_t)(db * 16 + mh * 8 + k8) * 64];
            __builtin_amdgcn_sched_barrier(0);
#pragma unroll
            for (int k8 = 0; k8 < 8; ++k8) { const int mb = mh * 4 + (k8 >> 1), s = k8 & 1;
                const u32x4 pw = (u32x4){pk[mb][s][0], pk[mb][s][1], pk[mb][s][2], pk[mb][s][3]};
                O = __builtin_amdgcn_mfma_f32_32x32x16_bf16(vf[k8], __builtin_bit_cast(bf16x8, pw), O, 0, 0, 0); }
            __builtin_amdgcn_sched_barrier(0);
        }
#pragma unroll
        for (int rq = 0; rq < 4; ++rq) {
            const unsigned w0 = cvt_pk_bf16(O[4 * rq] * inv, O[4 * rq + 1] * inv), w1 = cvt_pk_bf16(O[4 * rq + 2] * inv, O[4 * rq + 3] * inv);
            *(u64*)(op + 32 * db + 8 * rq) = (u64)w0 | ((u64)w1 << 32);
        }
    }
}
__device__ __forceinline__ void ph7_memattn(const Ctx& C, unsigned char* lds, unsigned* q, volatile LAS unsigned* slot) {
    for (;;) {
        const int it = queue_pop(q, slot);
        if (it >= DB + 256) break;
        if (it < DB) { const int r0 = MP + it * 8; memattn_unit(C, r0, C.cmem_k + (size_t)it * 262144, C.cmem_v + (size_t)it * 262144, lds, fresh_lane()); }
        else { const int uu = __builtin_amdgcn_readfirstlane((it - DB) * NWAVES + C.wave); memattn_unit_mfma(C, uu >> 2, uu & 3, fresh_lane()); }
    }
}

__device__ __forceinline__ void ph10_ffn_act(const Ctx& C) {
    const int gt = C.bid * NTHREADS + C.tid, NGT = C.G * NTHREADS;
    const float* G = (const float*)(C.ws + WS_G); const bf16_t* UP = (const bf16_t*)(C.ws + WS_UP); bf16_t* aff = (bf16_t*)(C.ws + WS_AFF);
    constexpr int CG = DFF / 8;
    for (int it = gt; it < MT * CG; it += NGT) {
        const int r = it / CG, c = (it - r * CG) * 8;
        float g0[8], p1[8], p2[8], up[8], w0[8], w1[8], w2[8], bb[8], y[8];
        load8_f32(G + (size_t)r * DFF + c, g0); load8_bf16(UP + (size_t)r * DFF + c, up);
        load8_f32(C.conv_ffn_w + c, w0); load8_f32(C.conv_ffn_w + DFF + c, w1); load8_f32(C.conv_ffn_w + 2 * DFF + c, w2); load8_f32(C.conv_ffn_b + c, bb);
        if (r < MP) {
            const int t = r & (SEQ - 1), b = r >> 13;
            if (t >= 1) load8_f32(G + (size_t)(r - 1) * DFF + c, p1); else { for (int e = 0; e < 8; ++e) p1[e] = 0.f; }
            if (t >= 2) load8_f32(G + (size_t)(r - 2) * DFF + c, p2); else { for (int e = 0; e < 8; ++e) p2[e] = 0.f; }
            if (t >= SEQ - 2) store8_f32(C.out + OFF_CF_P + (size_t)(b * 2 + (t - (SEQ - 2))) * DFF + c, g0);
        } else {
            const int rl = r - MP, b = rl >> 3, tt = rl & 7;
            if (tt >= 1) load8_f32(G + (size_t)(r - 1) * DFF + c, p1); else load8_f32(C.st_ffn + (size_t)(b * 2 + 1) * DFF + c, p1);
            if (tt >= 2) load8_f32(G + (size_t)(r - 2) * DFF + c, p2); else load8_f32(C.st_ffn + (size_t)(b * 2 + tt) * DFF + c, p2);
            if (tt >= 6) store8_f32(C.out + OFF_CF_S + (size_t)(b * 2 + (tt - 6)) * DFF + c, g0);
        }
#pragma unroll
        for (int e = 0; e < 8; ++e) { const float z = w0[e] * p2[e] + w1[e] * p1[e] + w2[e] * g0[e] + bb[e]; y[e] = (z / (1.0f + __expf(-z))) * up[e]; }
        store8_bf16(aff + (size_t)r * DFF + c, y);
    }
}

__device__ __forceinline__ void memattn_tile_lds(const Ctx& C, int pm, int h, unsigned char* lds) {
    const int lane = fresh_lane(), tid = C.wave * 64 + lane, r32 = lane & 31, hi = lane >> 5; const int b = pm >> 5; const int row = 256 * pm + 32 * C.wave + r32;
    LAS unsigned char* ldsl = (LAS unsigned char*)lds;
    const u32x4* kG = (const u32x4*)(C.ws + WS_MKF) + (size_t)((b * 4 + h) * 8 * 16) * 64;
    const u32x4* vG = (const u32x4*)(C.ws + WS_MVF) + (size_t)((b * 4 + h) * 8 * 16) * 64;
#pragma unroll 1
    for (int i0 = 0; i0 < 16; i0 += 8) { u32x4 t[8];
#pragma unroll
      for (int i = 0; i < 8; ++i) t[i] = kG[(i0 + i) * 512 + tid];
#pragma unroll
      for (int i = 0; i < 8; ++i) *(LAS u32x4*)(ldsl + (size_t)((i0 + i) * 512 + tid) * 16) = t[i]; }
    __builtin_amdgcn_sched_barrier(0);
    const bf16_t* qp = (const bf16_t*)(C.ws + WS_QMEM) + (size_t)row * 1024 + h * 256 + hi * 8;
    bf16x8 qf[16];
#pragma unroll
    for (int ks = 0; ks < 16; ++ks) qf[ks] = *(const bf16x8*)(qp + ks * 16);
    const float c = (1.0f / sqrtf(((const float*)(C.ws + ACC_SSQ))[row * 4 + h] * (1.f / 256.f) + EPS)) * (0.0625f * 1.4426950408889634f);
    __syncthreads();
    const LAS unsigned char* fL0 = ldsl + lane * 16; const LAS unsigned char* fL1 = fL0 + 65536;
#define FRAG(f) (*(const LAS bf16x8*)(((f) < 64 ? fL0 : fL1) + ((f) & 63) * 1024))
    float sum = 0.f;
    unsigned pk[8][2][4];
#pragma unroll
    for (int mb = 0; mb < 8; ++mb) {
        f32x16 S = f32x16{};
#pragma unroll
        for (int kh = 0; kh < 2; ++kh) {
            bf16x8 kf[8];
#pragma unroll
            for (int k8 = 0; k8 < 8; ++k8) kf[k8] = FRAG(mb * 16 + kh * 8 + k8);
#pragma unroll
            for (int k8 = 0; k8 < 8; ++k8) S = __builtin_amdgcn_mfma_f32_32x32x16_bf16(kf[k8], qf[kh * 8 + k8], S, 0, 0, 0);
        }
        float p[16];
#pragma unroll
        for (int r = 0; r < 16; ++r) { p[r] = __builtin_amdgcn_exp2f(S[r] * c); sum += p[r]; }
        asm volatile("" : "+v"(sum));
#pragma unroll
        for (int s2 = 0; s2 < 2; ++s2)
#pragma unroll
            for (int j = 0; j < 4; ++j) pk[mb][s2][j] = cvt_pk_bf16(p[8 * s2 + 2 * j], p[8 * s2 + 2 * j + 1]);
    }
    sum += __shfl_xor(sum, 32); const float inv = 1.0f / sum;
    __syncthreads();
#pragma unroll 1
    for (int i0 = 0; i0 < 16; i0 += 8) { u32x4 t[8];
#pragma unroll
      for (int i = 0; i < 8; ++i) t[i] = vG[(i0 + i) * 512 + tid];
#pragma unroll
      for (int i = 0; i < 8; ++i) *(LAS u32x4*)(ldsl + (size_t)((i0 + i) * 512 + tid) * 16) = t[i]; }
    __syncthreads();
    bf16_t* op = (bf16_t*)(C.ws + WS_OMEM) + (size_t)row * 1024 + h * 256 + 4 * hi;
#pragma unroll
    for (int db = 0; db < 8; ++db) {
        f32x16 O = f32x16{};
#pragma unroll
        for (int mh = 0; mh < 2; ++mh) {
            bf16x8 vf[8];
#pragma unroll
            for (int k8 = 0; k8 < 8; ++k8) vf[k8] = FRAG(db * 16 + mh * 8 + k8);
#pragma unroll
            for (int k8 = 0; k8 < 8; ++k8) { const int mb = mh * 4 + (k8 >> 1), s = k8 & 1;
                const u32x4 pw = (u32x4){pk[mb][s][0], pk[mb][s][1], pk[mb][s][2], pk[mb][s][3]};
                O = __builtin_amdgcn_mfma_f32_32x32x16_bf16(vf[k8], __builtin_bit_cast(bf16x8, pw), O, 0, 0, 0); }
        }
#pragma unroll
        for (int rq = 0; rq < 4; ++rq) {
            const unsigned w0 = cvt_pk_bf16(O[4 * rq] * inv, O[4 * rq + 1] * inv), w1 = cvt_pk_bf16(O[4 * rq + 2] * inv, O[4 * rq + 3] * inv);
            *(u64*)(op + 32 * db + 8 * rq) = (u64)w0 | ((u64)w1 << 32);
        }
    }
#undef FRAG
    __syncthreads();
}
__global__ void __launch_bounds__(NTHREADS, 2) fwd(Args args) {
    extern __shared__ __attribute__((aligned(16))) unsigned char lds[];
    Ctx C;
    C.x_p = (const float*)args.in[0]; C.x_s = (const float*)args.in[1]; C.cache_k = (const float*)args.in[2]; C.cache_v = (const float*)args.in[3]; C.cache_ik = (const float*)args.in[4];
    C.st_mix = (const float*)args.in[5]; C.st_ffn = (const float*)args.in[6]; C.cmem_k = (const float*)args.in[7]; C.cmem_v = (const float*)args.in[8]; C.page_table = (const int*)args.in[9];
    C.mem_p = (const float*)args.in[10]; C.g_mix = (const float*)args.in[11]; C.w_in = (const float*)args.in[12]; C.conv_mix_w = (const float*)args.in[13]; C.q_g = (const float*)args.in[14];
    C.k_g = (const float*)args.in[15]; C.w_out = (const float*)args.in[16]; C.g_mem = (const float*)args.in[17]; C.g_mem_src = (const float*)args.in[18]; C.w_q = (const float*)args.in[19];
    C.w_kv = (const float*)args.in[20]; C.mq_g = (const float*)args.in[21]; C.mk_g = (const float*)args.in[22]; C.w_o = (const float*)args.in[23]; C.g_ffn = (const float*)args.in[24];
    C.w_gu = (const float*)args.in[25]; C.conv_ffn_w = (const float*)args.in[26]; C.conv_ffn_b = (const float*)args.in[27]; C.w_down = (const float*)args.in[28];
    C.out = args.out; C.ws = args.ws;
    C.wave = __builtin_amdgcn_readfirstlane(threadIdx.x >> 6); C.lane = fresh_lane(); C.tid = C.wave * 64 + C.lane; C.G = gridDim.x; C.bid = blockIdx.x;
    unsigned char* ws = args.ws;
    LAS unsigned char* ldsl = (LAS unsigned char*)lds;
    volatile LAS unsigned* MISC = (volatile LAS unsigned*)(ldsl + MISC_OFF);
    for (int u = C.tid; u < (LDS_BYTES - RING_BYTES) / 4; u += NTHREADS) ((LAS unsigned*)(ldsl + RING_BYTES))[u] = 0u;
    __syncthreads();
    XcdBarrier bar; bar.bar = (unsigned*)(ws + WS_CTL) + CW_BAR; bar.x = 0; bar.st = nullptr;
    if (N_LAUNCHES == 1) bar = xcd_barrier_post((unsigned*)(ws + WS_CTL) + CW_BAR, MISC + 8);
    bar.wv = C.wave;
    const int lo = args.ph_lo, hi = args.ph_hi;
#ifndef PHMASK
#define PHMASK 0xFFFF
#endif
#define IN(k) (((PHMASK >> (k)) & 1) && lo <= (k) && (k) < hi)
#define DUP(k) (PROBE_DUP == (k))
#define SEAM(k) do { if (IN(k) && IN((k) + 1)) xcd_barrier(bar); C.lane = fresh_lane(); C.tid = C.wave * 64 + C.lane; } while (0)
    float* ss1 = (float*)(ws + ACC_SS1); float* ss2 = (float*)(ws + ACC_SS2); float* ssq = (float*)(ws + ACC_SSQ); float* ssk = (float*)(ws + ACC_SSK);
    float* rstd = (float*)(ws + WS_RSTD);

    if (IN(0)) { ph0_prologue(C, lds); if (DUP(0)) { __syncthreads(); ph0_prologue(C, lds); } } SEAM(0);
    if (IN(1)) {
        { pg8::Gemm g{(const bf16_t*)(ws + WS_XB), (const bf16_t*)(ws + WS_WIN), MT, DINP, DM, C.wave}; pg8::StaticOrder S; S.init(MT, DINP, C.G, C.bid);
          EpiIn E{rstd, (const float*)(ws + WS_COS), (const float*)(ws + WS_SIN), C.q_g, C.k_g, (bf16_t*)(ws + WS_CB), (bf16_t*)(ws + WS_U), (bf16_t*)(ws + WS_Q), (bf16_t*)(ws + WS_K), (bf16_t*)(ws + WS_V),
                  (bf16_t*)(ws + WS_QI), (bf16_t*)(ws + WS_KI), (float*)(ws + WS_IW), (float*)(ws + WS_QIF), C.out};
          pg8::gemm_phase<EpiIn, pg8::StaticOrder, true, true>(ldsl, g, S, E);
          if (DUP(1)) pg8::gemm_phase<EpiIn, pg8::StaticOrder, true, true>(ldsl, g, S, E); }
        { EpiKv E{rstd + MT, ssk, C.out};
          for (int t = C.bid; t < 256; t += C.G) gemm_small2_rc<DM, EpiKv>((const bf16_t*)(ws + WS_MEMB), (const bf16_t*)(ws + WS_WKV), (t >> 5) * 64, (t & 31) * 64, C.wave, fresh_lane(), E, lds); }
    } SEAM(1);
    if (IN(2)) { ph2_scores_select(C, lds, (unsigned*)(ws + WS_CTL) + CQ_PH2, MISC + 16); } SEAM(2);
    if (IN(4)) { ph4_attn_conv(C, lds); if (DUP(4)) { __syncthreads(); ph4_attn_conv(C, lds); } } SEAM(4);
    if (IN(5)) {
        pg8::Gemm g{(const bf16_t*)(ws + WS_AMIX), (const bf16_t*)(ws + WS_WOUT), MP, DM, DM, C.wave}; pg8::StaticOrder S; S.init(MP, DM, C.G, C.bid);
        EpiRes E{C.x_p, C.x_s, nullptr, nullptr, nullptr, (bf16_t*)(ws + WS_H1B), ss1};
        pg8::gemm_phase<EpiRes, pg8::StaticOrder, true, true>(ldsl, g, S, E);
        for (int t = C.bid; t < 256; t += C.G) gemm_small2<DM, EpiRes>(g.A, g.Bt, t, C.wave, fresh_lane(), E, lds);
        if (DUP(15)) { EpiRes E2{C.x_p, C.x_s, nullptr, nullptr, nullptr, (bf16_t*)(ws + WS_H1B), nullptr}; for (int t = C.bid; t < 256; t += C.G) gemm_small<EpiRes>(g.A, g.Bt, DM, t, C.wave, fresh_lane(), E2); }
        if (DUP(5)) { EpiRes E2{C.x_p, C.x_s, nullptr, nullptr, nullptr, (bf16_t*)(ws + WS_H1B), nullptr}; pg8::gemm_phase<EpiRes, pg8::StaticOrder, true, true>(ldsl, g, S, E2); }
    } SEAM(5);
    if (IN(6)) {
        pg8::Gemm g{(const bf16_t*)(ws + WS_H1B), (const bf16_t*)(ws + WS_WQ), MP, DM, DM, C.wave}; pg8::StaticOrder S; S.init(MP, DM, C.G, C.bid);
        EpiQm E{ss1, C.mq_g, (bf16_t*)(ws + WS_QMEM), ssq};
        pg8::gemm_phase<EpiQm, pg8::StaticOrder, true, true>(ldsl, g, S, E);
        const bool one = (MP / 256) * (DM / 256) <= C.G;
        if (one) {
            const int nM = MP / 256, nN = DM / 256, nwg = nM * nN; int wgid = C.bid;
            if (wgid < nwg) { const int q = nwg / 8, r = nwg % 8, xcd = wgid % 8, off = wgid / 8; wgid = (xcd < r ? xcd * (q + 1) : r * (q + 1) + (xcd - r) * q) + off;
                const int nig = 8 * nN, gid = wgid / nig, fm = gid * 8, gsz = (nM - fm) < 8 ? (nM - fm) : 8; const int pm = fm + ((wgid % nig) % gsz), pn = (wgid % nig) / gsz;
                asm volatile("s_waitcnt vmcnt(0)" ::: "memory");
                __syncthreads();
                memattn_tile_lds(C, pm, pn, lds); }
        }
        for (int t = C.bid; t < 256; t += C.G) gemm_small2<DM, EpiQm>(g.A, g.Bt, t, C.wave, fresh_lane(), E, lds);
        if (!one) { xcd_barrier(bar); for (int u = C.bid * NWAVES + C.wave; u < 2048; u += C.G * NWAVES) { const int uu = __builtin_amdgcn_readfirstlane(u); memattn_unit_mfma(C, uu >> 2, uu & 3, fresh_lane()); } }
    } SEAM(6);
    if (IN(7)) {
        const int wg0 = (C.G > DB) ? DB : 0;
        if (C.bid < wg0 || wg0 == 0) for (int u = C.bid; u < DB; u += (wg0 ? wg0 : C.G)) memattn_unit(C, MP + u * 8, C.cmem_k + (size_t)u * 262144, C.cmem_v + (size_t)u * 262144, lds, fresh_lane());
        if (C.bid >= wg0) {
            pg8::Gemm g{(const bf16_t*)(ws + WS_OMEM), (const bf16_t*)(ws + WS_WO), MP, DM, DM, C.wave}; pg8::StaticOrder S; S.init(MP, DM, C.G - wg0, C.bid - wg0);
            EpiRes E{nullptr, nullptr, (const bf16_t*)(ws + WS_H1B), nullptr, nullptr, (bf16_t*)(ws + WS_H2B), ss2};
            pg8::gemm_phase<EpiRes, pg8::StaticOrder, true, true>(ldsl, g, S, E);
        }
    } SEAM(7);
    if (IN(8)) {
        pg8::Gemm g{(const bf16_t*)(ws + WS_OMEM), (const bf16_t*)(ws + WS_WO), MP, DM, DM, C.wave};
        EpiRes E{nullptr, nullptr, (const bf16_t*)(ws + WS_H1B), nullptr, nullptr, (bf16_t*)(ws + WS_H2B), ss2};
        for (int t = C.bid; t < 256; t += C.G) gemm_small2<DM, EpiRes>(g.A, g.Bt, t, C.wave, fresh_lane(), E, lds);
    } SEAM(8);
    if (IN(9)) {
        pg8::Gemm g{(const bf16_t*)(ws + WS_H2B), (const bf16_t*)(ws + WS_WGU), MT, 2 * DFF, DM, C.wave}; pg8::StaticOrder S; S.init(MT, 2 * DFF, C.G, C.bid);
        EpiGu E{ss2, C.conv_ffn_w, C.conv_ffn_b, C.st_ffn, (bf16_t*)(ws + WS_AFF), (float*)(ws + WS_SIDEG), (float*)(ws + WS_SIDEU), (float*)(ws + WS_LASTG), C.out, (float*)(lds + HALO_OFF)};
        pg8::gemm_phase<EpiGu, pg8::StaticOrder, true, true>(ldsl, g, S, E);
        if (DUP(9)) pg8::gemm_phase<EpiGu, pg8::StaticOrder, true, true>(ldsl, g, S, E);
    } SEAM(9);
    if (IN(11)) {
        pg8::Gemm g{(const bf16_t*)(ws + WS_AFF), (const bf16_t*)(ws + WS_WDOWN), MP, DM, DFF, C.wave}; pg8::StaticOrder S; S.init(MP, DM, C.G, C.bid);
        { const int nM = MP / 256, nN = DM / 256, nwg = nM * nN; int wgid = C.bid;
          if (wgid < nwg) { const int q = nwg / 8, r = nwg % 8, xcd = wgid % 8, off = wgid / 8; wgid = (xcd < r ? xcd * (q + 1) : r * (q + 1) + (xcd - r) * q) + off;
            const int nig = 8 * nN, gid = wgid / nig, fm = gid * 8, gsz = (nM - fm) < 8 ? (nM - fm) : 8; ffn_fixup_rows(C, fm + ((wgid % nig) % gsz)); } }
        EpiRes E{nullptr, nullptr, (const bf16_t*)(ws + WS_H2B), C.out + OFF_Y_P, C.out + OFF_Y_S, nullptr, nullptr};
        pg8::gemm_phase<EpiRes, pg8::StaticOrder, true, true>(ldsl, g, S, E);
        for (int t = C.bid; t < 256; t += C.G) gemm_small2<DFF, EpiRes>(g.A, g.Bt, t, C.wave, fresh_lane(), E, lds);
        if (DUP(11)) pg8::gemm_phase<EpiRes, pg8::StaticOrder, true, true>(ldsl, g, S, E);
    }
#undef IN
#undef SEAM
}

extern "C" void kernel_launch(void* const* d_in, const int* in_sizes, int n_in, void* d_out, int out_size, void* d_ws, size_t ws_size, hipStream_t stream) {
    static int grid = 0;
    if (grid == 0) {
        if (n_in != 29 || (size_t)out_size != OUT_TOTAL || ws_size < WS_END) { fprintf(stderr, "kernel_launch: unexpected problem (n_in %d, out %d, ws %zu); nothing launched\n", n_in, out_size, ws_size); grid = -1; return; }
        int dev = 0, cus = 0;
        if (hipGetDevice(&dev) != hipSuccess || hipDeviceGetAttribute(&cus, hipDeviceAttributeMultiprocessorCount, dev) != hipSuccess) { grid = -1; return; }
        if (hipFuncSetAttribute((const void*)fwd, hipFuncAttributeMaxDynamicSharedMemorySize, LDS_BYTES) != hipSuccess) { fprintf(stderr, "kernel_launch: hipFuncSetAttribute failed\n"); grid = -1; return; }
        (void)hipGetLastError();
        grid = cus;
    }
    if (grid < 0) return;
    (void)hipMemsetAsync((char*)d_ws + WS_CTL, 0, CTL_ZERO_BYTES, stream);
    Args a{};
    for (int i = 0; i < 29; ++i) a.in[i] = d_in[i];
    a.out = (float*)d_out; a.ws = (unsigned char*)d_ws;
    if (N_LAUNCHES == 1) { a.ph_lo = 0; a.ph_hi = NPHASE; hipLaunchKernelGGL(fwd, dim3(grid), dim3(NTHREADS), LDS_BYTES, stream, a); }
    else for (int p = 0; p < NPHASE; ++p) { a.ph_lo = p; a.ph_hi = p + 1; hipLaunchKernelGGL(fwd, dim3(grid), dim3(NTHREADS), LDS_BYTES, stream, a); }
}
```

```cpp
#include <hip/hip_runtime.h>
#include <cstdio>
#include <cstdint>

#ifndef MK_N_LAUNCHES
#define MK_N_LAUNCHES 1
#endif

__device__ __forceinline__ int fresh_lane() { int l; asm volatile("v_mbcnt_lo_u32_b32 %0, -1, 0\n\tv_mbcnt_hi_u32_b32 %0, -1, %0" : "=v"(l)); return l; }

#include <hip/hip_bf16.h>
#include <cmath>
namespace attn_body {
using bf16=__hip_bfloat16;
using bf16x8=__attribute__((ext_vector_type(8)))short;
using s16x4=__attribute__((ext_vector_type(4)))short;
using f32x16=__attribute__((ext_vector_type(16)))float;
using u32x4=__attribute__((ext_vector_type(4)))unsigned;
constexpr int BATCH=2,NHEAD=8,SEQ=8192,D=64,DM=NHEAD*D,OPITCH=1024;
constexpr int NW=8,QBLK=32,QB=QBLK*NW,KVBLK=64,NQB=SEQ/QB;
constexpr int ATTN_PITCH=DM, ATTN_UNIT_ROWS=QB;
__device__ __forceinline__ int crow(int r,int hi){return (r&3)+8*(r>>2)+4*hi;}
#define SBAR() __builtin_amdgcn_sched_barrier(0)
__device__ __forceinline__ void cmask(f32x16&p0,f32x16&p1,int jb,int qrel,int hi){
  const float NEG=-INFINITY; int kb=64*jb+4*hi;
  #pragma unroll
  for(int r=0;r<16;++r){int kv=kb+(r&3)+8*(r>>2); if(kv>qrel)p0[r]=NEG; if(kv+32>qrel)p1[r]=NEG;}
}

constexpr int NSLOT=3, SLOTB=8192;
constexpr int LDS_K=0, LDS_V=NSLOT*SLOTB, LDS_WS=2*NSLOT*SLOTB, LDS_OST=LDS_WS+NW*64*4, LDS_BYTES=LDS_OST+NW*4096;
constexpr float C2=0.125f*1.4426950408889634f;
__device__ __forceinline__ void glds16(const void*gsrc,unsigned lds_dst){unsigned keep;
  asm volatile("s_mov_b32 %0, m0\n\ts_mov_b32 m0, %2\n\ts_nop 0\n\tglobal_load_lds_dwordx4 %1, off\n\ts_mov_b32 m0, %0":"=&s"(keep):"v"(gsrc),"s"(lds_dst):"memory");}
__device__ __forceinline__ float max3f(float a,float b,float c){float r;asm("v_max3_f32 %0, %1, %2, %3":"=v"(r):"v"(a),"v"(b),"v"(c));return r;}
__device__ __forceinline__ float max2f(float a,float b){float r;asm("v_max_f32_e32 %0, %1, %2":"=v"(r):"v"(a),"v"(b));return r;}
__device__ __forceinline__ float fadd_s(float a,float b){float r;asm("v_add_f32_e32 %0, %1, %2":"=v"(r):"v"(a),"v"(b));return r;}
__device__ __forceinline__ float fsub_s(float a,float b){float r;asm("v_sub_f32_e32 %0, %1, %2":"=v"(r):"v"(a),"v"(b));return r;}
typedef float f32x2_t __attribute__((ext_vector_type(2))); typedef __bf16 bf16x2_t __attribute__((ext_vector_type(2)));
__device__ __forceinline__ unsigned cvtpk_s(float lo,float hi){f32x2_t v={lo,hi};bf16x2_t b=__builtin_convertvector(v,bf16x2_t);return __builtin_bit_cast(unsigned,b);}
#define WAIT_BAR(N) asm volatile("s_waitcnt vmcnt(" #N ") lgkmcnt(0)\n\ts_barrier":::"memory")

__device__ __forceinline__ void qkt(f32x16&p0,f32x16&p1,const char*Kslot,const bf16x8*qr,const f32x16&negm,int r32,int hi){
  const char*kb=Kslot+hi*1024+r32*16;
  #pragma unroll
  for(int d0=0;d0<4;++d0){
    const bf16x8 b0=*reinterpret_cast<const bf16x8*>(kb+d0*2048);
    const bf16x8 b1=*reinterpret_cast<const bf16x8*>(kb+d0*2048+512);
    if(d0==0){p0=__builtin_amdgcn_mfma_f32_32x32x16_bf16(b0,qr[0],negm,0,0,0);p1=__builtin_amdgcn_mfma_f32_32x32x16_bf16(b1,qr[0],negm,0,0,0);}
    else{p0=__builtin_amdgcn_mfma_f32_32x32x16_bf16(b0,qr[d0],p0,0,0,0);p1=__builtin_amdgcn_mfma_f32_32x32x16_bf16(b1,qr[d0],p1,0,0,0);}}
}
typedef __attribute__((address_space(3))) const char* lds_cptr;
typedef short v4i16_t __attribute__((ext_vector_type(4)));
__device__ __forceinline__ void kload8(bf16x8*kf,lds_cptr kp){
  kf[0]=*(const __attribute__((address_space(3))) bf16x8*)(kp);      kf[1]=*(const __attribute__((address_space(3))) bf16x8*)(kp+512);
  kf[2]=*(const __attribute__((address_space(3))) bf16x8*)(kp+2048); kf[3]=*(const __attribute__((address_space(3))) bf16x8*)(kp+2560);
  kf[4]=*(const __attribute__((address_space(3))) bf16x8*)(kp+4096); kf[5]=*(const __attribute__((address_space(3))) bf16x8*)(kp+4608);
  kf[6]=*(const __attribute__((address_space(3))) bf16x8*)(kp+6144); kf[7]=*(const __attribute__((address_space(3))) bf16x8*)(kp+6656);
}
__device__ __forceinline__ void kload2(bf16x8*kf,lds_cptr kp,int j){ kf[2*j]=*(const __attribute__((address_space(3))) bf16x8*)(kp+j*2048); kf[2*j+1]=*(const __attribute__((address_space(3))) bf16x8*)(kp+j*2048+512); }
__device__ __forceinline__ s16x4 vtr(lds_cptr p){ return __builtin_bit_cast(s16x4,__builtin_amdgcn_ds_read_tr16_b64_v4i16((__attribute__((address_space(3))) v4i16_t*)p)); }
__device__ __forceinline__ float rowmax(const f32x16&p0,const f32x16&p1){
  float a=max3f(p0[0],p0[1],p1[0]),b=max3f(p0[2],p0[3],p1[1]);a=max3f(a,p1[2],p1[3]);
  #pragma unroll
  for(int r=4;r<16;r+=4){a=max3f(a,p0[r],p0[r+1]);b=max3f(b,p0[r+2],p0[r+3]);a=max3f(a,p1[r],p1[r+1]);b=max3f(b,p1[r+2],p1[r+3]);}
  const float m=max2f(a,b);
  auto rr=__builtin_amdgcn_permlane32_swap(__float_as_uint(m),__float_as_uint(m),false,false);
  return max2f(__uint_as_float(rr[0]),__uint_as_float(rr[1]));
}
__device__ __forceinline__ void pv(f32x16*o,int vb,bf16x8 pa0,bf16x8 pa1,bf16x8 pa2,bf16x8 pa3){
  #pragma unroll
  for(int d0=0;d0<2;++d0){s16x4 lo[4],hi[4];
    #pragma unroll
    for(int ks=0;ks<4;++ks){
      asm volatile("ds_read_b64_tr_b16 %0,%1 offset:%c2":"=&v"(lo[ks]):"v"(vb),"i"(d0*4096+ks*1024):"memory");
      asm volatile("ds_read_b64_tr_b16 %0,%1 offset:%c2":"=&v"(hi[ks]):"v"(vb),"i"(d0*4096+ks*1024+512):"memory");}
    asm volatile("s_waitcnt lgkmcnt(0)":::"memory");SBAR();
    #define PK(k) (bf16x8){lo[k][0],lo[k][1],lo[k][2],lo[k][3],hi[k][0],hi[k][1],hi[k][2],hi[k][3]}
    o[d0]=__builtin_amdgcn_mfma_f32_32x32x16_bf16(pa0,PK(0),o[d0],0,0,0);
    o[d0]=__builtin_amdgcn_mfma_f32_32x32x16_bf16(pa1,PK(1),o[d0],0,0,0);
    o[d0]=__builtin_amdgcn_mfma_f32_32x32x16_bf16(pa2,PK(2),o[d0],0,0,0);
    o[d0]=__builtin_amdgcn_mfma_f32_32x32x16_bf16(pa3,PK(3),o[d0],0,0,0);
    #undef PK
  }
}

#ifndef ATTN_STORE16
#define ATTN_STORE16(p,v) (*(u32x4*)(p)=(v))
#endif
typedef unsigned long long v16i __attribute__((ext_vector_type(8)));
#define MLOAD_P0(t_) do{ const unsigned long long* mp_=mbase+(size_t)(t_)*32; \
  asm volatile("s_load_dwordx16 %0, %1, 0x0":"=s"(mwA):"s"(mp_)); asm volatile("s_load_dwordx16 %0, %1, 0x40":"=s"(mwB):"s"(mp_)); }while(0)
#define MLOAD_P1(t_) do{ const unsigned long long* mp_=mbase+(size_t)(t_)*32; \
  asm volatile("s_load_dwordx16 %0, %1, 0x80":"=s"(mwA):"s"(mp_)); asm volatile("s_load_dwordx16 %0, %1, 0xc0":"=s"(mwB):"s"(mp_)); }while(0)
#define MAP1(X,r,W) do{ float t_=X[r]; asm volatile("v_cndmask_b32_e64 %0, 0, %0, %1":"+v"(t_):"s"(W)); X[r]=t_; }while(0)
#define MAPPLY1(P) do{ _Pragma("unroll") for(int r_=0;r_<8;++r_){ MAP1(P,r_,mwA[r_]); MAP1(P,8+r_,mwB[r_]); } }while(0)
#define MWAIT() asm volatile("s_waitcnt lgkmcnt(0)":::"memory")
template<int THRL> __device__ __forceinline__ void attn_unit(int b,int h,int qb,const bf16*Q,const bf16*__restrict__ K,const bf16*__restrict__ V,bf16*O,const unsigned long long*M,char*shm,int wid_in){
  const int lane=fresh_lane(),r32=lane&31,hi=lane>>5; const int wid=wid_in;
  const long rowbase=(long)b*SEQ; const int q0=qb*QB;
  const bf16*Qw=Q+(rowbase+q0+wid*QBLK)*DM+h*D;
  const bf16*Kh=K+rowbase*DM+h*D,*Vh=V+rowbase*DM+h*D;
  const unsigned long long*mbase=M+((size_t)(b*256+qb*8+wid))*(128*32); v16i mwA,mwB;
  const unsigned lds0=(unsigned)(uintptr_t)shm;
  float*wsf=(float*)(shm+LDS_WS)+wid*64;
  const bf16*ksrc=Kh+(long)lane*DM+wid*8;
  const bf16*vsrc=Vh+(long)(16*(wid&3)+(lane>>2))*DM+(wid>>2)*32+(lane&3)*8;
  const unsigned kdst=lds0+LDS_K+wid*1024, vdst=lds0+LDS_V+wid*1024;
  #define DMA_K(t,slot) glds16(ksrc+(long)(t)*KVBLK*DM,(unsigned)__builtin_amdgcn_readfirstlane(kdst+(slot)))
  #define DMA_V(t,slot) glds16(vsrc+(long)(t)*KVBLK*DM,(unsigned)__builtin_amdgcn_readfirstlane(vdst+(slot)))
  const int vb0=(int)(lds0+LDS_V)+((lane>>4)&1)*32+(lane&3)*8+(4*hi+((lane&15)>>2))*64;
  const char*Kbase=shm+LDS_K; bf16x8 kf[8];
  const lds_cptr shm3=(lds_cptr)shm; const lds_cptr kp0=shm3+LDS_K+hi*1024+r32*16; const lds_cptr vp0=shm3+LDS_V+((lane>>4)&1)*32+(lane&3)*8+(4*hi+((lane&15)>>2))*64;
  const int NT=(q0+QB)/KVBLK;
  DMA_K(0,0);DMA_V(0,0);DMA_K(1,SLOTB);
  bf16x8 qr[4];
  #pragma unroll
  for(int d0=0;d0<4;++d0)qr[d0]=*reinterpret_cast<const bf16x8*>(&Qw[(long)r32*DM+d0*16+hi*8]);
  float l_reg=0.f;f32x16 o[2];o[0]=f32x16{};o[1]=f32x16{};
  const int qrel=wid*QBLK+r32;
  #define CMASK(P0,P1,t) do{int jb_=(t)-(NT-4); if(jb_>=0)cmask(P0,P1,jb_,qrel,hi);}while(0)
  bool resc=false;
  #define START(P0,P1) do{ resc=false; \
    _Pragma("unroll") for(int r=0;r<16;++r)P0[r]=__builtin_amdgcn_exp2f(P0[r]); }while(0)
  #define RESC() do{}while(0)
  f32x16 pA0,pA1,pB0,pB1;
  int sl_prev=0,sl_cur=0,sl_next=SLOTB;
  #define ROT() do{sl_prev=sl_cur;sl_cur=sl_next;sl_next=(sl_next==(NSLOT-1)*SLOTB)?0:sl_next+SLOTB;}while(0)
  MLOAD_P0(0);
  DMA_K(2,2*SLOTB);
  WAIT_BAR(3);
  qkt(pA0,pA1,Kbase,qr,f32x16{},r32,hi);asm volatile("s_nop 15\n\ts_nop 7":"+v"(pA0),"+v"(pA1));CMASK(pA0,pA1,0);
  START(pA0,pA1);
  _Pragma("unroll") for(int r=0;r<16;++r)pA1[r]=__builtin_amdgcn_exp2f(pA1[r]);
  WAIT_BAR(0);
  DMA_K(3,0);DMA_V(1,SLOTB);
  ROT();
  kload8(kf,kp0+sl_cur);
  WAIT_BAR(2);
  s16x4 vlo[8],vhi[8]; u32x4 pw0,pw1,pw2,pw3;
  #define PKW(P,B) cvtpk_s(P[B],P[B+1])
  #define PAF(k) __builtin_bit_cast(bf16x8,pw##k)
  #define VFR(i) (bf16x8){vlo[i][0],vlo[i][1],vlo[i][2],vlo[i][3],vhi[i][0],vhi[i][1],vhi[i][2],vhi[i][3]}
  #define PIN(x) asm volatile("":"+v"(x))
  #define MX3(a,b,c) __builtin_fmaxf(__builtin_fmaxf((a),(b)),(c))
  #define GAPA(MF,A0,A1,A2,A3,W0,W1,PW) do{ MF; sacc+=A0; sacc+=A1; sacc+=A2; sacc+=A3; PIN(sacc); W0; W1; PIN(PW); SBAR(); }while(0)
  #define EX(v) __builtin_amdgcn_exp2f(v)
  #define GAPB(MF,X,B) do{ MF; X[B]=EX(X[B]); X[B+1]=EX(X[B+1]); X[B+2]=EX(X[B+2]); X[B+3]=EX(X[B+3]); PIN(X); SBAR(); }while(0)
  #define VRD(i) do{ vlo[i]=vtr(vp_+(((i)>>2)*4096+((i)&3)*1024)); vhi[i]=vtr(vp_+(((i)>>2)*4096+((i)&3)*1024+512)); }while(0)
  #define KRD(G,j) do{ if(G){ kload2(kf,kp0+sl_next,j); SBAR(); } }while(0)
  #define STEP(C0,C1,P0,P1,t,GK,GV,GL) do{ SBAR(); MAPPLY1(P0); MLOAD_P1((t)-1); SBAR(); \
    const lds_cptr vp_=vp0+sl_prev; \
    VRD(0); SBAR(); float sacc=(P0[0]+P0[1]); \
    GAPA(C0=__builtin_amdgcn_mfma_f32_32x32x16_bf16(kf[0],qr[0],f32x16{},0,0,0), P0[2],P0[3],P0[4],P0[5],     pw0[0]=PKW(P0,0), pw0[1]=PKW(P0,2), pw0); \
    VRD(4); SBAR(); GAPA(C1=__builtin_amdgcn_mfma_f32_32x32x16_bf16(kf[1],qr[0],f32x16{},0,0,0), P0[6],P0[7],P0[8],P0[9],     pw0[2]=PKW(P0,4), pw0[3]=PKW(P0,6), pw0); \
    VRD(1); SBAR(); GAPA(C0=__builtin_amdgcn_mfma_f32_32x32x16_bf16(kf[2],qr[1],C0,0,0,0),   P0[10],P0[11],P0[12],P0[13], pw1[0]=PKW(P0,8), pw1[1]=PKW(P0,10), pw1); \
    MWAIT(); MAPPLY1(P1); MLOAD_P0(t); SBAR(); \
    VRD(5); SBAR(); GAPA(C1=__builtin_amdgcn_mfma_f32_32x32x16_bf16(kf[3],qr[1],C1,0,0,0),   P0[14],P0[15],P1[0],P1[1],   pw1[2]=PKW(P0,12),pw1[3]=PKW(P0,14), pw1); \
    VRD(2); SBAR(); GAPA(C0=__builtin_amdgcn_mfma_f32_32x32x16_bf16(kf[4],qr[2],C0,0,0,0),   P1[2],P1[3],P1[4],P1[5],     pw2[0]=PKW(P1,0), pw2[1]=PKW(P1,2), pw2); \
    VRD(6); SBAR(); GAPA(C1=__builtin_amdgcn_mfma_f32_32x32x16_bf16(kf[5],qr[2],C1,0,0,0),   P1[6],P1[7],P1[8],P1[9],     pw2[2]=PKW(P1,4), pw2[3]=PKW(P1,6), pw2); \
    VRD(3); SBAR(); GAPA(C0=__builtin_amdgcn_mfma_f32_32x32x16_bf16(kf[6],qr[3],C0,0,0,0),   P1[10],P1[11],P1[12],P1[13], pw3[0]=PKW(P1,8), pw3[1]=PKW(P1,10), pw3); \
    VRD(7); SBAR(); GAPA(C1=__builtin_amdgcn_mfma_f32_32x32x16_bf16(kf[7],qr[3],C1,0,0,0),   P1[14],P1[15],0.f,0.f,       pw3[2]=PKW(P1,12),pw3[3]=PKW(P1,14), pw3); \
    l_reg+=sacc; \
    if(GK){DMA_K((t)+3,sl_cur);} if(GV){DMA_V((t)+1,sl_next);} \
    CMASK(C0,C1,t); \
    SBAR(); \
    GAPB(o[0]=__builtin_amdgcn_mfma_f32_32x32x16_bf16(PAF(0),VFR(0),o[0],0,0,0), C0,0); \
    GAPB(o[1]=__builtin_amdgcn_mfma_f32_32x32x16_bf16(PAF(0),VFR(4),o[1],0,0,0), C0,4); \
    KRD(GL,0); GAPB(o[0]=__builtin_amdgcn_mfma_f32_32x32x16_bf16(PAF(1),VFR(1),o[0],0,0,0), C0,8); \
    KRD(GL,1); GAPB(o[1]=__builtin_amdgcn_mfma_f32_32x32x16_bf16(PAF(1),VFR(5),o[1],0,0,0), C0,12); \
    KRD(GL,2); GAPB(o[0]=__builtin_amdgcn_mfma_f32_32x32x16_bf16(PAF(2),VFR(2),o[0],0,0,0), C1,0); \
    KRD(GL,3); GAPB(o[1]=__builtin_amdgcn_mfma_f32_32x32x16_bf16(PAF(2),VFR(6),o[1],0,0,0), C1,4); \
    GAPB(o[0]=__builtin_amdgcn_mfma_f32_32x32x16_bf16(PAF(3),VFR(3),o[0],0,0,0), C1,8); \
    GAPB(o[1]=__builtin_amdgcn_mfma_f32_32x32x16_bf16(PAF(3),VFR(7),o[1],0,0,0), C1,12); \
    }while(0)
  int t=1;
  #undef CMASK
  #define CMASK(P0,P1,t) do{}while(0)
  for(;t+5<NT;t+=2){
    STEP(pB0,pB1,pA0,pA1,t,true,true,true);     WAIT_BAR(2); RESC(); ROT();
    STEP(pA0,pA1,pB0,pB1,t+1,true,true,true);   WAIT_BAR(2); RESC(); ROT();
  }
  #undef CMASK
  #define CMASK(P0,P1,t) do{int jb_=(t)-(NT-4); if(jb_>=0)cmask(P0,P1,jb_,qrel,hi);}while(0)
  #define ENDW(tt) do{ if((tt)+3<NT){WAIT_BAR(2);} else if((tt)+2<NT){WAIT_BAR(1);} else {WAIT_BAR(0);} }while(0)
  for(;t+1<NT;t+=2){
    STEP(pB0,pB1,pA0,pA1,t,(t+3<NT),(t+1<NT),(t+1<NT));       ENDW(t);   RESC(); ROT();
    STEP(pA0,pA1,pB0,pB1,t+1,(t+4<NT),(t+2<NT),(t+2<NT));     ENDW(t+1); RESC(); ROT();
  }
  STEP(pB0,pB1,pA0,pA1,NT-1,false,false,false); RESC();
  MWAIT(); MAPPLY1(pB0); MLOAD_P1(NT-1); MWAIT(); MAPPLY1(pB1);
  { float sacc=pB0[0]+pB0[1]; _Pragma("unroll") for(int r=2;r<16;++r)sacc+=pB0[r]; _Pragma("unroll") for(int r=0;r<16;++r)sacc+=pB1[r]; l_reg+=sacc;
    pw0=(u32x4){PKW(pB0,0),PKW(pB0,2),PKW(pB0,4),PKW(pB0,6)};pw1=(u32x4){PKW(pB0,8),PKW(pB0,10),PKW(pB0,12),PKW(pB0,14)};pw2=(u32x4){PKW(pB1,0),PKW(pB1,2),PKW(pB1,4),PKW(pB1,6)};pw3=(u32x4){PKW(pB1,8),PKW(pB1,10),PKW(pB1,12),PKW(pB1,14)};
    SBAR(); pv(o,vb0+sl_cur,PAF(0),PAF(1),PAF(2),PAF(3)); }
  #undef PKW
  #undef PAF
  #undef VFR
  #undef PIN
  #undef MX3
  #undef GAPA
  #undef GAPB
  #undef EX
  #undef VRD
  #undef KRD
  #undef STEP
  #undef ENDW
  { const int lane=fresh_lane(),r32=lane&31,hi=lane>>5; float*wsf=(float*)(shm+LDS_WS)+wid*64;
  {auto rr=__builtin_amdgcn_permlane32_swap(__float_as_uint(l_reg),__float_as_uint(l_reg),false,false);l_reg=__uint_as_float(rr[0])+__uint_as_float(rr[1]);}
  if(hi==0)wsf[32+r32]=l_reg;asm volatile("s_waitcnt lgkmcnt(0)":::"memory");
  float rli[16];
  #pragma unroll
  for(int r=0;r<16;++r)rli[r]=__builtin_amdgcn_rcpf(wsf[32+crow(r,hi)]);
  bf16*Ow=O+(rowbase+q0+wid*QBLK)*OPITCH+h*D;
  { bf16*stg=(bf16*)(shm+LDS_OST)+wid*2048;
    #pragma unroll
    for(int r=0;r<16;++r){const int orow=crow(r,hi);
      #pragma unroll
      for(int d0=0;d0<2;++d0)stg[orow*64+d0*32+r32]=__float2bfloat16(o[d0][r]*rli[r]);}
    asm volatile("s_waitcnt lgkmcnt(0)":::"memory");
    #pragma unroll
    for(int i=0;i<4;++i){const int row=i*8+(lane>>3),ch=lane&7; const u32x4 v=*(const u32x4*)(stg+row*64+ch*8); ATTN_STORE16(Ow+(long)row*OPITCH+ch*8,v);} }
  }
  asm volatile("s_waitcnt lgkmcnt(0)\n\ts_barrier":::"memory");
  #undef DMA_K
  #undef DMA_V
  #undef CMASK
  #undef START
  #undef RESC
  #undef ROT
}
constexpr int ATTN_LDS_BYTES=LDS_BYTES;
struct AttnTensors { const bf16* Q; const bf16* K; const bf16* V; bf16* O; const unsigned long long* M; int wave; };
struct AttnUnit { int bh; int qb; };
struct StaticOrder {
  int vcu;
  __device__ __forceinline__ explicit StaticOrder(int grid,int block):vcu((block%8)*(grid/8)+block/8){}
  __device__ __forceinline__ bool next(int i,AttnUnit&u)const{ if(i>=2)return false; const int s=vcu&15; u.bh=vcu>>4; u.qb=(i==0)?s:31-s; return true; }
  __device__ __forceinline__ void a_ready(const AttnUnit&)const{}
  __device__ __forceinline__ void done(const AttnUnit&)const{}
};
template<class Sched,int THRL=8> __device__ __forceinline__ void attn_phase(char*lds,const AttnTensors&T,const Sched&S){
  AttnUnit u;
  for(int i=0;S.next(i,u);++i){ S.a_ready(u); attn_unit<THRL>(u.bh/NHEAD,u.bh%NHEAD,u.qb,T.Q,T.K,T.V,T.O,T.M,lds,T.wave); S.done(u); }
}
#undef SBAR
#undef WAIT_BAR
#undef MLOAD_P0
#undef MLOAD_P1
#undef MAP1
#undef MAPPLY1
#undef MWAIT
}
namespace pg8 {
#define PG8_LAS __attribute__((address_space(3)))
typedef unsigned short bf16_t;
typedef short bf16x8 __attribute__((ext_vector_type(8)));
typedef float f32x4 __attribute__((ext_vector_type(4)));
typedef unsigned u32x4 __attribute__((ext_vector_type(4)));
constexpr int BM = 256, BK = 64, HALF = 128, HTB = HALF * BK * 2  , STAGE_BYTES = 8 * HTB, NXCD = 8, WGM = 8;

__host__ __device__ __forceinline__ int lds_byte(int r, int c) { const int st = (r >> 4) * 2 + (c >> 5), rr = r & 15, cc = c & 31, ob = rr * 64 + cc * 2; return st * 1024 + (ob ^ (((ob >> 9) & 1) << 5)); }
__host__ __device__ __forceinline__ void stage_rc(int b, int& R, int& C) { const int st = b / 1024, sb = b % 1024, swz = sb ^ (((sb >> 9) & 1) << 5); R = (st >> 1) * 16 + swz / 64; C = (st & 1) * 32 + (swz % 64) / 2; }
__host__ __device__ __forceinline__ int perm32(int rho) { const int n = rho >> 4, i = rho & 15; return 8 * (i >> 2) + 4 * n + (i & 3); }

struct Unit { int pm, pn; };
struct Gemm { const bf16_t* A; const bf16_t* Bt; int M, N, K, wave; };

struct StaticOrder {
    int nM, nN, nwg, G, c;
    __host__ __device__ void init(int M, int N, int G_, int c_) { nM = M / BM; nN = N / BM; nwg = nM * nN; G = G_; c = c_; }
    __host__ __device__ bool next(int i, Unit& u) const {
        const long L = (long)i * G + c; if (L >= nwg) return false;
        int wgid = (int)L; { const int q = nwg / NXCD, r = nwg % NXCD, xcd = wgid % NXCD, off = wgid / NXCD; wgid = (xcd < r ? xcd * (q + 1) : r * (q + 1) + (xcd - r) * q) + off; }
        const int nig = WGM * nN, gid = wgid / nig, fm = gid * WGM, gsz = (nM - fm) < WGM ? (nM - fm) : WGM;
        u.pm = fm + ((wgid % nig) % gsz); u.pn = (wgid % nig) / gsz; return true;
    }
    __device__ __forceinline__ void a_ready(const Unit&) const {}
    __device__ __forceinline__ void done(const Unit&) const {}
};

__device__ __forceinline__ unsigned cvt_pk_bf16(float lo, float hi) { unsigned r; asm volatile("v_cvt_pk_bf16_f32 %0, %1, %2" : "=v"(r) : "v"(lo), "v"(hi)); return r; }
typedef float f32x2 __attribute__((ext_vector_type(2)));
template <class Epi, class Sched, bool ALIGN_EPI = false, bool SP2 = false>
__device__ __forceinline__ void gemm_phase(PG8_LAS unsigned char* lds, const Gemm g, const Sched& S, const Epi& E) {
    const int wid = g.wave, lane = fresh_lane(), tid = wid * 64 + lane, wr = wid >> 2, wc = wid & 3, fr = lane & 15, fq = lane >> 4;
    const int K = g.K, nt = K / BK;
    unsigned voffA[2], voffB[2];
#pragma unroll
    for (int i = 0; i < 2; ++i) { int R, C; stage_rc(tid * 16 + i * 8192, R, C); const int Rb = Epi::PERM ? ((R & ~31) + perm32(R & 31)) : R;
        voffA[i] = (unsigned)(R * K + C) * 2u; voffB[i] = (unsigned)(Rb * K + C) * 2u; }
    const size_t kstep = (size_t)(BK * 2);
    const size_t hstep = (size_t)HALF * K * 2;
    const size_t tstep = 2 * hstep;
    const unsigned ldsw = (unsigned)wid * 1024u;
    const int aoff = lds_byte(wr * 64 + fr, fq * 8), boff = lds_byte(wc * 32 + fr, fq * 8);
#define PG8_SA(b, h) (((b) * 2 + (h)) * HTB)
#define PG8_SB(b, h) ((4 + (b) * 2 + (h)) * HTB)
#define PG8_STAGE(bufoff, gbase, voff) do { _Pragma("unroll") for (int _i = 0; _i < 2; ++_i) \
        __builtin_amdgcn_global_load_lds((const unsigned*)((const char*)(gbase) + (voff)[_i]), (PG8_LAS unsigned*)(lds + (bufoff) + ldsw + _i * 8192), 16, 0, 0); } while (0)
#define PG8_LDA(dst, b, h) do { _Pragma("unroll") for (int m = 0; m < 4; ++m) _Pragma("unroll") for (int k = 0; k < 2; ++k) dst[m][k] = *(const PG8_LAS bf16x8*)(lds + PG8_SA(b, h) + aoff + m * 2048 + k * 1024); } while (0)
#define PG8_LDB(dst, b, h) do { _Pragma("unroll") for (int n = 0; n < 2; ++n) _Pragma("unroll") for (int k = 0; k < 2; ++k) dst[n][k] = *(const PG8_LAS bf16x8*)(lds + PG8_SB(b, h) + boff + n * 2048 + k * 1024); } while (0)
#define PG8_MMA(ai, bj, At, Bt) do { __builtin_amdgcn_s_setprio(1); _Pragma("unroll") for (int m = 0; m < 4; ++m) _Pragma("unroll") for (int n = 0; n < 2; ++n) _Pragma("unroll") for (int k = 0; k < 2; ++k) \
        acc[ai][bj][m][n] = __builtin_amdgcn_mfma_f32_16x16x32_bf16(Bt[n][k], At[m][k], acc[ai][bj][m][n], 0, 0, 0); __builtin_amdgcn_s_setprio(0); } while (0)
#define PG8_WAIT_V(n) asm volatile("s_waitcnt vmcnt(" #n ")" ::: "memory")
#define PG8_WAIT_L(n) asm volatile("s_waitcnt lgkmcnt(" #n ")" ::: "memory")
#define PG8_BAR __builtin_amdgcn_s_barrier()
#define PG8_SCHED __builtin_amdgcn_sched_barrier(0)
    Unit cur, nxt; int ui = 0;
    if (!S.next(0, cur)) return;
    f32x4 acc[2][2][4][2];
#pragma unroll
    for (int a = 0; a < 2; ++a)
#pragma unroll
        for (int b = 0; b < 2; ++b)
#pragma unroll
            for (int m = 0; m < 4; ++m)
#pragma unroll
                for (int n = 0; n < 2; ++n) acc[a][b][m][n] = (f32x4){0.f, 0.f, 0.f, 0.f};
    bf16x8 At[4][2], B0[2][2], B1[2][2];
    const char* cA = (const char*)g.A + (size_t)cur.pm * tstep; const char* cB = (const char*)g.Bt + (size_t)cur.pn * tstep;
    S.a_ready(cur);
    if constexpr (SP2) {
        PG8_STAGE(PG8_SB(0, 0), cB, voffB); PG8_STAGE(PG8_SB(0, 1), cB + hstep, voffB); PG8_STAGE(PG8_SA(0, 0), cA, voffA); PG8_STAGE(PG8_SA(0, 1), cA + hstep, voffA);
        if (wr == 1) PG8_BAR;
        PG8_WAIT_V(2); PG8_BAR;
        PG8_STAGE(PG8_SB(1, 0), cB + kstep, voffB); PG8_STAGE(PG8_SA(1, 0), cA + kstep, voffA); PG8_STAGE(PG8_SB(1, 1), cB + hstep + kstep, voffB);
        PG8_WAIT_V(6); PG8_BAR;
    } else {
        PG8_STAGE(PG8_SB(0, 0), cB, voffB); PG8_STAGE(PG8_SA(0, 0), cA, voffA); PG8_STAGE(PG8_SB(0, 1), cB + hstep, voffB); PG8_STAGE(PG8_SA(0, 1), cA + hstep, voffA);
        if (wr == 1) PG8_BAR;
        PG8_WAIT_V(4); PG8_BAR;
        PG8_STAGE(PG8_SB(1, 0), cB + kstep, voffB); PG8_STAGE(PG8_SA(1, 0), cA + kstep, voffA); PG8_STAGE(PG8_SB(1, 1), cB + hstep + kstep, voffB);
        PG8_WAIT_V(6); PG8_BAR;
    }
    for (;;) {
        const bool has_next = S.next(ui + 1, nxt);
        const char* nA = has_next ? (const char*)g.A + (size_t)nxt.pm * tstep : cA; const char* nB = has_next ? (const char*)g.Bt + (size_t)nxt.pn * tstep : cB;
        for (int t = 0; t < nt; t += 2) {
            const bool last = (t == nt - 2);
            const char* a1 = cA + (size_t)(t + 1) * kstep;
            const char* a2 = last ? nA : cA + (size_t)(t + 2) * kstep; const char* b2 = last ? nB : cB + (size_t)(t + 2) * kstep;
            const char* a3 = a2 + kstep; const char* b3 = b2 + kstep;
            if (last && has_next) S.a_ready(nxt);
            if constexpr (SP2) {
            PG8_LDB(B0, 0, 0); PG8_LDB(B1, 0, 1); PG8_SCHED; PG8_LDA(At, 0, 0); PG8_STAGE(PG8_SA(1, 1), a1 + hstep, voffA);
            PG8_WAIT_V(8); PG8_WAIT_L(0); PG8_BAR; PG8_MMA(0, 0, At, B0); PG8_MMA(0, 1, At, B1); PG8_BAR; PG8_SCHED;
            PG8_LDA(At, 0, 1); PG8_STAGE(PG8_SB(0, 0), b2, voffB); PG8_STAGE(PG8_SB(0, 1), b2 + hstep, voffB); PG8_STAGE(PG8_SA(0, 0), a2, voffA);
            PG8_WAIT_V(8); PG8_WAIT_L(0); PG8_BAR; PG8_MMA(1, 0, At, B0); PG8_MMA(1, 1, At, B1); PG8_BAR; PG8_SCHED;
            PG8_LDB(B0, 1, 0); PG8_LDB(B1, 1, 1); PG8_SCHED; PG8_LDA(At, 1, 0); PG8_STAGE(PG8_SA(0, 1), a2 + hstep, voffA);
            PG8_WAIT_V(8); PG8_WAIT_L(0); PG8_BAR; PG8_MMA(0, 0, At, B0); PG8_MMA(0, 1, At, B1); PG8_BAR; PG8_SCHED;
            PG8_LDA(At, 1, 1); PG8_STAGE(PG8_SB(1, 0), b3, voffB); PG8_STAGE(PG8_SB(1, 1), b3 + hstep, voffB); PG8_STAGE(PG8_SA(1, 0), a3, voffA);
            PG8_WAIT_V(8); PG8_WAIT_L(0); PG8_BAR; PG8_MMA(1, 0, At, B0); PG8_MMA(1, 1, At, B1); PG8_BAR; PG8_SCHED;
            } else {
            PG8_LDB(B0, 0, 0); PG8_SCHED; PG8_LDA(At, 0, 0); PG8_STAGE(PG8_SA(1, 1), a1 + hstep, voffA);
            PG8_WAIT_L(8); PG8_BAR; PG8_WAIT_L(0); PG8_MMA(0, 0, At, B0); PG8_BAR; PG8_SCHED;
            PG8_LDB(B1, 0, 1); PG8_STAGE(PG8_SB(0, 0), b2, voffB);
            PG8_BAR; PG8_WAIT_L(0); PG8_MMA(0, 1, At, B1); PG8_BAR;
            PG8_LDA(At, 0, 1); PG8_STAGE(PG8_SA(0, 0), a2, voffA);
            PG8_BAR; PG8_WAIT_L(0); PG8_MMA(1, 0, At, B0); PG8_BAR; PG8_SCHED;
            PG8_STAGE(PG8_SB(0, 1), b2 + hstep, voffB);
            PG8_WAIT_V(6); PG8_BAR; PG8_MMA(1, 1, At, B1); PG8_BAR;
            PG8_LDB(B0, 1, 0); PG8_SCHED; PG8_LDA(At, 1, 0); PG8_STAGE(PG8_SA(0, 1), a2 + hstep, voffA);
            PG8_WAIT_L(8); PG8_BAR; PG8_WAIT_L(0); PG8_MMA(0, 0, At, B0); PG8_BAR; PG8_SCHED;
            PG8_LDB(B1, 1, 1); PG8_STAGE(PG8_SB(1, 0), b3, voffB);
            PG8_BAR; PG8_WAIT_L(0); PG8_MMA(0, 1, At, B1); PG8_BAR;
            PG8_LDA(At, 1, 1); PG8_STAGE(PG8_SA(1, 0), a3, voffA);
            PG8_BAR; PG8_WAIT_L(0); PG8_MMA(1, 0, At, B0); PG8_BAR; PG8_SCHED;
            PG8_STAGE(PG8_SB(1, 1), b3 + hstep, voffB);
            PG8_WAIT_V(6); PG8_BAR; PG8_MMA(1, 1, At, B1); PG8_BAR;
            }
        }
        if constexpr (ALIGN_EPI) { if (wr == 0) PG8_BAR; }
        if constexpr (!Epi::AFTER_DRAIN) { E(acc, cur, wr, wc, fr, fq); S.done(cur); }
        if (!has_next) break;
#pragma unroll
        for (int a = 0; a < 2; ++a)
#pragma unroll
            for (int b = 0; b < 2; ++b)
#pragma unroll
                for (int m = 0; m < 4; ++m)
#pragma unroll
                    for (int n = 0; n < 2; ++n) acc[a][b][m][n] = (f32x4){0.f, 0.f, 0.f, 0.f};
        cur = nxt; cA = nA; cB = nB; ++ui;
        if constexpr (ALIGN_EPI) { if (wr == 1) PG8_BAR; }
    }
    PG8_WAIT_V(0);
    if constexpr (!ALIGN_EPI) { if (wr == 0) PG8_BAR; }
    PG8_BAR;
    if constexpr (Epi::AFTER_DRAIN) { E.fused(acc, cur, wr, wc, fr, fq, lds, wid, lane); S.done(cur); }
#undef PG8_SA
#undef PG8_SB
#undef PG8_STAGE
#undef PG8_LDA
#undef PG8_LDB
#undef PG8_MMA
#undef PG8_WAIT_V
#undef PG8_WAIT_L
#undef PG8_BAR
#undef PG8_SCHED
}
}
#define GAS __attribute__((address_space(1)))
#define LAS __attribute__((address_space(3)))
#define RLX_AGENT __ATOMIC_RELAXED, __HIP_MEMORY_SCOPE_AGENT
#define XB_TMO      128
#define XB_XCNT(j)  (256  + 64 * (j))
#define XB_XSUB(j)  (1280 + 64 * (j))
#define XB_XGEN(j)  (2304 + 64 * (j))
#define XB_TOP      3328
#define XB_TOPGEN   3392
#define XCD_BAR_WORDS 3456
#define XB_SPIN_CAP (1u << 21)

__device__ __forceinline__ unsigned xb_ld(unsigned* p)              { return __hip_atomic_load(p, __ATOMIC_RELAXED, __HIP_MEMORY_SCOPE_AGENT); }
__device__ __forceinline__ unsigned xb_add(unsigned* p, unsigned v) { return __hip_atomic_fetch_add(p, v, __ATOMIC_RELAXED, __HIP_MEMORY_SCOPE_AGENT); }
__device__ __forceinline__ unsigned xb_xcc_id() { return (unsigned)__builtin_amdgcn_s_getreg((3 << 11) | 20) & 0xFu; }
#define XB_SPIN(cond, bar) do { unsigned _sp = 0; while (cond) { __builtin_amdgcn_s_sleep(1); \
    if ((++_sp & 255u) == 0u) { if (xb_ld(&(bar)[XB_TMO])) break; if (_sp > XB_SPIN_CAP) { atomicAdd(&(bar)[XB_TMO], 1u); break; } } } } while (0)

struct XcdBarrier {
    unsigned* bar; unsigned x; int wv;
    volatile LAS unsigned* st;
};

__device__ __forceinline__ XcdBarrier xcd_barrier_post(unsigned* bar, volatile LAS unsigned* st) {
    XcdBarrier b; b.bar = bar; b.x = xb_xcc_id(); b.st = st;
    if (threadIdx.x == 0) (void)xb_add(&bar[XB_XCNT(b.x)], 1u);
    return b;
}
__device__ __forceinline__ void xcd_barrier_complete(unsigned* bar, unsigned x, unsigned& nloc, unsigned& nx) {
    const unsigned G = gridDim.x * gridDim.y * gridDim.z;
    unsigned sum, cnt, mine, sp = 0u;
    for (;;) {
        sum = 0u; cnt = 0u; mine = 0u;
#pragma unroll
        for (unsigned j = 0; j < 16; ++j) { const unsigned c = xb_ld(&bar[XB_XCNT(j)]); sum += c; cnt += (c > 0u) ? 1u : 0u; mine = (j == x) ? c : mine; }
        if (sum == G) break;
        __builtin_amdgcn_s_sleep(1);
        if ((++sp & 255u) == 0u) { if (xb_ld(&bar[XB_TMO])) break; if (sp > XB_SPIN_CAP) { atomicAdd(&bar[XB_TMO], 1u); break; } }
    }
    nloc = mine > 0u ? mine : 1u; nx = cnt > 0u ? cnt : 1u;
}

__device__ __forceinline__ void xcd_barrier(const XcdBarrier& b) {
    asm volatile("s_waitcnt vmcnt(0)" ::: "memory");
    __syncthreads();
    if (b.wv == 0 && fresh_lane() == 0) {
        unsigned* bar = b.bar;
        __builtin_amdgcn_s_waitcnt(0);
        unsigned nloc = b.st[0], nx = b.st[1];
        if (nloc == 0u) { xcd_barrier_complete(bar, b.x, nloc, nx); b.st[0] = nloc; b.st[1] = nx; }
        const unsigned old = xb_add(&bar[XB_XSUB(b.x)], 1u);
        const unsigned gen = old / nloc;
        if (old + 1u == (gen + 1u) * nloc) {
            __builtin_amdgcn_fence(__ATOMIC_RELEASE, "agent");
            asm volatile("s_waitcnt vmcnt(0)" ::: "memory");
            const unsigned og = xb_add(&bar[XB_TOP], 1u);
            const unsigned tg = og / nx;
            if (og + 1u == (tg + 1u) * nx) xb_add(&bar[XB_TOPGEN], 1u);
            else XB_SPIN(xb_ld(&bar[XB_TOPGEN]) == tg, bar);
            __builtin_amdgcn_fence(__ATOMIC_ACQUIRE, "agent");
            xb_add(&bar[XB_XGEN(b.x)], 1u);
            asm volatile("s_waitcnt vmcnt(0)" ::: "memory");
        } else {
            XB_SPIN(xb_ld(&bar[XB_XGEN(b.x)]) == gen, bar);
            __builtin_amdgcn_fence(__ATOMIC_ACQUIRE, "agent");
            asm volatile("s_waitcnt vmcnt(0)" ::: "memory");
        }
    }
    __syncthreads();
}
#ifndef PROBE_DUP
#define PROBE_DUP -1
#endif
using pg8::bf16_t; using pg8::f32x4; using pg8::u32x4; using pg8::Unit; using pg8::cvt_pk_bf16;
typedef unsigned long long u64;
constexpr int DM = 1024, SEQ = 8192, NB = 2, MP = NB * SEQ, DB = 128, DS = 8, MS = DB * DS, MT = MP + MS;
constexpr int PAST = 2048, PAGE = 128, NPAGES = 16;
constexpr int DCONV = 512, NH = 8, HD = 64, TOPK = 256;
constexpr int NMEM = 256, MH = 4, MHD = 256, DFF = 2816;
constexpr int DIN = 3656, DINP = 3840;
constexpr float EPS = 1e-6f;
constexpr int SPITCH = 2112;
constexpr int NWAVES = 8, NTHREADS = 512;
constexpr int NPHASE = 12;
constexpr int N_LAUNCHES = MK_N_LAUNCHES;

constexpr size_t OFF_Y_P = 0, OFF_Y_S = 16777216, OFF_K_P = 17825792, OFF_V_P = 26214400, OFF_IK_P = 34603008, OFF_CM_P = 35651584, OFF_CF_P = 35653632,
                 OFF_MK_P = 35664896, OFF_MV_P = 36189184, OFF_K_S = 36713472, OFF_V_S = 37237760, OFF_IK_S = 37762048, OFF_CM_S = 37827584, OFF_CF_S = 37958656, OUT_TOTAL = 38679552;

constexpr size_t MiB = 1u << 20;
constexpr size_t WS_CTL = 0, CTL_ZERO_BYTES = 1 * MiB;
constexpr size_t ACC_SS1 = 65536, ACC_SS2 = 139264, ACC_SSQ = 212992, ACC_SSK = 491520;
constexpr size_t WS_WIN = 1 * MiB, WS_WOUT = 9 * MiB, WS_WQ = 11 * MiB, WS_WKV = 13 * MiB, WS_WO = 17 * MiB, WS_WGU = 19 * MiB, WS_WDOWN = 30 * MiB;
constexpr size_t WS_COS = 36 * MiB, WS_SIN = 37 * MiB, WS_RSTD = 38 * MiB, WS_IW = 39 * MiB;
constexpr size_t WS_XB = 40 * MiB, WS_MEMB = 74 * MiB, WS_QIF = 75 * MiB  , WS_CB = 78 * MiB, WS_U = 95 * MiB;
constexpr size_t WS_Q = 112 * MiB, WS_K = 129 * MiB, WS_V = 146 * MiB, WS_QI = 163 * MiB, WS_KI = 180 * MiB, WS_AMIX = 183 * MiB;
constexpr size_t WS_H1 = 217 * MiB, WS_H1B = 285 * MiB, WS_QMEM = 319 * MiB, WS_OMEM = 353 * MiB, WS_H2 = 387 * MiB, WS_H2B = 455 * MiB;
constexpr size_t WS_SIDEG = 489 * MiB, WS_SIDEU = 491 * MiB, WS_LASTG = 493 * MiB, WS_G = 496 * MiB, WS_UP = 676 * MiB, WS_AFF = 770 * MiB, WS_SC = 864 * MiB, WS_SCS = 1376 * MiB, WS_SEL = 1385 * MiB, WS_CNT = 1403 * MiB, WS_MASK = 1404 * MiB, WS_MKF = 1420 * MiB, WS_MVF = 1421 * MiB, WS_END = 1422 * MiB;

constexpr int CW_BAR = 4096;
constexpr int CQ_PH2 = 1024, CQ_PH7 = 1536;
constexpr int RING_BYTES = 131072, MISC_OFF = RING_BYTES + 320, HALO_OFF = RING_BYTES + 1024, LDS_BYTES = 147456;

#define GAS __attribute__((address_space(1)))
#define LAS __attribute__((address_space(3)))
#define LDS_WAIT() asm volatile("s_waitcnt lgkmcnt(0)" ::: "memory")
typedef short bf16x8 __attribute__((ext_vector_type(8)));
typedef float f32x16 __attribute__((ext_vector_type(16)));

__device__ __forceinline__ float bf2f(unsigned b) { return __uint_as_float(b << 16); }
__device__ __forceinline__ float wave_sum(float v) {
#pragma unroll
    for (int o = 1; o < 64; o <<= 1) v += __shfl_xor(v, o);
    return v;
}
__device__ __forceinline__ float wave_max(float v) {
#pragma unroll
    for (int o = 1; o < 64; o <<= 1) v = fmaxf(v, __shfl_xor(v, o));
    return v;
}
__device__ __forceinline__ void store8_bf16(bf16_t* p, const float* v) {
    u32x4 w; w.x = cvt_pk_bf16(v[0], v[1]); w.y = cvt_pk_bf16(v[2], v[3]); w.z = cvt_pk_bf16(v[4], v[5]); w.w = cvt_pk_bf16(v[6], v[7]);
    *(u32x4*)p = w;
}
__device__ __forceinline__ void store8_f32(float* p, const float* v) {
    *(f32x4*)p = (f32x4){v[0], v[1], v[2], v[3]}; *(f32x4*)(p + 4) = (f32x4){v[4], v[5], v[6], v[7]};
}
__device__ __forceinline__ void load8_f32(const float* p, float* v) {
    const f32x4 a = *(const f32x4*)p, b = *(const f32x4*)(p + 4);
    v[0] = a.x; v[1] = a.y; v[2] = a.z; v[3] = a.w; v[4] = b.x; v[5] = b.y; v[6] = b.z; v[7] = b.w;
}
__device__ __forceinline__ void load8_bf16(const bf16_t* p, float* v) {
    const u32x4 w = *(const u32x4*)p;
    v[0] = bf2f(w.x & 0xffffu); v[1] = bf2f(w.x >> 16); v[2] = bf2f(w.y & 0xffffu); v[3] = bf2f(w.y >> 16);
    v[4] = bf2f(w.z & 0xffffu); v[5] = bf2f(w.z >> 16); v[6] = bf2f(w.w & 0xffffu); v[7] = bf2f(w.w >> 16);
}

struct Args { const void* in[29]; float* out; unsigned char* ws; int ph_lo, ph_hi; };
struct Ctx {
    const float *x_p, *x_s, *cache_k, *cache_v, *cache_ik, *st_mix, *st_ffn, *cmem_k, *cmem_v; const int* page_table; const float* mem_p;
    const float *g_mix, *w_in, *conv_mix_w, *q_g, *k_g, *w_out, *g_mem, *g_mem_src, *w_q, *w_kv, *mq_g, *mk_g, *w_o, *g_ffn, *w_gu, *conv_ffn_w, *conv_ffn_b, *w_down;
    float* out; unsigned char* ws;
    int tid, lane, wave, G, bid;
};

#define EPI_ROWS(ai, m) (u.pm * 256 + (ai) * 128 + wr * 64 + (m) * 16 + fr)
#define EPI_GET(dst, ai, bj, m, s) do { _Pragma("unroll") for (int e_ = 0; e_ < 4; ++e_) { (dst)[e_] = acc[ai][bj][m][0][e_] * (s); (dst)[4 + e_] = acc[ai][bj][m][1][e_] * (s); } } while (0)

struct EpiIn {
    static constexpr bool PERM = true, AFTER_DRAIN = false;
    const float* rstd; const float* cosT; const float* sinT; const float* qg; const float* kg;
    bf16_t *cbb, *ub, *qb, *kb, *vb, *qib, *kib; float* iwf; float* qif; float* out;
    __device__ __forceinline__ void operator()(const f32x4 (&acc)[2][2][4][2], const Unit& u, int wr, int wc, int fr, int fq) const {
        const int pn = u.pn; const int c8 = wc * 32 + 8 * fq; const bool samp = (u.pm >= 64);
#pragma unroll
        for (int ai = 0; ai < 2; ++ai) {
            float rsa[4];
#pragma unroll
            for (int m = 0; m < 4; ++m) rsa[m] = rstd[EPI_ROWS(ai, m)];
#pragma unroll
            for (int m = 0; m < 4; ++m) {
                const int r = EPI_ROWS(ai, m); const float rs = rsa[m];
                float lo[8], hi[8]; EPI_GET(lo, ai, 0, m, rs); EPI_GET(hi, ai, 1, m, rs);
                const int rl = samp ? r - MP : r; const int pos = samp ? PAST + (rl & 7) : (rl & (SEQ - 1));
                if (pn < 2) {
                    store8_bf16(cbb + (size_t)r * 512 + pn * 256 + c8, lo); store8_bf16(cbb + (size_t)r * 512 + pn * 256 + 128 + c8, hi);
                } else if (pn < 6) {
                    const int ch = 128 * (pn - 2) + c8; float uu[8];
#pragma unroll
                    for (int e = 0; e < 8; ++e) uu[e] = lo[e] * hi[e];
                    store8_bf16(ub + (size_t)r * 512 + ch, uu);
                    if (!samp) { const int t = rl & (SEQ - 1); if (t >= SEQ - 2) store8_f32(out + OFF_CM_P + (size_t)((rl >> 13) * 2 + (t - (SEQ - 2))) * 512 + ch, uu); }
                    else { const int tt = rl & 7; if (tt >= 6) store8_f32(out + OFF_CM_S + (size_t)((rl >> 3) * 2 + (tt - 6)) * 512 + ch, uu); }
                } else if (pn < 10 || pn == 12 || pn == 13) {
                    const int head = 4 * (pn & 1) + wc; const int d0 = 8 * fq;
                    if (pn < 10) {
                        float ss = 0.f;
#pragma unroll
                        for (int e = 0; e < 8; ++e) ss += lo[e] * lo[e] + hi[e] * hi[e];
                        ss += __shfl_xor(ss, 16); ss += __shfl_xor(ss, 32);
                        const float rn = 1.0f / sqrtf(ss * (1.f / 64.f) + EPS);
                        const float* g = (pn < 8) ? qg : kg; float gl[8], gh[8]; load8_f32(g + d0, gl); load8_f32(g + 32 + d0, gh);
#pragma unroll
                        for (int e = 0; e < 8; ++e) { lo[e] *= rn * gl[e]; hi[e] *= rn * gh[e]; }
                    }
                    float cs[8], sn[8]; load8_f32(cosT + (size_t)pos * 32 + d0, cs); load8_f32(sinT + (size_t)pos * 32 + d0, sn);
                    float ol[8], oh[8];
#pragma unroll
                    for (int e = 0; e < 8; ++e) { ol[e] = lo[e] * cs[e] - hi[e] * sn[e]; oh[e] = hi[e] * cs[e] + lo[e] * sn[e]; }
                    const size_t o512 = (size_t)r * 512 + head * 64 + d0;
                    if (pn < 8) {
#pragma unroll
                        for (int e = 0; e < 8; ++e) { ol[e] *= 0.18033688011112042f; oh[e] *= 0.18033688011112042f; }
                        store8_bf16(qb + o512, ol); store8_bf16(qb + o512 + 32, oh);
                    } else if (pn < 10) {
                        store8_bf16(kb + o512, ol); store8_bf16(kb + o512 + 32, oh);
                        float* ko = out + (samp ? OFF_K_S : OFF_K_P) + (size_t)rl * 512 + head * 64 + d0; store8_f32(ko, ol); store8_f32(ko + 32, oh);
                    } else {
                        store8_bf16(qib + o512, ol); store8_bf16(qib + o512 + 32, oh);
                    }
                } else if (pn < 12) {
                    const int c = 256 * (pn - 10) + c8;
                    store8_bf16(vb + (size_t)r * 512 + c, lo); store8_bf16(vb + (size_t)r * 512 + c + 128, hi);
                    float* vo = out + (samp ? OFF_V_S : OFF_V_P) + (size_t)rl * 512 + c; store8_f32(vo, lo); store8_f32(vo + 128, hi);
                } else {
                    if (wc == 0) {
                        const int d0 = 8 * fq; float cs[8], sn[8]; load8_f32(cosT + (size_t)pos * 32 + d0, cs); load8_f32(sinT + (size_t)pos * 32 + d0, sn);
                        float ol[8], oh[8];
#pragma unroll
                        for (int e = 0; e < 8; ++e) { ol[e] = lo[e] * cs[e] - hi[e] * sn[e]; oh[e] = hi[e] * cs[e] + lo[e] * sn[e]; }
                        store8_bf16(kib + (size_t)r * 64 + d0, ol); store8_bf16(kib + (size_t)r * 64 + 32 + d0, oh);
                        float* io = out + (samp ? OFF_IK_S : OFF_IK_P) + (size_t)rl * 64 + d0; store8_f32(io, ol); store8_f32(io + 32, oh);
                    } else if (wc == 1 && fq == 0) {
                        store8_f32(iwf + (size_t)r * 8, lo);
                    }
                }
            }
        }
    }
};

struct EpiKv {
    static constexpr bool PERM = true, AFTER_DRAIN = false;
    const float* rstd; float* ssk; float* out;
    __device__ __forceinline__ void operator()(const f32x4 (&acc)[2][2][4][2], const Unit& u, int wr, int wc, int fr, int fq) const {
        const int pn = u.pn; const int c8 = wc * 32 + 8 * fq;
        float rsv[2][4];
#pragma unroll
        for (int ai = 0; ai < 2; ++ai)
#pragma unroll
            for (int m = 0; m < 4; ++m) rsv[ai][m] = rstd[EPI_ROWS(ai, m)];
#pragma unroll
        for (int ai = 0; ai < 2; ++ai)
#pragma unroll
            for (int m = 0; m < 4; ++m) {
                const int r = EPI_ROWS(ai, m); const float rs = rsv[ai][m];
                float lo[8], hi[8]; EPI_GET(lo, ai, 0, m, rs); EPI_GET(hi, ai, 1, m, rs);
                if (pn < 4) {
                    float* o = out + OFF_MK_P + (size_t)r * 1024 + pn * 256 + c8; store8_f32(o, lo); store8_f32(o + 128, hi);
                    float ss = 0.f;
#pragma unroll
                    for (int e = 0; e < 8; ++e) ss += lo[e] * lo[e] + hi[e] * hi[e];
                    ss += __shfl_xor(ss, 16); ss += __shfl_xor(ss, 32);
                    if (fq == 0) atomicAdd(ssk + r * 4 + pn, ss);
                } else {
                    float* o = out + OFF_MV_P + (size_t)r * 1024 + (pn - 4) * 256 + c8; store8_f32(o, lo); store8_f32(o + 128, hi);
                }
            }
    }
    __device__ __forceinline__ void small8(int r, int c, const f32x4& v0, const f32x4& v1) const {
        const float rs = rstd[r];
        float v[8] = {v0.x * rs, v0.y * rs, v0.z * rs, v0.w * rs, v1.x * rs, v1.y * rs, v1.z * rs, v1.w * rs};
        if (c < 1024) {
            store8_f32(out + OFF_MK_P + (size_t)r * 1024 + c, v);
            float ss = 0.f;
#pragma unroll
            for (int e = 0; e < 8; ++e) ss += v[e] * v[e];
            ss += __shfl_xor(ss, 1); ss += __shfl_xor(ss, 2); ss += __shfl_xor(ss, 4);
            if ((fresh_lane() & 7) == 0) atomicAdd(ssk + r * 4 + (c >> 8), ss);
        } else store8_f32(out + OFF_MV_P + (size_t)r * 1024 + (c - 1024), v);
    }
};

struct EpiRes {
    static constexpr bool PERM = true, AFTER_DRAIN = false;
    const float* resP; const float* resS; const bf16_t* resB; float* dstP; float* dstS; bf16_t* dstB; float* ss;
    __device__ __forceinline__ void row(const f32x4 (&acc)[2][2][4][2], int ai, int m, int r, int rl, bool samp, int c8, int fq, const float* a, const float* b) const {
        float lo[8], hi[8]; EPI_GET(lo, ai, 0, m, 1.f); EPI_GET(hi, ai, 1, m, 1.f);
        float s2 = 0.f;
#pragma unroll
        for (int e = 0; e < 8; ++e) { lo[e] += a[e]; hi[e] += b[e]; s2 += lo[e] * lo[e] + hi[e] * hi[e]; }
        if (dstP) { float* dp = (samp ? dstS : dstP) + (size_t)rl * 1024 + c8; store8_f32(dp, lo); store8_f32(dp + 128, hi); }
        if (dstB) { store8_bf16(dstB + (size_t)r * 1024 + c8, lo); store8_bf16(dstB + (size_t)r * 1024 + c8 + 128, hi); }
        if (ss) { s2 += __shfl_xor(s2, 16); s2 += __shfl_xor(s2, 32); if (fq == 0) atomicAdd(ss + r, s2); }
    }
    __device__ __forceinline__ void operator()(const f32x4 (&acc)[2][2][4][2], const Unit& u, int wr, int wc, int fr, int fq) const {
        const bool samp = (u.pm >= 64); const int c8 = u.pn * 256 + wc * 32 + 8 * fq;
        if (resB) {
#pragma unroll
            for (int ai = 0; ai < 2; ++ai) {
                u32x4 ra[4], rb[4];
#pragma unroll
                for (int m = 0; m < 4; ++m) { const int r = EPI_ROWS(ai, m); ra[m] = *(const u32x4*)(resB + (size_t)r * 1024 + c8); rb[m] = *(const u32x4*)(resB + (size_t)r * 1024 + c8 + 128); }
#pragma unroll
                for (int m = 0; m < 4; ++m) { const int r = EPI_ROWS(ai, m); const int rl = samp ? r - MP : r; float a[8], b[8];
                    const u32x4 wa = ra[m], wb = rb[m];
                    a[0] = bf2f(wa.x & 0xffffu); a[1] = bf2f(wa.x >> 16); a[2] = bf2f(wa.y & 0xffffu); a[3] = bf2f(wa.y >> 16); a[4] = bf2f(wa.z & 0xffffu); a[5] = bf2f(wa.z >> 16); a[6] = bf2f(wa.w & 0xffffu); a[7] = bf2f(wa.w >> 16);
                    b[0] = bf2f(wb.x & 0xffffu); b[1] = bf2f(wb.x >> 16); b[2] = bf2f(wb.y & 0xffffu); b[3] = bf2f(wb.y >> 16); b[4] = bf2f(wb.z & 0xffffu); b[5] = bf2f(wb.z >> 16); b[6] = bf2f(wb.w & 0xffffu); b[7] = bf2f(wb.w >> 16);
                    row(acc, ai, m, r, rl, samp, c8, fq, a, b); }
            }
        } else {
#pragma unroll
            for (int ai = 0; ai < 2; ++ai) {
                f32x4 fa[4][2], fb[4][2];
#pragma unroll
                for (int m = 0; m < 4; ++m) { const int r = EPI_ROWS(ai, m); const int rl = samp ? r - MP : r; const float* rp = (samp ? resS : resP) + (size_t)rl * 1024 + c8;
                    fa[m][0] = *(const f32x4*)rp; fa[m][1] = *(const f32x4*)(rp + 4); fb[m][0] = *(const f32x4*)(rp + 128); fb[m][1] = *(const f32x4*)(rp + 132); }
#pragma unroll
                for (int m = 0; m < 4; ++m) { const int r = EPI_ROWS(ai, m); const int rl = samp ? r - MP : r;
                    const float a[8] = {fa[m][0].x, fa[m][0].y, fa[m][0].z, fa[m][0].w, fa[m][1].x, fa[m][1].y, fa[m][1].z, fa[m][1].w};
                    const float b[8] = {fb[m][0].x, fb[m][0].y, fb[m][0].z, fb[m][0].w, fb[m][1].x, fb[m][1].y, fb[m][1].z, fb[m][1].w};
                    row(acc, ai, m, r, rl, samp, c8, fq, a, b); }
            }
        }
    }
    __device__ __forceinline__ void small8(int r, int c, const f32x4& v0, const f32x4& v1) const {
        const int rl = r - MP; f32x4 a, b;
        if (resB) { const u32x4 w = *(const u32x4*)(resB + (size_t)r * 1024 + c);
            a = (f32x4){bf2f(w.x & 0xffffu), bf2f(w.x >> 16), bf2f(w.y & 0xffffu), bf2f(w.y >> 16)}; b = (f32x4){bf2f(w.z & 0xffffu), bf2f(w.z >> 16), bf2f(w.w & 0xffffu), bf2f(w.w >> 16)}; }
        else { const float* rp = resS + (size_t)rl * 1024 + c; a = *(const f32x4*)rp; b = *(const f32x4*)(rp + 4); }
        a = a + v0; b = b + v1;
        if (dstS) { float* dp = dstS + (size_t)rl * 1024 + c; *(f32x4*)dp = a; *(f32x4*)(dp + 4) = b; }
        if (dstB) { u32x4 w; w.x = cvt_pk_bf16(a.x, a.y); w.y = cvt_pk_bf16(a.z, a.w); w.z = cvt_pk_bf16(b.x, b.y); w.w = cvt_pk_bf16(b.z, b.w); *(u32x4*)(dstB + (size_t)r * 1024 + c) = w; }
        if (ss) { float s2 = (a.x * a.x + a.y * a.y) + (a.z * a.z + a.w * a.w) + (b.x * b.x + b.y * b.y) + (b.z * b.z + b.w * b.w);
            s2 += __shfl_xor(s2, 1); s2 += __shfl_xor(s2, 2); s2 += __shfl_xor(s2, 4); if ((c & 63) == 0) atomicAdd(ss + r, s2); }
    }
    __device__ __forceinline__ void small(int r, int c, int q, const f32x4& v0, const f32x4& v1) const {
        const int rl = r - MP; f32x4 a, b;
        if (resB) { const u64 w0 = *(const u64*)(resB + (size_t)r * 1024 + c), w1 = *(const u64*)(resB + (size_t)r * 1024 + c + 16);
            a = (f32x4){bf2f((unsigned)w0 & 0xffffu), bf2f(((unsigned)w0) >> 16), bf2f((unsigned)(w0 >> 32) & 0xffffu), bf2f((unsigned)(w0 >> 48))};
            b = (f32x4){bf2f((unsigned)w1 & 0xffffu), bf2f(((unsigned)w1) >> 16), bf2f((unsigned)(w1 >> 32) & 0xffffu), bf2f((unsigned)(w1 >> 48))}; }
        else { const float* rp = resS + (size_t)rl * 1024 + c; a = *(const f32x4*)rp; b = *(const f32x4*)(rp + 16); }
        a = a + v0; b = b + v1;
        if (dstS) { float* dp = dstS + (size_t)rl * 1024 + c; *(f32x4*)dp = a; *(f32x4*)(dp + 16) = b; }
        if (dstB) { bf16_t* bp = dstB + (size_t)r * 1024 + c; *(u64*)bp = (u64)cvt_pk_bf16(a.x, a.y) | ((u64)cvt_pk_bf16(a.z, a.w) << 32); *(u64*)(bp + 16) = (u64)cvt_pk_bf16(b.x, b.y) | ((u64)cvt_pk_bf16(b.z, b.w) << 32); }
        if (ss) { float s2 = (a.x * a.x + a.y * a.y) + (a.z * a.z + a.w * a.w) + (b.x * b.x + b.y * b.y) + (b.z * b.z + b.w * b.w); s2 += __shfl_xor(s2, 16); s2 += __shfl_xor(s2, 32); if (q == 0) atomicAdd(ss + r, s2); }
    }
};

struct EpiQm {
    static constexpr bool PERM = true, AFTER_DRAIN = false;
    const float* ss1; const float* mqg; bf16_t* qmem; float* ssq;
    __device__ __forceinline__ void operator()(const f32x4 (&acc)[2][2][4][2], const Unit& u, int wr, int wc, int fr, int fq) const {
        const int c8 = wc * 32 + 8 * fq; float gl[8], gh[8]; load8_f32(mqg + c8, gl); load8_f32(mqg + 128 + c8, gh);
        float rsv[2][4];
#pragma unroll
        for (int ai = 0; ai < 2; ++ai)
#pragma unroll
            for (int m = 0; m < 4; ++m) rsv[ai][m] = __builtin_amdgcn_rsqf(ss1[EPI_ROWS(ai, m)] * (1.f / 1024.f) + EPS);
#pragma unroll
        for (int ai = 0; ai < 2; ++ai)
#pragma unroll
            for (int m = 0; m < 4; ++m) {
                const int r = EPI_ROWS(ai, m); const float rs = rsv[ai][m];
                float lo[8], hi[8]; EPI_GET(lo, ai, 0, m, rs); EPI_GET(hi, ai, 1, m, rs);
                float s2 = 0.f;
#pragma unroll
                for (int e = 0; e < 8; ++e) { s2 += lo[e] * lo[e] + hi[e] * hi[e]; lo[e] *= gl[e]; hi[e] *= gh[e]; }
                s2 += __shfl_xor(s2, 16); s2 += __shfl_xor(s2, 32); if (fq == 0) atomicAdd(ssq + r * 4 + u.pn, s2);
                bf16_t* o = qmem + (size_t)r * 1024 + u.pn * 256 + c8; store8_bf16(o, lo); store8_bf16(o + 128, hi);
            }
    }
    __device__ __forceinline__ void small8(int r, int c, const f32x4& v0, const f32x4& v1) const {
        const float rs = __builtin_amdgcn_rsqf(ss1[r] * (1.f / 1024.f) + EPS); const f32x4 a = v0 * rs, b = v1 * rs;
        float s2 = (a.x * a.x + a.y * a.y) + (a.z * a.z + a.w * a.w) + (b.x * b.x + b.y * b.y) + (b.z * b.z + b.w * b.w); s2 += __shfl_xor(s2, 1); s2 += __shfl_xor(s2, 2); s2 += __shfl_xor(s2, 4);
        if ((c & 63) == 0) atomicAdd(ssq + r * 4 + (c >> 8), s2);
        const f32x4 g0 = *(const f32x4*)(mqg + (c & 255)), g1 = *(const f32x4*)(mqg + (c & 255) + 4); const f32x4 x = a * g0, y = b * g1;
        u32x4 w; w.x = cvt_pk_bf16(x.x, x.y); w.y = cvt_pk_bf16(x.z, x.w); w.z = cvt_pk_bf16(y.x, y.y); w.w = cvt_pk_bf16(y.z, y.w); *(u32x4*)(qmem + (size_t)r * 1024 + c) = w;
    }
    __device__ __forceinline__ void small(int r, int c, int q, const f32x4& v0, const f32x4& v1) const {
        const float rs = 1.0f / sqrtf(ss1[r] * (1.f / 1024.f) + EPS); const f32x4 a = v0 * rs, b = v1 * rs;
        float s2 = (a.x * a.x + a.y * a.y) + (a.z * a.z + a.w * a.w) + (b.x * b.x + b.y * b.y) + (b.z * b.z + b.w * b.w); s2 += __shfl_xor(s2, 16); s2 += __shfl_xor(s2, 32);
        if (q == 0) atomicAdd(ssq + r * 4 + (c >> 8), s2);
        const f32x4 g0 = *(const f32x4*)(mqg + (c & 255)), g1 = *(const f32x4*)(mqg + (c & 255) + 16); const f32x4 x = a * g0, y = b * g1;
        bf16_t* bp = qmem + (size_t)r * 1024 + c; *(u64*)bp = (u64)cvt_pk_bf16(x.x, x.y) | ((u64)cvt_pk_bf16(x.z, x.w) << 32); *(u64*)(bp + 16) = (u64)cvt_pk_bf16(y.x, y.y) | ((u64)cvt_pk_bf16(y.z, y.w) << 32);
    }
};

#define DPP_SHR1(old, x) __builtin_bit_cast(float, __builtin_amdgcn_update_dpp(__builtin_bit_cast(int, (old)), __builtin_bit_cast(int, (x)), 0x111, 0xF, 0xF, false))
#define DPP_SHR2(old, x) __builtin_bit_cast(float, __builtin_amdgcn_update_dpp(__builtin_bit_cast(int, (old)), __builtin_bit_cast(int, (x)), 0x112, 0xF, 0xF, false))
#define DPP_ROR1(x) __builtin_bit_cast(float, __builtin_amdgcn_update_dpp(0, __builtin_bit_cast(int, (x)), 0x121, 0xF, 0xF, true))
#define DPP_ROR2(x) __builtin_bit_cast(float, __builtin_amdgcn_update_dpp(0, __builtin_bit_cast(int, (x)), 0x122, 0xF, 0xF, true))
struct EpiGu {
    static constexpr bool PERM = true, AFTER_DRAIN = false;
    const float* ss2; const float* cw; const float* cb; const float* st; bf16_t* aff; float* sideg; float* sideu; float* lastg; float* out; float* halo;
    __device__ __forceinline__ void operator()(const f32x4 (&acc)[2][2][4][2], const Unit& u, int wr, int wc, int fr, int fq) const {
        const int ch = 128 * u.pn + wc * 32 + 8 * fq; const bool samp = (u.pm >= 64);
        float w0[8], w1[8], w2[8], bb[8]; load8_f32(cw + ch, w0); load8_f32(cw + DFF + ch, w1); load8_f32(cw + 2 * DFF + ch, w2); load8_f32(cb + ch, bb);
        float* hme = halo + (((wr * 4 + wc) * 4 + fq) * 2) * 8;
        float rsv[2][4];
#pragma unroll
        for (int ai = 0; ai < 2; ++ai)
#pragma unroll
            for (int m = 0; m < 4; ++m) rsv[ai][m] = __builtin_amdgcn_rsqf(ss2[EPI_ROWS(ai, m)] * (1.f / 1024.f) + EPS);
#pragma unroll
        for (int ai = 0; ai < 2; ++ai) {
            const int r = EPI_ROWS(ai, 3); const float rs = rsv[ai][3];
            float g[8]; EPI_GET(g, ai, 0, 3, rs);
            if (fr >= 14) { store8_f32(hme + ai * 512 + (fr - 14) * 8, g); if (ai == 1 && wr == 1 && !samp) store8_f32(lastg + (size_t)(u.pm * 2 + (fr - 14)) * DFF + ch, g); }
        }
        asm volatile("s_waitcnt lgkmcnt(0)" ::: "memory"); __builtin_amdgcn_s_barrier();
#pragma unroll
        for (int ai = 0; ai < 2; ++ai) {
            float prev[8];
#pragma unroll
            for (int m = 0; m < 4; ++m) {
                const int r = EPI_ROWS(ai, m); const float rs = rsv[ai][m];
                float g[8], up[8], p1[8], p2[8]; EPI_GET(g, ai, 0, m, rs); EPI_GET(up, ai, 1, m, rs);
                if (m == 0) {
                    float x1[8], x2[8];
#pragma unroll
                    for (int e = 0; e < 8; ++e) { x1[e] = 0.f; x2[e] = 0.f; }
                    if (!(ai == 0 && wr == 0) && !samp) {
                        const float* hp = halo + (wr == 1 ? ai * 512 : (ai - 1) * 512) + ((((wr ^ 1) * 4 + wc) * 4 + fq) * 2) * 8;
                        if (fr == 0) { load8_f32(hp, x2); load8_f32(hp + 8, x1); } else if (fr == 1) { load8_f32(hp + 8, x2); }
                    }
#pragma unroll
                    for (int e = 0; e < 8; ++e) { p1[e] = DPP_SHR1(x1[e], g[e]); p2[e] = DPP_SHR2(x2[e], g[e]); }
                    if (ai == 0 && wr == 0 && !samp && (u.pm & 31) != 0 && fr < 2) {
                        store8_f32(sideg + (size_t)(u.pm * 2 + fr) * DFF + ch, g); store8_f32(sideu + (size_t)(u.pm * 2 + fr) * DFF + ch, up);
                    }
                } else {
#pragma unroll
                    for (int e = 0; e < 8; ++e) { const float x1 = DPP_ROR1(prev[e]), x2 = DPP_ROR2(prev[e]); p1[e] = DPP_SHR1(x1, g[e]); p2[e] = DPP_SHR2(x2, g[e]); }
                }
                if (samp) {
                    const int rl = r - MP, b = rl >> 3, tt = rl & 7;
                    if (tt == 0) { load8_f32(st + (size_t)(b * 2 + 1) * DFF + ch, p1); load8_f32(st + (size_t)(b * 2) * DFF + ch, p2); }
                    else if (tt == 1) { load8_f32(st + (size_t)(b * 2 + 1) * DFF + ch, p2); }
                    if (tt >= 6) store8_f32(out + OFF_CF_S + (size_t)(b * 2 + (tt - 6)) * DFF + ch, g);
                } else {
                    const int t = r & (SEQ - 1); if (t >= SEQ - 2) store8_f32(out + OFF_CF_P + (size_t)((r >> 13) * 2 + (t - (SEQ - 2))) * DFF + ch, g);
                }
                float y[8];
#pragma unroll
                for (int e = 0; e < 8; ++e) { const float z = w0[e] * p2[e] + w1[e] * p1[e] + w2[e] * g[e] + bb[e]; y[e] = (z * __builtin_amdgcn_rcpf(1.0f + __builtin_amdgcn_exp2f(-1.4426950408889634f * z))) * up[e]; prev[e] = g[e]; }
                store8_bf16(aff + (size_t)r * DFF + ch, y);
            }
        }
    }
};
__device__ __forceinline__ void ffn_fixup_rows(const Ctx& C, int pm) {
    if (pm >= 64 || (pm & 31) == 0) return;
    const float* sideg = (const float*)(C.ws + WS_SIDEG); const float* sideu = (const float*)(C.ws + WS_SIDEU); const float* lastg = (const float*)(C.ws + WS_LASTG);
    bf16_t* aff = (bf16_t*)(C.ws + WS_AFF);
    constexpr int NC = (DFF + NTHREADS - 1) / NTHREADS;
    float g0[NC], g1[NC], u0[NC], u1[NC], l0[NC], l1[NC], w0[NC], w1[NC], w2[NC], bb[NC];
#pragma unroll
    for (int i = 0; i < NC; ++i) { const int c = C.tid + i * NTHREADS; const int cc = (c < DFF) ? c : 0;
        g0[i] = sideg[(size_t)(pm * 2) * DFF + cc]; g1[i] = sideg[(size_t)(pm * 2 + 1) * DFF + cc]; u0[i] = sideu[(size_t)(pm * 2) * DFF + cc]; u1[i] = sideu[(size_t)(pm * 2 + 1) * DFF + cc];
        l0[i] = lastg[(size_t)((pm - 1) * 2) * DFF + cc]; l1[i] = lastg[(size_t)((pm - 1) * 2 + 1) * DFF + cc];
        w0[i] = C.conv_ffn_w[cc]; w1[i] = C.conv_ffn_w[DFF + cc]; w2[i] = C.conv_ffn_w[2 * DFF + cc]; bb[i] = C.conv_ffn_b[cc]; }
#pragma unroll
    for (int i = 0; i < NC; ++i) { const int c = C.tid + i * NTHREADS;
        const float z0 = w0[i] * l0[i] + w1[i] * l1[i] + w2[i] * g0[i] + bb[i], z1 = w0[i] * l1[i] + w1[i] * g0[i] + w2[i] * g1[i] + bb[i];
        if (c < DFF) {
            aff[(size_t)(256 * pm) * DFF + c] = (bf16_t)(cvt_pk_bf16((z0 * __builtin_amdgcn_rcpf(1.0f + __builtin_amdgcn_exp2f(-1.4426950408889634f * z0))) * u0[i], 0.f) & 0xffffu);
            aff[(size_t)(256 * pm + 1) * DFF + c] = (bf16_t)(cvt_pk_bf16((z1 * __builtin_amdgcn_rcpf(1.0f + __builtin_amdgcn_exp2f(-1.4426950408889634f * z1))) * u1[i], 0.f) & 0xffffu); } }
    asm volatile("s_waitcnt vmcnt(0)" ::: "memory");
    __syncthreads();
}

template <class Epi> __device__ __forceinline__ void gemm_small(const bf16_t* A, const bf16_t* Bt, int K, int tile, int wave, int lane, const Epi& E) {
    const int i = lane & 15, q = lane >> 4, wm = wave & 3, wn = wave >> 2;
    const int row = MP + (tile >> 4) * 64 + wm * 16 + i, col0 = (tile & 15) * 64 + wn * 32;
    const bf16_t* ap = A + (size_t)row * K + 8 * q; const bf16_t* bp0 = Bt + (size_t)(col0 + i) * K + 8 * q; const bf16_t* bp1 = bp0 + (size_t)16 * K;
    f32x4 c0 = {0.f, 0.f, 0.f, 0.f}, c1 = {0.f, 0.f, 0.f, 0.f};
    for (int k0 = 0; k0 < K; k0 += 256) {
        bf16x8 a[8], b0[8], b1[8];
#pragma unroll
        for (int u = 0; u < 8; ++u) { a[u] = *(const bf16x8*)(ap + k0 + 32 * u); b0[u] = *(const bf16x8*)(bp0 + k0 + 32 * u); b1[u] = *(const bf16x8*)(bp1 + k0 + 32 * u); }
#pragma unroll
        for (int u = 0; u < 8; ++u) { c0 = __builtin_amdgcn_mfma_f32_16x16x32_bf16(b0[u], a[u], c0, 0, 0, 0); c1 = __builtin_amdgcn_mfma_f32_16x16x32_bf16(b1[u], a[u], c1, 0, 0, 0); }
    }
    E.small(row, col0 + 4 * q, q, c0, c1);
}

template <int K, class Epi> __device__ __forceinline__ void gemm_small2_rc(const bf16_t* A, const bf16_t* Bt, int row0, int col0, int wave, int lane, const Epi& E, unsigned char* lds) {
    constexpr int KW = K / 8, NS = KW / 32;
    const int i = lane & 15, q = lane >> 4;
    const bf16_t* ap = A + (size_t)(row0 + i) * K + wave * KW + 8 * q; const bf16_t* bp = Bt + (size_t)(col0 + i) * K + wave * KW + 8 * q;
    f32x4 acc[4][4];
#pragma unroll
    for (int cb = 0; cb < 4; ++cb)
#pragma unroll
        for (int rb = 0; rb < 4; ++rb) acc[cb][rb] = (f32x4){0.f, 0.f, 0.f, 0.f};
#pragma unroll
    for (int s0 = 0; s0 < NS; s0 += 4) {
        bf16x8 a[4][4], b[4][4];
#pragma unroll
        for (int s = 0; s < 4; ++s) if (s0 + s < NS) {
#pragma unroll
            for (int x = 0; x < 4; ++x) { a[s][x] = *(const bf16x8*)(ap + (size_t)(16 * x) * K + 32 * (s0 + s)); b[s][x] = *(const bf16x8*)(bp + (size_t)(16 * x) * K + 32 * (s0 + s)); } }
#pragma unroll
        for (int s = 0; s < 4; ++s) if (s0 + s < NS) {
#pragma unroll
            for (int cb = 0; cb < 4; ++cb)
#pragma unroll
                for (int rb = 0; rb < 4; ++rb) acc[cb][rb] = __builtin_amdgcn_mfma_f32_16x16x32_bf16(b[s][cb], a[s][rb], acc[cb][rb], 0, 0, 0); }
    }
    float* slab = (float*)lds + wave * 4096;
    __syncthreads();
#pragma unroll
    for (int cb = 0; cb < 4; ++cb)
#pragma unroll
        for (int rb = 0; rb < 4; ++rb) *(f32x4*)(slab + (16 * rb + i) * 64 + 4 * ((4 * cb + q) ^ i)) = acc[cb][rb];
    __syncthreads();
    {
        const int t = wave * 64 + lane, r = t >> 3, c8 = t & 7;
        f32x4 v0 = {0.f, 0.f, 0.f, 0.f}, v1 = {0.f, 0.f, 0.f, 0.f};
#pragma unroll
        for (int w = 0; w < 8; ++w) { const float* sp = (const float*)lds + w * 4096 + r * 64;
            v0 += *(const f32x4*)(sp + 4 * ((2 * c8) ^ (r & 15))); v1 += *(const f32x4*)(sp + 4 * ((2 * c8 + 1) ^ (r & 15))); }
        E.small8(row0 + r, col0 + 8 * c8, v0, v1);
    }
    __syncthreads();
}
template <int K, class Epi> __device__ __forceinline__ void gemm_small2(const bf16_t* A, const bf16_t* Bt, int tile, int wave, int lane, const Epi& E, unsigned char* lds) {
    gemm_small2_rc<K, Epi>(A, Bt, MP + (tile >> 4) * 64, (tile & 15) * 64, wave, lane, E, lds);
}

__device__ __forceinline__ int orig_win(int np) {
    const int T = np >> 8, cl = np & 255, bj = cl >> 7, wc = (cl >> 5) & 3, i = cl & 31;
    if (T < 2) return np;
    if (T < 6) return (bj ? 1024 : 512) + 128 * (T - 2) + (cl & 127);
    if (T < 8) return 1536 + (4 * (T - 6) + wc) * 64 + 32 * bj + i;
    if (T < 10) return 2048 + (4 * (T - 8) + wc) * 64 + 32 * bj + i;
    if (T < 12) return 2560 + 256 * (T - 10) + cl;
    if (T < 14) return 3072 + (4 * (T - 12) + wc) * 64 + 32 * bj + i;
    if (wc == 0) return 3584 + 32 * bj + i;
    if (wc == 1 && bj == 0 && i < 8) return 3648 + i;
    return -1;
}
__device__ __forceinline__ int orig_wgu(int np) { const int T = np >> 8, cl = np & 255; return ((cl >> 7) ? DFF : 0) + 128 * T + (cl & 127); }

template <int MODE> __device__ __forceinline__ void wt_item(const float* W, int K, int N, int Np, const float* gain, bf16_t* WT, int item, float* scr, int lane) {
    const int nblk = Np / 32, kb = item / nblk, nb = item - kb * nblk, k0 = 64 * kb, n0 = 32 * nb;
    const int np = n0 + (lane & 31); const int o = (MODE == 1) ? orig_win(np) : (MODE == 2) ? orig_wgu(np) : np;
    float wv[32];
#pragma unroll
    for (int i = 0; i < 32; ++i) { const int kk = 2 * i + (lane >> 5); wv[i] = (o >= 0) ? W[(size_t)(k0 + kk) * N + o] : 0.f; }
    if (gain) {
        float gv[32];
#pragma unroll
        for (int i = 0; i < 32; ++i) gv[i] = gain[k0 + 2 * i + (lane >> 5)];
#pragma unroll
        for (int i = 0; i < 32; ++i) wv[i] *= gv[i];
    }
#pragma unroll
    for (int i = 0; i < 32; ++i) scr[(2 * i + (lane >> 5)) * 33 + (lane & 31)] = wv[i];
    LDS_WAIT();
    const int c = lane & 7;
#pragma unroll
    for (int j = 0; j < 4; ++j) { const int n = (lane >> 3) + 8 * j; const float* s = scr + (8 * c) * 33 + n;
        u32x4 ov; ov.x = cvt_pk_bf16(s[0 * 33], s[1 * 33]); ov.y = cvt_pk_bf16(s[2 * 33], s[3 * 33]); ov.z = cvt_pk_bf16(s[4 * 33], s[5 * 33]); ov.w = cvt_pk_bf16(s[6 * 33], s[7 * 33]);
        *(u32x4*)(WT + (size_t)(n0 + n) * K + k0 + 8 * c) = ov; }
    LDS_WAIT();
}
__device__ __forceinline__ void row_to_bf16(const float* xrow, bf16_t* orow, float* rstd_out, int lane) {
    const f32x4* xr = (const f32x4*)xrow + lane; f32x4 v[4]; float s = 0.f;
#pragma unroll
    for (int j = 0; j < 4; ++j) { v[j] = xr[64 * j]; s += (v[j].x * v[j].x + v[j].y * v[j].y) + (v[j].z * v[j].z + v[j].w * v[j].w); }
    s = wave_sum(s); if (lane == 0) *rstd_out = 1.0f / sqrtf(s * (1.f / 1024.f) + EPS);
    u64* o8 = (u64*)orow + lane;
#pragma unroll
    for (int j = 0; j < 4; ++j) o8[64 * j] = (u64)cvt_pk_bf16(v[j].x, v[j].y) | ((u64)cvt_pk_bf16(v[j].z, v[j].w) << 32);
}
__device__ __forceinline__ void sincos_d(double a, float& sn, float& cs) {
    const double n = __builtin_rint(a * 0.63661977236758134308); const int q = ((int)n) & 3;
    double r = __builtin_fma(-n, 1.57079632679489655800e+00, a); r = __builtin_fma(-n, 6.12323399573676603587e-17, r);
    const double r2 = r * r;
    double ps = 1.0 / 6227020800.0; ps = ps * r2 - 1.0 / 39916800.0; ps = ps * r2 + 1.0 / 362880.0; ps = ps * r2 - 1.0 / 5040.0; ps = ps * r2 + 1.0 / 120.0; ps = ps * r2 - 1.0 / 6.0; ps = ps * r2 * r + r;
    double pc = -1.0 / 87178291200.0; pc = pc * r2 + 1.0 / 479001600.0; pc = pc * r2 - 1.0 / 3628800.0; pc = pc * r2 + 1.0 / 40320.0; pc = pc * r2 - 1.0 / 720.0; pc = pc * r2 + 1.0 / 24.0; pc = pc * r2 - 0.5; pc = pc * r2 + 1.0;
    const double s = (q == 0) ? ps : (q == 1) ? pc : (q == 2) ? -ps : -pc;
    const double c = (q == 0) ? pc : (q == 1) ? -ps : (q == 2) ? -pc : ps;
    sn = (float)s; cs = (float)c;
}
__device__ __forceinline__ void ph0_prologue(const Ctx& C, unsigned char* lds) {
    float* scr = (float*)lds + C.wave * (64 * 33);
    const int gw = C.bid * NWAVES + C.wave, NGW = C.G * NWAVES;
    constexpr int I_IN = 16 * (DINP / 32), I_OUT = 16 * 32, I_Q = 16 * 32, I_KV = 16 * 64, I_O = 16 * 32, I_GU = 16 * (2 * DFF / 32), I_DN = (DFF / 64) * 32;
    constexpr int NIT = I_IN + I_OUT + I_Q + I_KV + I_O + I_GU + I_DN;
    for (int it = gw; it < NIT; it += NGW) {
        int r = __builtin_amdgcn_readfirstlane(it);
        if (r < I_IN) { wt_item<1>(C.w_in, DM, DIN, DINP, C.g_mix, (bf16_t*)(C.ws + WS_WIN), r, scr, C.lane); continue; } r -= I_IN;
        if (r < I_OUT) { wt_item<0>(C.w_out, DM, DM, DM, nullptr, (bf16_t*)(C.ws + WS_WOUT), r, scr, C.lane); continue; } r -= I_OUT;
        if (r < I_Q) { wt_item<0>(C.w_q, DM, DM, DM, C.g_mem, (bf16_t*)(C.ws + WS_WQ), r, scr, C.lane); continue; } r -= I_Q;
        if (r < I_KV) { wt_item<0>(C.w_kv, DM, 2 * DM, 2 * DM, C.g_mem_src, (bf16_t*)(C.ws + WS_WKV), r, scr, C.lane); continue; } r -= I_KV;
        if (r < I_O) { wt_item<0>(C.w_o, DM, DM, DM, nullptr, (bf16_t*)(C.ws + WS_WO), r, scr, C.lane); continue; } r -= I_O;
        if (r < I_GU) { wt_item<2>(C.w_gu, DM, 2 * DFF, 2 * DFF, C.g_ffn, (bf16_t*)(C.ws + WS_WGU), r, scr, C.lane); continue; } r -= I_GU;
        wt_item<0>(C.w_down, DFF, DM, DM, nullptr, (bf16_t*)(C.ws + WS_WDOWN), r, scr, C.lane);
    }
    float* rstd = (float*)(C.ws + WS_RSTD);
    for (int m0 = gw; m0 < MT + 512; m0 += 4 * NGW) {
        const float* src[4]; bf16_t* dst[4]; bool ok[4]; f32x4 v[4][4];
#pragma unroll
        for (int u = 0; u < 4; ++u) { const int m = m0 + u * NGW; ok[u] = m < MT + 512; const int mm = ok[u] ? m : 0;
            if (mm < MP) { src[u] = C.x_p + (size_t)mm * DM; dst[u] = (bf16_t*)(C.ws + WS_XB) + (size_t)mm * DM; }
            else if (mm < MT) { src[u] = C.x_s + (size_t)(mm - MP) * DM; dst[u] = (bf16_t*)(C.ws + WS_XB) + (size_t)mm * DM; }
            else { src[u] = C.mem_p + (size_t)(mm - MT) * DM; dst[u] = (bf16_t*)(C.ws + WS_MEMB) + (size_t)(mm - MT) * DM; }
#pragma unroll
            for (int j = 0; j < 4; ++j) v[u][j] = ((const f32x4*)src[u] + C.lane)[64 * j]; }
#pragma unroll
        for (int u = 0; u < 4; ++u) { const int m = m0 + u * NGW; float s = 0.f;
#pragma unroll
            for (int j = 0; j < 4; ++j) s += (v[u][j].x * v[u][j].x + v[u][j].y * v[u][j].y) + (v[u][j].z * v[u][j].z + v[u][j].w * v[u][j].w);
            s = wave_sum(s);
            if (ok[u]) { if (C.lane == 0) rstd[m] = 1.0f / sqrtf(s * (1.f / 1024.f) + EPS);
                u64* o8 = (u64*)dst[u] + C.lane;
#pragma unroll
                for (int j = 0; j < 4; ++j) o8[64 * j] = (u64)cvt_pk_bf16(v[u][j].x, v[u][j].y) | ((u64)cvt_pk_bf16(v[u][j].z, v[u][j].w) << 32); } }
    }
    const int gt = C.bid * NTHREADS + C.tid, NGT = C.G * NTHREADS;
    float* cosT = (float*)(C.ws + WS_COS); float* sinT = (float*)(C.ws + WS_SIN);
    for (int i = gt; i < SEQ * 32; i += NGT) {
        const int pos = i >> 5, d = i & 31;
        const float inv = expf((float)d * (float)(-2.0 * 9.210340371976184 / 64.0));
        const float ang = (float)pos * inv;
        float sn, cs; sincos_d((double)ang, sn, cs); cosT[i] = cs; sinT[i] = sn;
    }
}

constexpr int MEMP_CHUNK = 512, NMEMP = 65536 / MEMP_CHUNK;
__device__ __forceinline__ void ph2_memprep(const Ctx& C, int chunk) {
    const int gt = chunk * MEMP_CHUNK + C.wave * 64 + fresh_lane(), NGT = NTHREADS, cEnd = (chunk + 1) * MEMP_CHUNK;
    const float* ssk = (const float*)(C.ws + ACC_SSK); float* mk = C.out + OFF_MK_P; const float* mv = C.out + OFF_MV_P;
    bf16_t* mkF = (bf16_t*)(C.ws + WS_MKF); bf16_t* mvF = (bf16_t*)(C.ws + WS_MVF);
    for (int c = gt; c < cEnd; c += NGT) {
        const int lane = c & 63, ks = (c >> 6) & 15, mb = (c >> 10) & 7, h = (c >> 13) & 3, b = c >> 15; const int r32 = lane & 31, hi = lane >> 5;
        const int r = b * 256 + 32 * mb + r32, d0 = 16 * ks + 8 * hi;
        const float rn = 1.0f / sqrtf(ssk[r * 4 + h] * (1.f / 256.f) + EPS);
        float v[8], g[8]; float* p = mk + (size_t)r * 1024 + h * 256 + d0; load8_f32(p, v); load8_f32(C.mk_g + d0, g);
#pragma unroll
        for (int e = 0; e < 8; ++e) v[e] = v[e] * rn * g[e];
        store8_f32(p, v); store8_bf16(mkF + (size_t)c * 8, v);
    }
    for (int c = gt; c < cEnd; c += NGT) {
        const int lane = c & 63, s = (c >> 6) & 1, mb = (c >> 7) & 7, db = (c >> 10) & 7, h = (c >> 13) & 3, b = c >> 15; const int r32 = lane & 31, hi = lane >> 5;
        float v[8];
#pragma unroll
        for (int j = 0; j < 8; ++j) { const int m = 32 * mb + 16 * s + 8 * (j >> 2) + 4 * hi + (j & 3); v[j] = mv[(size_t)(b * 256 + m) * 1024 + h * 256 + 32 * db + r32]; }
        store8_bf16(mvF + (size_t)c * 8, v);
    }
}
__device__ __forceinline__ void score_unit_prompt(const Ctx& C, int b, int g, unsigned char* lds) {
    const int lane = fresh_lane(), tid = C.wave * 64 + lane, r32 = lane & 31, hi = lane >> 5;
    const bf16_t* qib = (const bf16_t*)(C.ws + WS_QI); const bf16_t* kib = (const bf16_t*)(C.ws + WS_KI);
#pragma unroll
    for (int j = 0; j < 4; ++j) { const int id = tid + 512 * j, c = id >> 5, r = id & 31;
        *(u32x4*)(lds + id * 16) = *(const u32x4*)(qib + (size_t)(b * SEQ + 32 * g + r) * 512 + c * 8); }
    __syncthreads();
    const int qrow0 = b * SEQ + 32 * g;
    float w[8]; load8_f32((const float*)(C.ws + WS_IW) + (size_t)(qrow0 + r32) * 8, w);
    float* stg = (float*)(lds + 32768 + C.wave * 8704);
    float* sout = (float*)(C.ws + WS_SC) + (size_t)(qrow0 + (lane >> 4)) * SEQ + (lane & 15) * 4;
    const int nt = (g >> 1) + 1;
    const int ntp = ((32 * g + 32 + 511) >> 9) << 3;
    const int tq = 32 * g + r32;
    const unsigned char* qbase = lds + hi * 512 + r32 * 16;
    const bf16_t* kp0 = kib + (size_t)(b * SEQ + r32) * 64 + hi * 8;
    bf16x8 kf[4][2];
    { const bf16_t* kp = kp0 + (size_t)((C.wave < nt) ? C.wave : 0) * 4096;
#pragma unroll
      for (int d0 = 0; d0 < 4; ++d0) { kf[d0][0] = *(const bf16x8*)(kp + d0 * 16); kf[d0][1] = *(const bf16x8*)(kp + 32 * 64 + d0 * 16); } }
    for (int kt = C.wave; kt < ntp; kt += NWAVES) {
        bf16x8 kn[4][2];
        { const bf16_t* kp = kp0 + (size_t)((kt + NWAVES < nt) ? kt + NWAVES : kt) * 4096;
#pragma unroll
          for (int d0 = 0; d0 < 4; ++d0) { kn[d0][0] = *(const bf16x8*)(kp + d0 * 16); kn[d0][1] = *(const bf16x8*)(kp + 32 * 64 + d0 * 16); } }
        float a0[16], a1[16];
#pragma unroll
        for (int r = 0; r < 16; ++r) { a0[r] = 0.f; a1[r] = 0.f; }
        if (kt < nt) {
#pragma unroll
        for (int h = 0; h < 8; ++h) {
            bf16x8 qf[4];
#pragma unroll
            for (int d0 = 0; d0 < 4; ++d0) qf[d0] = *(const bf16x8*)(qbase + (h * 8 + d0 * 2) * 512);
            f32x16 p = {};
#pragma unroll
            for (int d0 = 0; d0 < 4; ++d0) p = __builtin_amdgcn_mfma_f32_32x32x16_bf16(kf[d0][0], qf[d0], p, 0, 0, 0);
#pragma unroll
            for (int r = 0; r < 16; ++r) a0[r] = __builtin_fmaf(w[h], __builtin_amdgcn_fmed3f(p[r], 0.f, 3.0e38f), a0[r]);
            f32x16 p2 = {};
#pragma unroll
            for (int d0 = 0; d0 < 4; ++d0) p2 = __builtin_amdgcn_mfma_f32_32x32x16_bf16(kf[d0][1], qf[d0], p2, 0, 0, 0);
#pragma unroll
            for (int r = 0; r < 16; ++r) a1[r] = __builtin_fmaf(w[h], __builtin_amdgcn_fmed3f(p2[r], 0.f, 3.0e38f), a1[r]);
#pragma unroll
            for (int r = 0; r < 16; ++r) { asm volatile("" : "+v"(a0[r])); asm volatile("" : "+v"(a1[r])); }
        }
        }
        if (kt * 64 + 63 > 32 * g) {
#pragma unroll
            for (int r = 0; r < 16; ++r) { const int key = kt * 64 + (r & 3) + 8 * (r >> 2) + 4 * hi; if (key > tq) a0[r] = -INFINITY; if (key + 32 > tq) a1[r] = -INFINITY; }
        }
#pragma unroll
        for (int r = 0; r < 16; ++r) { const unsigned u0 = __float_as_uint(a0[r]), u1 = __float_as_uint(a1[r]);
            a0[r] = __uint_as_float(u0 ^ ((unsigned)((int)u0 >> 31) | 0x80000000u)); a1[r] = __uint_as_float(u1 ^ ((unsigned)((int)u1 >> 31) | 0x80000000u)); }
#pragma unroll
        for (int rq = 0; rq < 4; ++rq) {
            *(f32x4*)(stg + r32 * 68 + 8 * rq + 4 * hi) = (f32x4){a0[4 * rq], a0[4 * rq + 1], a0[4 * rq + 2], a0[4 * rq + 3]};
            *(f32x4*)(stg + r32 * 68 + 32 + 8 * rq + 4 * hi) = (f32x4){a1[4 * rq], a1[4 * rq + 1], a1[4 * rq + 2], a1[4 * rq + 3]};
        }
#pragma unroll
        for (int i = 0; i < 8; ++i) { const f32x4 v = *(const f32x4*)(stg + (i * 4 + (lane >> 4)) * 68 + (lane & 15) * 4); *(f32x4*)(sout + (size_t)(i * 4) * SEQ + kt * 64) = v; }
#pragma unroll
        for (int d0 = 0; d0 < 4; ++d0) { kf[d0][0] = kn[d0][0]; kf[d0][1] = kn[d0][1]; }
    }
    asm volatile("s_waitcnt vmcnt(0)" ::: "memory");
    __syncthreads();
}
__device__ __forceinline__ float dpp_sum8s(float x) {
    x += __builtin_bit_cast(float, __builtin_amdgcn_update_dpp(0, __builtin_bit_cast(int, x), 0xB1, 0xF, 0xF, true));
    x += __builtin_bit_cast(float, __builtin_amdgcn_update_dpp(0, __builtin_bit_cast(int, x), 0x4E, 0xF, 0xF, true));
    x += __builtin_bit_cast(float, __builtin_amdgcn_update_dpp(0, __builtin_bit_cast(int, x), 0x141, 0xF, 0xF, true));
    return x;
}
__device__ __forceinline__ void score_unit_sample(const Ctx& C, int b, int c) {
    const int lane = fresh_lane(), r32 = lane & 31, hi = lane >> 5;
    const bf16_t* qib = (const bf16_t*)(C.ws + WS_QI);
    bf16x8 qf[2][4]; float w2[2];
#pragma unroll
    for (int nb = 0; nb < 2; ++nb) { const int row = MP + b * DS + 4 * nb + (r32 >> 3), h = r32 & 7;
        w2[nb] = ((const float*)(C.ws + WS_IW))[(size_t)row * 8 + h];
#pragma unroll
        for (int d0 = 0; d0 < 4; ++d0) qf[nb][d0] = *(const bf16x8*)(qib + (size_t)row * 512 + h * 64 + d0 * 16 + hi * 8); }
    const int kb0 = 4 * c, kb1 = (c == 15) ? 65 : 4 * c + 4;
    float* scs = (float*)(C.ws + WS_SCS) + (size_t)(b * DS) * SPITCH;
#define SKP(kb_) (((kb_) < 64) ? (C.cache_ik + ((size_t)C.page_table[b * NPAGES + ((kb_) >> 2)] * PAGE + ((kb_) & 3) * 32 + r32) * 64 + 8 * hi) : (C.out + OFF_IK_S + (size_t)(b * DS + (r32 & 7)) * 64 + 8 * hi))
    f32x4 kr[4][2];
    { const float* kp = SKP(kb0);
#pragma unroll
      for (int d0 = 0; d0 < 4; ++d0) { kr[d0][0] = *(const f32x4*)(kp + 16 * d0); kr[d0][1] = *(const f32x4*)(kp + 16 * d0 + 4); } }
    for (int kb = kb0; kb < kb1; ++kb) {
        f32x4 kn[4][2];
        { const int kbn = (kb + 1 < kb1) ? kb + 1 : kb; const float* kp = SKP(kbn);
#pragma unroll
          for (int d0 = 0; d0 < 4; ++d0) { kn[d0][0] = *(const f32x4*)(kp + 16 * d0); kn[d0][1] = *(const f32x4*)(kp + 16 * d0 + 4); } }
        bf16x8 kf[4];
#pragma unroll
        for (int d0 = 0; d0 < 4; ++d0) {
            const u32x4 pk = (u32x4){cvt_pk_bf16(kr[d0][0].x, kr[d0][0].y), cvt_pk_bf16(kr[d0][0].z, kr[d0][0].w), cvt_pk_bf16(kr[d0][1].x, kr[d0][1].y), cvt_pk_bf16(kr[d0][1].z, kr[d0][1].w)}; kf[d0] = __builtin_bit_cast(bf16x8, pk); }
#pragma unroll
        for (int nb = 0; nb < 2; ++nb) {
            f32x16 D = {};
#pragma unroll
            for (int d0 = 0; d0 < 4; ++d0) D = __builtin_amdgcn_mfma_f32_32x32x16_bf16(kf[d0], qf[nb][d0], D, 0, 0, 0);
            float s[16];
#pragma unroll
            for (int r = 0; r < 16; ++r) s[r] = dpp_sum8s(w2[nb] * __builtin_amdgcn_fmed3f(D[r], 0.f, 3.0e38f));
            if ((r32 & 7) == 0) {
                float* dst = scs + (size_t)(4 * nb + (r32 >> 3)) * SPITCH + 32 * kb + 4 * hi;
#pragma unroll
                for (int rq = 0; rq < 4; ++rq) if (32 * kb + 8 * rq + 4 * hi < PAST + DS) *(f32x4*)(dst + 8 * rq) = (f32x4){s[4 * rq], s[4 * rq + 1], s[4 * rq + 2], s[4 * rq + 3]};
            }
        }
#pragma unroll
        for (int d0 = 0; d0 < 4; ++d0) { kr[d0][0] = kn[d0][0]; kr[d0][1] = kn[d0][1]; }
    }
#undef SKP
}
__device__ __forceinline__ int mask_col(int lane) { const int p = lane >> 5, k5 = lane & 31, hi = (k5 >> 2) & 1, r = (k5 & 3) | ((k5 >> 3) << 2); return (p * 16 + r) * 2 + hi; }
template <int NI, int SHIFT, int BITS, int PSHIFT>
__device__ __forceinline__ void radix_pass(const unsigned (&v)[NI], int n, unsigned prefix, unsigned* hist, int lane, unsigned& bin_out, int& k) {
    constexpr int NBINS = 1 << BITS, BPL = NBINS / 64;
    lane = fresh_lane();
#pragma unroll
    for (int j = 0; j < BPL; ++j) hist[j * 64 + lane] = 0u;
    LDS_WAIT();
    int nn = n; asm volatile("" : "+s"(nn));
#pragma unroll
    for (int c = 0; c < NI / 8; ++c) if (c * 512 < nn) {
#pragma unroll
        for (int j = 0; j < 8; ++j) { const int i = c * 8 + j;
            const bool match = (PSHIFT >= 32) ? true : ((v[i] >> (PSHIFT & 31)) == prefix);
            if (match && (lane < nn - i * 64)) atomicAdd(&hist[(v[i] >> SHIFT) & (NBINS - 1)], 1u); }
    }
    LDS_WAIT();
    unsigned cnt = 0u;
    { constexpr int NSL = BPL / 4; const u32x4* hp = (const u32x4*)(hist + BPL * lane); const int f = (lane / (16 / NSL)) & (NSL - 1);
#pragma unroll
      for (int j = 0; j < NSL; ++j) { const u32x4 h = hp[j ^ f]; cnt += (h.x + h.y) + (h.z + h.w); } }
    unsigned S = cnt;
#pragma unroll
    for (int off = 1; off < 64; off <<= 1) { const unsigned t = __shfl_down(S, off); if (lane + off < 64) S += t; }
    const u64 bal = __ballot(S >= (unsigned)k);
    const int Ls = bal ? (63 - __clzll(bal)) : 0;
    const unsigned Sn = __shfl(S, (Ls + 1) & 63); const unsigned above = (Ls < 63) ? Sn : 0u;
    const unsigned hj = hist[BPL * Ls + (lane & (BPL - 1))];
    unsigned T = (lane < BPL) ? hj : 0u;
#pragma unroll
    for (int off = 1; off < BPL; off <<= 1) { const unsigned t = __shfl_down(T, off); if (lane + off < BPL) T += t; }
    const u64 bal2 = __ballot((lane < BPL) && (above + T >= (unsigned)k));
    const int js = bal2 ? (63 - __clzll(bal2)) : 0;
    const unsigned Tj = __shfl(T, js), hjs = __shfl(hj, js);
    LDS_WAIT();
    bin_out = (unsigned)(BPL * Ls + js); k = k - (int)(above + Tj - hjs);
}
template <int NI, bool MASK> __device__ __forceinline__ void select_row(const float* sc, int n, int* list, unsigned* hist, int lane, unsigned* maskw, int qbit) {
    lane = fresh_lane();
    if (n <= TOPK) {
#pragma unroll
        for (int i = 0; i < 4; ++i) { const int s = i * 64 + lane; if (s < n) { if (MASK) atomicOr(&maskw[i * 64 + mask_col(lane)], 1u << qbit); else list[s] = s; } }
        return;
    }
    unsigned v[NI];
    {
        lane = fresh_lane();
        int nn = n; asm volatile("" : "+s"(nn));
        const float* scl = sc + lane;
#pragma unroll
        for (int c = 0; c < NI / 16; ++c) {
            if (c * 1024 < nn) {
#pragma unroll
                for (int j = 0; j < 16; ++j) { const int i = c * 16 + j; v[i] = __float_as_uint(scl[(lane < nn - i * 64) ? i * 64 : 0]); }
            } else {
#pragma unroll
                for (int j = 0; j < 16; ++j) v[c * 16 + j] = 0u;
            }
        }
#pragma unroll
        for (int c = 0; c < NI / 16; ++c) {
            if (c * 1024 < nn) {
#pragma unroll
                for (int j = 0; j < 16; ++j) { const int i = c * 16 + j; const unsigned u = v[i]; const unsigned key = (u & 0x80000000u) ? ~u : (u | 0x80000000u); v[i] = (lane < nn - i * 64) ? key : 0u; }
            }
        }
    }
    int k = TOPK; unsigned b1, b2, b3;
    radix_pass<NI, 21, 11, 32>(v, n, 0u, hist, lane, b1, k);
    radix_pass<NI, 10, 11, 21>(v, n, b1, hist, lane, b2, k);
    radix_pass<NI, 0, 10, 10>(v, n, (b1 << 11) | b2, hist, lane, b3, k);
    const unsigned tau = (b1 << 21) | (b2 << 10) | b3;
    lane = fresh_lane();
    int nn = n; asm volatile("" : "+s"(nn));
    int base = 0, eqc = 0; const u64 ltmask = (1ull << lane) - 1ull; const int mcol = mask_col(lane);
#pragma unroll
    for (int c = 0; c < NI / 8; ++c) if (c * 512 < nn) {
#pragma unroll
        for (int j = 0; j < 8; ++j) { const int i = c * 8 + j;
            const bool inb = (lane < nn - i * 64); const bool gt = inb && (v[i] > tau), eq = inb && (v[i] == tau);
            const u64 eqb = __ballot(eq); const int erank = eqc + __popcll(eqb & ltmask);
            const bool take = gt || (eq && erank < k); eqc += __popcll(eqb);
            const u64 tb = __ballot(take); const int pos = base + __popcll(tb & ltmask);
            if (take && pos < TOPK) { if (MASK) atomicOr(&maskw[i * 64 + mcol], 1u << qbit); else list[pos] = i * 64 + lane; }
            base += __popcll(tb); }
    }
}
template <int NI, int SHIFT, int BITS, int PSHIFT>
__device__ __forceinline__ void radix_pass_p(const unsigned (&v)[NI], int nch, unsigned prefix, unsigned* hist, int lane, unsigned& bin_out, int& k, int& hcnt) {
    constexpr int NBINS = 1 << BITS, BPL = NBINS / 64;
    lane = fresh_lane();
#pragma unroll
    for (int j = 0; j < BPL; ++j) hist[j * 64 + lane] = 0u;
    LDS_WAIT();
    int nc = nch; asm volatile("" : "+s"(nc));
#pragma unroll
    for (int c = 0; c < NI / 8; ++c) if (c < nc) {
#pragma unroll
        for (int j = 0; j < 8; ++j) { const int i = c * 8 + j;
            if (PSHIFT >= 32) atomicAdd(&hist[(v[i] >> SHIFT) & (NBINS - 1)], 1u);
            else if ((v[i] >> (PSHIFT & 31)) == prefix) atomicAdd(&hist[(v[i] >> SHIFT) & (NBINS - 1)], 1u); }
    }
    if (PROBE_DUP == 33 && PSHIFT >= 32) {
#pragma unroll
        for (int c = 0; c < NI / 8; ++c) if (c < nc) {
#pragma unroll
            for (int j = 0; j < 8; ++j) { const int i = c * 8 + j; atomicSub(&hist[(v[i] >> SHIFT) & (NBINS - 1)], 1u); }
        }
#pragma unroll
        for (int c = 0; c < NI / 8; ++c) if (c < nc) {
#pragma unroll
            for (int j = 0; j < 8; ++j) { const int i = c * 8 + j; atomicAdd(&hist[(v[i] >> SHIFT) & (NBINS - 1)], 1u); }
        }
    }
    LDS_WAIT();
    unsigned cnt = 0u;
    { constexpr int NSL = BPL / 4; const u32x4* hp = (const u32x4*)(hist + BPL * lane); const int f = (lane / (16 / NSL)) & (NSL - 1);
#pragma unroll
      for (int j = 0; j < NSL; ++j) { const u32x4 h = hp[j ^ f]; cnt += (h.x + h.y) + (h.z + h.w); } }
    unsigned S = cnt;
#pragma unroll
    for (int off = 1; off < 64; off <<= 1) { const unsigned t = __shfl_down(S, off); if (lane + off < 64) S += t; }
    const u64 bal = __ballot(S >= (unsigned)k);
    const int Ls = bal ? (63 - __clzll(bal)) : 0;
    const unsigned Sn = __shfl(S, (Ls + 1) & 63); const unsigned above = (Ls < 63) ? Sn : 0u;
    const unsigned hj = hist[BPL * Ls + (lane & (BPL - 1))];
    unsigned T = (lane < BPL) ? hj : 0u;
#pragma unroll
    for (int off = 1; off < BPL; off <<= 1) { const unsigned t = __shfl_down(T, off); if (lane + off < BPL) T += t; }
    const u64 bal2 = __ballot((lane < BPL) && (above + T >= (unsigned)k));
    const int js = bal2 ? (63 - __clzll(bal2)) : 0;
    const unsigned Tj = __shfl(T, js), hjs = __shfl(hj, js);
    LDS_WAIT();
    bin_out = (unsigned)(BPL * Ls + js); hcnt = (int)hjs; k = k - (int)(above + Tj - hjs);
}
template <int NI> __device__ __forceinline__ void select_row_p(const float* sc, int n, unsigned* hist, unsigned* maskw, int qbit) {
    int lane = fresh_lane();
    if (n <= TOPK) {
#pragma unroll
        for (int i = 0; i < 4; ++i) { const int s = i * 64 + lane; if (s < n) atomicOr(&maskw[i * 64 + mask_col(lane)], 1u << qbit); }
        return;
    }
    const int nch = (n + 511) >> 9;
    unsigned v[NI];
    {
        int nc = nch; asm volatile("" : "+s"(nc));
        const float* scl = sc + lane;
#pragma unroll
        for (int c = 0; c < NI / 8; ++c) {
            if (c < nc) {
#pragma unroll
                for (int j = 0; j < 8; ++j) { const int i = c * 8 + j; v[i] = __float_as_uint(scl[i * 64]); }
            } else {
#pragma unroll
                for (int j = 0; j < 8; ++j) v[c * 8 + j] = 0u;
            }
        }
    }
    int k = TOPK, hc = 0; unsigned b1, b2 = 0u, b3 = 0u; unsigned tau; bool exact;
    radix_pass_p<NI, 21, 11, 32>(v, nch, 0u, hist, lane, b1, k, hc);
    tau = b1 << 21; exact = (hc == k);
    if (!exact) {
        radix_pass_p<NI, 10, 11, 21>(v, nch, b1, hist, lane, b2, k, hc);
        tau = (b1 << 21) | (b2 << 10); exact = (hc == k);
        if (!exact) { radix_pass_p<NI, 0, 10, 10>(v, nch, (b1 << 11) | b2, hist, lane, b3, k, hc); tau = (b1 << 21) | (b2 << 10) | b3; exact = (hc == k); }
    }
    lane = fresh_lane();
    int nc = nch; asm volatile("" : "+s"(nc));
    const int mcol = mask_col(lane);
    if (exact) {
#pragma unroll
        for (int c = 0; c < NI / 8; ++c) if (c < nc) {
#pragma unroll
            for (int j = 0; j < 8; ++j) { const int i = c * 8 + j; if (v[i] >= tau) atomicOr(&maskw[i * 64 + mcol], 1u << qbit); }
        }
    } else {
        int eqc = 0; const u64 ltmask = (1ull << lane) - 1ull;
#pragma unroll
        for (int c = 0; c < NI / 8; ++c) if (c < nc) {
#pragma unroll
            for (int j = 0; j < 8; ++j) { const int i = c * 8 + j;
                const bool gt = v[i] > tau, eq = v[i] == tau;
                const u64 eqb = __ballot(eq); const int erank = eqc + __popcll(eqb & ltmask); eqc += __popcll(eqb);
                if (gt || (eq && erank < k)) atomicOr(&maskw[i * 64 + mcol], 1u << qbit); }
        }
    }
}
__device__ __forceinline__ void select_group_prompt(const Ctx& C, int b, int g, unsigned char* lds) {
    unsigned* hist = (unsigned*)lds + C.wave * 2048; unsigned* maskw = (unsigned*)(lds + 65536);
    { const int tid0 = C.wave * 64 + fresh_lane();
#pragma unroll
      for (int j = 0; j < 16; ++j) maskw[tid0 + 512 * j] = 0u; }
    __syncthreads();
#pragma unroll 1
    for (int j = 0; j < 4; ++j) {
        const int q = C.wave + 8 * j, t = 32 * g + q, ru = b * SEQ + t;
        select_row_p<128>((const float*)(C.ws + WS_SC) + (size_t)ru * SEQ, t + 1, hist, maskw, q);
    }
    __syncthreads();
    const int ntile = 4 * ((g >> 3) + 1);
    u32x4* dst = (u32x4*)((u64*)(C.ws + WS_MASK) + (size_t)(b * 256 + g) * (128 * 32));
    for (int i = C.wave * 64 + fresh_lane(); i < ntile * 16; i += NTHREADS) dst[i] = *(const u32x4*)(maskw + 4 * i);
    __syncthreads();
}
constexpr int CONV_CHUNK = 4096, NCONV = (MT * 64 + CONV_CHUNK - 1) / CONV_CHUNK;
__device__ __forceinline__ void conv_mix_branch(const Ctx& C, int chunk) {
    const int tid2 = C.wave * 64 + fresh_lane();
    const int gt = chunk * CONV_CHUNK + tid2, NGT = NTHREADS, itEnd = (chunk + 1) * CONV_CHUNK;
    const bf16_t* ub = (const bf16_t*)(C.ws + WS_U); const bf16_t* cbb = (const bf16_t*)(C.ws + WS_CB); bf16_t* amix = (bf16_t*)(C.ws + WS_AMIX);
    for (int it0 = gt; it0 < itEnd; it0 += 4 * NGT) {
        u32x4 ru0[4], rp1[4], rp2[4], rcb[4]; f32x4 fp1[4][2], fp2[4][2]; bool ok[4], s1[4], s2[4];
#pragma unroll
        for (int q = 0; q < 4; ++q) { const int it = it0 + q * NGT; ok[q] = it < MT * 64; const int itc = ok[q] ? it : 0; const int r = itc >> 6, c = (itc & 63) * 8;
            ru0[q] = *(const u32x4*)(ub + (size_t)r * 512 + c); rcb[q] = *(const u32x4*)(cbb + (size_t)r * 512 + c);
            int t; bool smp = r >= MP; int b = 0;
            if (!smp) t = r & (SEQ - 1); else { const int rl = r - MP; b = rl >> 3; t = rl & 7; }
            s1[q] = smp && t < 1; s2[q] = smp && t < 2;
            rp1[q] = (t >= 1) ? *(const u32x4*)(ub + (size_t)(r - 1) * 512 + c) : (u32x4){0u, 0u, 0u, 0u};
            rp2[q] = (t >= 2) ? *(const u32x4*)(ub + (size_t)(r - 2) * 512 + c) : (u32x4){0u, 0u, 0u, 0u};
            if (s1[q]) { const float* sp = C.st_mix + (size_t)(b * 2 + 1) * 512 + c; fp1[q][0] = *(const f32x4*)sp; fp1[q][1] = *(const f32x4*)(sp + 4); }
            if (s2[q]) { const float* sp = C.st_mix + (size_t)(b * 2 + t) * 512 + c; fp2[q][0] = *(const f32x4*)sp; fp2[q][1] = *(const f32x4*)(sp + 4); } }
#pragma unroll
        for (int q = 0; q < 4; ++q) if (ok[q]) { const int it = it0 + q * NGT; const int r = it >> 6, c = (it & 63) * 8;
            float u0[8], p1[8], p2[8], cb[8], w0[8], w1[8], w2[8], y[8];
            const u32x4 a = ru0[q], bq = rcb[q], c1 = rp1[q], c2 = rp2[q];
            u0[0] = bf2f(a.x & 0xffffu); u0[1] = bf2f(a.x >> 16); u0[2] = bf2f(a.y & 0xffffu); u0[3] = bf2f(a.y >> 16); u0[4] = bf2f(a.z & 0xffffu); u0[5] = bf2f(a.z >> 16); u0[6] = bf2f(a.w & 0xffffu); u0[7] = bf2f(a.w >> 16);
            cb[0] = bf2f(bq.x & 0xffffu); cb[1] = bf2f(bq.x >> 16); cb[2] = bf2f(bq.y & 0xffffu); cb[3] = bf2f(bq.y >> 16); cb[4] = bf2f(bq.z & 0xffffu); cb[5] = bf2f(bq.z >> 16); cb[6] = bf2f(bq.w & 0xffffu); cb[7] = bf2f(bq.w >> 16);
            p1[0] = bf2f(c1.x & 0xffffu); p1[1] = bf2f(c1.x >> 16); p1[2] = bf2f(c1.y & 0xffffu); p1[3] = bf2f(c1.y >> 16); p1[4] = bf2f(c1.z & 0xffffu); p1[5] = bf2f(c1.z >> 16); p1[6] = bf2f(c1.w & 0xffffu); p1[7] = bf2f(c1.w >> 16);
            p2[0] = bf2f(c2.x & 0xffffu); p2[1] = bf2f(c2.x >> 16); p2[2] = bf2f(c2.y & 0xffffu); p2[3] = bf2f(c2.y >> 16); p2[4] = bf2f(c2.z & 0xffffu); p2[5] = bf2f(c2.z >> 16); p2[6] = bf2f(c2.w & 0xffffu); p2[7] = bf2f(c2.w >> 16);
            if (s1[q]) { p1[0] = fp1[q][0].x; p1[1] = fp1[q][0].y; p1[2] = fp1[q][0].z; p1[3] = fp1[q][0].w; p1[4] = fp1[q][1].x; p1[5] = fp1[q][1].y; p1[6] = fp1[q][1].z; p1[7] = fp1[q][1].w; }
            if (s2[q]) { p2[0] = fp2[q][0].x; p2[1] = fp2[q][0].y; p2[2] = fp2[q][0].z; p2[3] = fp2[q][0].w; p2[4] = fp2[q][1].x; p2[5] = fp2[q][1].y; p2[6] = fp2[q][1].z; p2[7] = fp2[q][1].w; }
            load8_f32(C.conv_mix_w + c, w0); load8_f32(C.conv_mix_w + 512 + c, w1); load8_f32(C.conv_mix_w + 1024 + c, w2);
#pragma unroll
            for (int e2 = 0; e2 < 8; ++e2) y[e2] = cb[e2] * (w0[e2] * p2[e2] + w1[e2] * p1[e2] + w2[e2] * u0[e2]);
            store8_bf16(amix + (size_t)r * 1024 + c, y); }
    }
}

__device__ __forceinline__ int queue_pop(unsigned* q, volatile LAS unsigned* slot) {
    __syncthreads();
    if (threadIdx.x == 0) *slot = xb_add(q, 1u);
    __syncthreads();
    return __builtin_amdgcn_readfirstlane((int)*slot);
}
__device__ __forceinline__ void ph2_scores_select(const Ctx& C, unsigned char* lds, unsigned* q, volatile LAS unsigned* slot) {
    for (;;) {
        const int it = queue_pop(q, slot);
        if (it >= DB + 512 + NCONV + NMEMP) break;
        if (it < DB) {
            const int bt = it;
            score_unit_sample(C, bt, 2 * C.wave); score_unit_sample(C, bt, 2 * C.wave + 1);
            asm volatile("s_waitcnt vmcnt(0)" ::: "memory");
            __syncthreads();
            const int rl = bt * DS + C.wave;
            select_row<48, false>((const float*)(C.ws + WS_SCS) + (size_t)rl * SPITCH, PAST + C.wave + 1, (int*)(C.ws + WS_SEL) + (size_t)(MP + rl) * TOPK, (unsigned*)lds + C.wave * 2048, 0, nullptr, 0);
        } else if (it < DB + 512) {
            const int j = it - DB, b = j & 1, g = 255 - (j >> 1);
            score_unit_prompt(C, b, g, lds); if (PROBE_DUP == 12) score_unit_prompt(C, b, g, lds);
            select_group_prompt(C, b, g, lds); if (PROBE_DUP == 13) select_group_prompt(C, b, g, lds);
        } else if (it < DB + 512 + NCONV) conv_mix_branch(C, it - DB - 512);
        else ph2_memprep(C, it - DB - 512 - NCONV);
    }
}

template <bool SAMP> __device__ __forceinline__ void attn_gather_row(const Ctx& C, int r, int lane) {
    const int rl = SAMP ? r - MP : r; const int b = SAMP ? (rl >> 3) : (rl >> 13);
    const int n = SAMP ? PAST + (rl & 7) + 1 : (rl & (SEQ - 1)) + 1; const int cnt = n < TOPK ? n : TOPK;
    const int* __restrict__ list = (const int*)(C.ws + WS_SEL) + (size_t)r * TOPK;
    float q[8]; load8_bf16((const bf16_t*)(C.ws + WS_Q) + (size_t)r * 512 + lane * 8, q);
    float mrun = -INFINITY, l = 0.f, o[8];
#pragma unroll
    for (int e = 0; e < 8; ++e) o[e] = 0.f;
    for (int j0 = 0; j0 < cnt; j0 += 4) {
        float kk[4][8], vv[4][8];
#pragma unroll
        for (int u = 0; u < 4; ++u) {
            const int j = (j0 + u < cnt) ? j0 + u : j0; const int s = list[j];
            if (SAMP) {
                const float *kp, *vp;
                if (s < PAST) { const size_t ro = ((size_t)C.page_table[b * NPAGES + (s >> 7)] * PAGE + (s & (PAGE - 1))) * 512 + lane * 8; kp = C.cache_k + ro; vp = C.cache_v + ro; }
                else { const size_t ro = (size_t)(b * DS + (s - PAST)) * 512 + lane * 8; kp = C.out + OFF_K_S + ro; vp = C.out + OFF_V_S + ro; }
                load8_f32(kp, kk[u]); load8_f32(vp, vv[u]);
            } else {
                const size_t ro = (size_t)(b * SEQ + s) * 512 + lane * 8;
                load8_bf16((const bf16_t*)(C.ws + WS_K) + ro, kk[u]); load8_bf16((const bf16_t*)(C.ws + WS_V) + ro, vv[u]);
            }
        }
#pragma unroll
        for (int u = 0; u < 4; ++u) if (j0 + u < cnt) {
            float d = 0.f;
#pragma unroll
            for (int e = 0; e < 8; ++e) d = fmaf(q[e], kk[u][e], d);
            d += __shfl_xor(d, 1); d += __shfl_xor(d, 2); d += __shfl_xor(d, 4);
            const float mn = fmaxf(mrun, d); const float corr = __builtin_amdgcn_exp2f(mrun - mn), p = __builtin_amdgcn_exp2f(d - mn);
            l = l * corr + p;
#pragma unroll
            for (int e = 0; e < 8; ++e) o[e] = o[e] * corr + p * vv[u][e];
            mrun = mn;
        }
    }
    const float il = 1.0f / l;
#pragma unroll
    for (int e = 0; e < 8; ++e) o[e] *= il;
    store8_bf16((bf16_t*)(C.ws + WS_AMIX) + (size_t)r * 1024 + 512 + lane * 8, o);
}
__device__ __forceinline__ float dpp_sum8(float x) {
    x += __builtin_bit_cast(float, __builtin_amdgcn_update_dpp(0, __builtin_bit_cast(int, x), 0xB1, 0xF, 0xF, true));
    x += __builtin_bit_cast(float, __builtin_amdgcn_update_dpp(0, __builtin_bit_cast(int, x), 0x4E, 0xF, 0xF, true));
    x += __builtin_bit_cast(float, __builtin_amdgcn_update_dpp(0, __builtin_bit_cast(int, x), 0x141, 0xF, 0xF, true));
    return x;
}
__device__ __forceinline__ void gather_half(const Ctx& C, int r, int hf, int lane, float* part) {
    const int rl = r - MP, b = rl >> 3;
    const int* list = (const int*)(C.ws + WS_SEL) + (size_t)r * TOPK + 128 * hf;
    int rowid[2];
#pragma unroll
    for (int c = 0; c < 2; ++c) { const int s = list[64 * c + lane];
        rowid[c] = (s < PAST) ? (C.page_table[b * NPAGES + (s >> 7)] * PAGE + (s & (PAGE - 1))) : (0x40000000 | (b * DS + (s - PAST))); }
    float q[8]; load8_bf16((const bf16_t*)(C.ws + WS_Q) + (size_t)r * 512 + lane * 8, q);
    float mrun = -1e30f, l = 0.f, o[8];
#pragma unroll
    for (int e = 0; e < 8; ++e) o[e] = 0.f;
    const float* newK = C.out + OFF_K_S; const float* newV = C.out + OFF_V_S;
#define G_LOAD(KK, VV, c_, j_) do { _Pragma("unroll") for (int u = 0; u < 4; ++u) { \
        const int id = __builtin_amdgcn_readlane(rowid[c_], (j_) + u); const bool isnew = (id >> 30) != 0; const size_t ro = (size_t)(id & 0x3FFFFFFF) * 512; \
        const float* kp = (isnew ? newK : C.cache_k) + ro + lane * 8; const float* vp = (isnew ? newV : C.cache_v) + ro + lane * 8; \
        load8_f32(kp, KK[u]); load8_f32(vp, VV[u]); } } while (0)
#define G_FOLD(KK, VV) do { float d[4]; float mx = mrun; \
        _Pragma("unroll") for (int u = 0; u < 4; ++u) { float t = 0.f; _Pragma("unroll") for (int e = 0; e < 8; ++e) t = fmaf(q[e], KK[u][e], t); d[u] = dpp_sum8(t); mx = fmaxf(mx, d[u]); } \
        const float corr = __builtin_amdgcn_exp2f(mrun - mx); l *= corr; \
        _Pragma("unroll") for (int e = 0; e < 8; ++e) o[e] *= corr; \
        _Pragma("unroll") for (int u = 0; u < 4; ++u) { const float p = __builtin_amdgcn_exp2f(d[u] - mx); l += p; _Pragma("unroll") for (int e = 0; e < 8; ++e) o[e] = fmaf(p, VV[u][e], o[e]); } \
        mrun = mx; } while (0)
#pragma unroll
    for (int c = 0; c < 2; ++c) {
        float ka[4][8], va[4][8], kb[4][8], vb[4][8];
        G_LOAD(ka, va, c, 0);
#pragma unroll 1
        for (int j0 = 0; j0 < 64; j0 += 8) {
            G_LOAD(kb, vb, c, j0 + 4);
            G_FOLD(ka, va);
            if (j0 + 8 < 64) G_LOAD(ka, va, c, j0 + 8);
            G_FOLD(kb, vb);
        }
    }
#undef G_LOAD
#undef G_FOLD
    part[lane * 10] = mrun; part[lane * 10 + 1] = l;
#pragma unroll
    for (int e = 0; e < 8; ++e) part[lane * 10 + 2 + e] = o[e];
}
struct AttnOrder {
    int v, i0, n;
    __device__ __forceinline__ bool next(int i, attn_body::AttnUnit& u) const { if (i >= n) return false; const int s = v & 15; u.bh = v >> 4; u.qb = (i0 + i == 0) ? s : 31 - s; return true; }
    __device__ __forceinline__ void a_ready(const attn_body::AttnUnit&) const {}
    __device__ __forceinline__ void done(const attn_body::AttnUnit&) const {}
};
__device__ __forceinline__ void ph4_gather_unit(const Ctx& C, int u, unsigned char* lds, int lane2) {
    const int batch = (u & 7) + 8 * (u >> 4), r = MP + batch * DS + 4 * ((u >> 3) & 1) + (C.wave & 3), hf = C.wave >> 2;
    float* part = (float*)lds + C.wave * 640;
    __syncthreads();
    gather_half(C, r, hf, lane2, part);
    __syncthreads();
    if (C.wave < 4) {
        const float* p0 = part + lane2 * 10; const float* p1 = p0 + 4 * 640;
        const float m0 = p0[0], m1 = p1[0], m = fmaxf(m0, m1), c0 = __builtin_amdgcn_exp2f(m0 - m), c1 = __builtin_amdgcn_exp2f(m1 - m);
        const float il = 1.0f / (p0[1] * c0 + p1[1] * c1); float o[8];
#pragma unroll
        for (int e = 0; e < 8; ++e) o[e] = (p0[2 + e] * c0 + p1[2 + e] * c1) * il;
        store8_bf16((bf16_t*)(C.ws + WS_AMIX) + (size_t)r * 1024 + 512 + lane2 * 8, o);
    }
    __syncthreads();
}
__device__ __forceinline__ void ph4_attn_conv(const Ctx& C, unsigned char* lds) {
    const attn_body::AttnTensors AT{(const attn_body::bf16*)(C.ws + WS_Q), (const attn_body::bf16*)(C.ws + WS_K), (const attn_body::bf16*)(C.ws + WS_V),
                                    (attn_body::bf16*)(C.ws + WS_AMIX) + 512, (const u64*)(C.ws + WS_MASK), C.wave};
    const int vcu = (C.G % 8 == 0) ? (C.bid % 8) * (C.G / 8) + C.bid / 8 : C.bid;
    const int mode = (C.bid >> 4) % 3;
    for (int v = vcu, u = C.bid; v < 256; v += C.G, u += C.G) {
        if (mode == 0) ph4_gather_unit(C, u, lds, fresh_lane());
        { const AttnOrder S{v, 0, 1}; attn_body::attn_phase<AttnOrder>((char*)lds, AT, S); }
        if (mode == 1) ph4_gather_unit(C, u, lds, fresh_lane());
        { const AttnOrder S{v, 1, 1}; attn_body::attn_phase<AttnOrder>((char*)lds, AT, S); }
        if (mode == 2) ph4_gather_unit(C, u, lds, fresh_lane());
        if (PROBE_DUP == 24) ph4_gather_unit(C, u, lds, fresh_lane());
    }
}

typedef __bf16 bf16x2_t __attribute__((ext_vector_type(2)));
__device__ __forceinline__ float dot2bf(unsigned a, unsigned b, float c) { return __builtin_amdgcn_fdot2_f32_bf16(__builtin_bit_cast(bf16x2_t, a), __builtin_bit_cast(bf16x2_t, b), c, false); }
__device__ __forceinline__ float dpp_sum16(float x) {
    x += __builtin_bit_cast(float, __builtin_amdgcn_update_dpp(0, __builtin_bit_cast(int, x), 0xB1, 0xF, 0xF, true));
    x += __builtin_bit_cast(float, __builtin_amdgcn_update_dpp(0, __builtin_bit_cast(int, x), 0x4E, 0xF, 0xF, true));
    x += __builtin_bit_cast(float, __builtin_amdgcn_update_dpp(0, __builtin_bit_cast(int, x), 0x141, 0xF, 0xF, true));
    x += __builtin_bit_cast(float, __builtin_amdgcn_update_dpp(0, __builtin_bit_cast(int, x), 0x140, 0xF, 0xF, true));
    return x;
}
__device__ __forceinline__ void memattn_unit(const Ctx& C, int r0, const float* kp0, const float* vp0, unsigned char* lds, int lane) {
    const int w = C.wave, h = lane >> 4;
    float* logits = (float*)lds;
    const bf16_t* qmem = (const bf16_t*)(C.ws + WS_QMEM); const float* ssq = (const float*)(C.ws + ACC_SSQ);
    {
        unsigned q[8][8]; float rsq[8];
#pragma unroll
        for (int qi = 0; qi < 8; ++qi) { const u32x4 a = *(const u32x4*)(qmem + (size_t)(r0 + qi) * 1024 + lane * 16), bq = *(const u32x4*)(qmem + (size_t)(r0 + qi) * 1024 + lane * 16 + 8);
            q[qi][0] = a.x; q[qi][1] = a.y; q[qi][2] = a.z; q[qi][3] = a.w; q[qi][4] = bq.x; q[qi][5] = bq.y; q[qi][6] = bq.z; q[qi][7] = bq.w;
            rsq[qi] = (1.0f / sqrtf(ssq[(r0 + qi) * 4 + h] * (1.f / 256.f) + EPS)) * (0.0625f * 1.4426950408889634f); }
        const float* kbase = kp0 + (size_t)(32 * w) * 1024 + lane * 16;
#pragma unroll 1
        for (int mb = 0; mb < 8; ++mb) {
            f32x4 kr[4][4];
#pragma unroll
            for (int u = 0; u < 4; ++u)
#pragma unroll
                for (int j = 0; j < 4; ++j) kr[u][j] = *(const f32x4*)(kbase + (size_t)(mb * 4 + u) * 1024 + 4 * j);
#pragma unroll
            for (int u = 0; u < 4; ++u) {
                unsigned kb[8];
#pragma unroll
                for (int j = 0; j < 4; ++j) { kb[2 * j] = cvt_pk_bf16(kr[u][j].x, kr[u][j].y); kb[2 * j + 1] = cvt_pk_bf16(kr[u][j].z, kr[u][j].w); }
                const int m = 32 * w + mb * 4 + u;
#pragma unroll
                for (int qi = 0; qi < 8; ++qi) {
                    float p = 0.f;
#pragma unroll
                    for (int e = 0; e < 8; ++e) p = dot2bf(q[qi][e], kb[e], p);
                    p = dpp_sum16(p);
                    if ((lane & 15) == 0) logits[(qi * 4 + h) * 256 + m] = p * rsq[qi];
                }
            }
        }
    }
    __syncthreads();
#pragma unroll
    for (int rr = 0; rr < 4; ++rr) {
        float* row = logits + (4 * w + rr) * 256; float x[4]; float mx = -INFINITY;
#pragma unroll
        for (int j = 0; j < 4; ++j) { x[j] = row[lane + 64 * j]; mx = fmaxf(mx, x[j]); }
        mx = wave_max(mx); float s = 0.f;
#pragma unroll
        for (int j = 0; j < 4; ++j) { x[j] = __builtin_amdgcn_exp2f(x[j] - mx); s += x[j]; }
        s = wave_sum(s); const float is = 1.0f / s;
#pragma unroll
        for (int j = 0; j < 4; ++j) row[lane + 64 * j] = x[j] * is;
    }
    __syncthreads();
    {
        const int hw = w >> 1;
        float acc[8][2];
#pragma unroll
        for (int qi = 0; qi < 8; ++qi) { acc[qi][0] = 0.f; acc[qi][1] = 0.f; }
        const float* vbase = vp0 + 128 * w + 2 * lane;
        float2 va[16];
#pragma unroll
        for (int u = 0; u < 16; ++u) va[u] = *(const float2*)(vbase + (size_t)u * 1024);
#pragma unroll 1
        for (int m0 = 0; m0 < 256; m0 += 16) {
            float2 vb[16];
            const int mn = (m0 + 16 < 256) ? m0 + 16 : m0;
#pragma unroll
            for (int u = 0; u < 16; ++u) vb[u] = *(const float2*)(vbase + (size_t)(mn + u) * 1024);
#pragma unroll
            for (int hf = 0; hf < 2; ++hf) {
#pragma unroll
                for (int qi = 0; qi < 8; ++qi) {
                    const float* pr = logits + (qi * 4 + hw) * 256 + m0 + 8 * hf;
                    const f32x4 p0 = *(const f32x4*)pr, p1 = *(const f32x4*)(pr + 4);
                    acc[qi][0] = fmaf(p0.x, va[8 * hf + 0].x, acc[qi][0]); acc[qi][1] = fmaf(p0.x, va[8 * hf + 0].y, acc[qi][1]);
                    acc[qi][0] = fmaf(p0.y, va[8 * hf + 1].x, acc[qi][0]); acc[qi][1] = fmaf(p0.y, va[8 * hf + 1].y, acc[qi][1]);
                    acc[qi][0] = fmaf(p0.z, va[8 * hf + 2].x, acc[qi][0]); acc[qi][1] = fmaf(p0.z, va[8 * hf + 2].y, acc[qi][1]);
                    acc[qi][0] = fmaf(p0.w, va[8 * hf + 3].x, acc[qi][0]); acc[qi][1] = fmaf(p0.w, va[8 * hf + 3].y, acc[qi][1]);
                    acc[qi][0] = fmaf(p1.x, va[8 * hf + 4].x, acc[qi][0]); acc[qi][1] = fmaf(p1.x, va[8 * hf + 4].y, acc[qi][1]);
                    acc[qi][0] = fmaf(p1.y, va[8 * hf + 5].x, acc[qi][0]); acc[qi][1] = fmaf(p1.y, va[8 * hf + 5].y, acc[qi][1]);
                    acc[qi][0] = fmaf(p1.z, va[8 * hf + 6].x, acc[qi][0]); acc[qi][1] = fmaf(p1.z, va[8 * hf + 6].y, acc[qi][1]);
                    acc[qi][0] = fmaf(p1.w, va[8 * hf + 7].x, acc[qi][0]); acc[qi][1] = fmaf(p1.w, va[8 * hf + 7].y, acc[qi][1]);
                }
                __builtin_amdgcn_sched_barrier(0);
            }
#pragma unroll
            for (int u = 0; u < 16; ++u) va[u] = vb[u];
        }
        bf16_t* op = (bf16_t*)(C.ws + WS_OMEM) + (size_t)r0 * 1024 + 128 * w + 2 * lane;
#pragma unroll
        for (int qi = 0; qi < 8; ++qi) *(unsigned*)(op + (size_t)qi * 1024) = cvt_pk_bf16(acc[qi][0], acc[qi][1]);
    }
    __syncthreads();
}
__device__ __forceinline__ void memattn_unit_mfma(const Ctx& C, int qg, int h, int lane) {
    const int r32 = lane & 31, hi = lane >> 5; const int b = qg >> 8; const int row = 32 * qg + r32;
    const bf16_t* qp = (const bf16_t*)(C.ws + WS_QMEM) + (size_t)row * 1024 + h * 256 + hi * 8;
    bf16x8 qf[16];
#pragma unroll
    for (int ks = 0; ks < 16; ++ks) qf[ks] = *(const bf16x8*)(qp + ks * 16);
    const float c = (1.0f / sqrtf(((const float*)(C.ws + ACC_SSQ))[row * 4 + h] * (1.f / 256.f) + EPS)) * (0.0625f * 1.4426950408889634f);
    const bf16x8* kF = (const bf16x8*)(C.ws + WS_MKF) + (size_t)((b * 4 + h) * 8 * 16) * 64 + lane;
    f32x16 S[8];
#pragma unroll
    for (int mb = 0; mb < 8; ++mb) {
        S[mb] = f32x16{};
#pragma unroll
        for (int kh = 0; kh < 2; ++kh) {
            bf16x8 kf[8];
#pragma unroll
            for (int k8 = 0; k8 < 8; ++k8) kf[k8] = kF[(size_t)(mb * 16 + kh * 8 + k8) * 64];
            __builtin_amdgcn_sched_barrier(0);
#pragma unroll
            for (int k8 = 0; k8 < 8; ++k8) S[mb] = __builtin_amdgcn_mfma_f32_32x32x16_bf16(kf[k8], qf[kh * 8 + k8], S[mb], 0, 0, 0);
            __builtin_amdgcn_sched_barrier(0);
        }
    }
    float mx = -INFINITY;
#pragma unroll
    for (int mb = 0; mb < 8; ++mb)
#pragma unroll
        for (int r = 0; r < 16; ++r) mx = fmaxf(mx, S[mb][r]);
    mx = fmaxf(mx, __shfl_xor(mx, 32));
    const float mc = mx * c; float sum = 0.f;
    unsigned pk[8][2][4];
#pragma unroll
    for (int mb = 0; mb < 8; ++mb) {
        float p[16];
#pragma unroll
        for (int r = 0; r < 16; ++r) { p[r] = __builtin_amdgcn_exp2f(S[mb][r] * c - mc); sum += p[r]; }
#pragma unroll
        for (int s = 0; s < 2; ++s)
#pragma unroll
            for (int j = 0; j < 4; ++j) pk[mb][s][j] = cvt_pk_bf16(p[8 * s + 2 * j], p[8 * s + 2 * j + 1]);
    }
    sum += __shfl_xor(sum, 32); const float inv = 1.0f / sum;
    const bf16x8* vF = (const bf16x8*)(C.ws + WS_MVF) + (size_t)((b * 4 + h) * 8 * 16) * 64 + lane;
    bf16_t* op = (bf16_t*)(C.ws + WS_OMEM) + (size_t)row * 1024 + h * 256 + 4 * hi;
#pragma unroll
    for (int db = 0; db < 8; ++db) {
        f32x16 O = f32x16{};
#pragma unroll
        for (int mh = 0; mh < 2; ++mh) {
            bf16x8 vf[8];
#pragma unroll
            for (int k8 = 0; k8 < 8; ++k8) vf[k8] = vF[(size_t)(db * 16 + mh * 8 + k8) * 64];
            __builtin_amdgcn_sched_barrier(0);
#pragma unroll
            for (int k8 = 0; k8 < 8; ++k8) { const int mb = mh * 4 + (k8 >> 1), s = k8 & 1;
                const u32x4 pw = (u32x4){pk[mb][s][0], pk[mb][s][1], pk[mb][s][2], pk[mb][s][3]};
                O = __builtin_amdgcn_mfma_f32_32x32x16_bf16(vf[k8], __builtin_bit_cast(bf16x8, pw), O, 0, 0, 0); }
            __builtin_amdgcn_sched_barrier(0);
        }
#pragma unroll
        for (int rq = 0; rq < 4; ++rq) {
            const unsigned w0 = cvt_pk_bf16(O[4 * rq] * inv, O[4 * rq + 1] * inv), w1 = cvt_pk_bf16(O[4 * rq + 2] * inv, O[4 * rq + 3] * inv);
            *(u64*)(op + 32 * db + 8 * rq) = (u64)w0 | ((u64)w1 << 32);
        }
    }
}
__device__ __forceinline__ void ph7_memattn(const Ctx& C, unsigned char* lds, unsigned* q, volatile LAS unsigned* slot) {
    for (;;) {
        const int it = queue_pop(q, slot);
        if (it >= DB + 256) break;
        if (it < DB) { const int r0 = MP + it * 8; memattn_unit(C, r0, C.cmem_k + (size_t)it * 262144, C.cmem_v + (size_t)it * 262144, lds, fresh_lane()); }
        else { const int uu = __builtin_amdgcn_readfirstlane((it - DB) * NWAVES + C.wave); memattn_unit_mfma(C, uu >> 2, uu & 3, fresh_lane()); }
    }
}

__device__ __forceinline__ void ph10_ffn_act(const Ctx& C) {
    const int gt = C.bid * NTHREADS + C.tid, NGT = C.G * NTHREADS;
    const float* G = (const float*)(C.ws + WS_G); const bf16_t* UP = (const bf16_t*)(C.ws + WS_UP); bf16_t* aff = (bf16_t*)(C.ws + WS_AFF);
    constexpr int CG = DFF / 8;
    for (int it = gt; it < MT * CG; it += NGT) {
        const int r = it / CG, c = (it - r * CG) * 8;
        float g0[8], p1[8], p2[8], up[8], w0[8], w1[8], w2[8], bb[8], y[8];
        load8_f32(G + (size_t)r * DFF + c, g0); load8_bf16(UP + (size_t)r * DFF + c, up);
        load8_f32(C.conv_ffn_w + c, w0); load8_f32(C.conv_ffn_w + DFF + c, w1); load8_f32(C.conv_ffn_w + 2 * DFF + c, w2); load8_f32(C.conv_ffn_b + c, bb);
        if (r < MP) {
            const int t = r & (SEQ - 1), b = r >> 13;
            if (t >= 1) load8_f32(G + (size_t)(r - 1) * DFF + c, p1); else { for (int e = 0; e < 8; ++e) p1[e] = 0.f; }
            if (t >= 2) load8_f32(G + (size_t)(r - 2) * DFF + c, p2); else { for (int e = 0; e < 8; ++e) p2[e] = 0.f; }
            if (t >= SEQ - 2) store8_f32(C.out + OFF_CF_P + (size_t)(b * 2 + (t - (SEQ - 2))) * DFF + c, g0);
        } else {
            const int rl = r - MP, b = rl >> 3, tt = rl & 7;
            if (tt >= 1) load8_f32(G + (size_t)(r - 1) * DFF + c, p1); else load8_f32(C.st_ffn + (size_t)(b * 2 + 1) * DFF + c, p1);
            if (tt >= 2) load8_f32(G + (size_t)(r - 2) * DFF + c, p2); else load8_f32(C.st_ffn + (size_t)(b * 2 + tt) * DFF + c, p2);
            if (tt >= 6) store8_f32(C.out + OFF_CF_S + (size_t)(b * 2 + (tt - 6)) * DFF + c, g0);
        }
#pragma unroll
        for (int e = 0; e < 8; ++e) { const float z = w0[e] * p2[e] + w1[e] * p1[e] + w2[e] * g0[e] + bb[e]; y[e] = (z / (1.0f + __expf(-z))) * up[e]; }
        store8_bf16(aff + (size_t)r * DFF + c, y);
    }
}

__device__ __forceinline__ void memattn_tile_lds(const Ctx& C, int pm, int h, unsigned char* lds) {
    const int lane = fresh_lane(), tid = C.wave * 64 + lane, r32 = lane & 31, hi = lane >> 5; const int b = pm >> 5; const int row = 256 * pm + 32 * C.wave + r32;
    LAS unsigned char* ldsl = (LAS unsigned char*)lds;
    const u32x4* kG = (const u32x4*)(C.ws + WS_MKF) + (size_t)((b * 4 + h) * 8 * 16) * 64;
    const u32x4* vG = (const u32x4*)(C.ws + WS_MVF) + (size_t)((b * 4 + h) * 8 * 16) * 64;
#pragma unroll 1
    for (int i0 = 0; i0 < 16; i0 += 8) { u32x4 t[8];
#pragma unroll
      for (int i = 0; i < 8; ++i) t[i] = kG[(i0 + i) * 512 + tid];
#pragma unroll
      for (int i = 0; i < 8; ++i) *(LAS u32x4*)(ldsl + (size_t)((i0 + i) * 512 + tid) * 16) = t[i]; }
    __builtin_amdgcn_sched_barrier(0);
    const bf16_t* qp = (const bf16_t*)(C.ws + WS_QMEM) + (size_t)row * 1024 + h * 256 + hi * 8;
    bf16x8 qf[16];
#pragma unroll
    for (int ks = 0; ks < 16; ++ks) qf[ks] = *(const bf16x8*)(qp + ks * 16);
    const float c = (1.0f / sqrtf(((const float*)(C.ws + ACC_SSQ))[row * 4 + h] * (1.f / 256.f) + EPS)) * (0.0625f * 1.4426950408889634f);
    __syncthreads();
    const LAS unsigned char* fL0 = ldsl + lane * 16; const LAS unsigned char* fL1 = fL0 + 65536;
#define FRAG(f) (*(const LAS bf16x8*)(((f) < 64 ? fL0 : fL1) + ((f) & 63) * 1024))
    float sum = 0.f;
    unsigned pk[8][2][4];
#pragma unroll
    for (int mb = 0; mb < 8; ++mb) {
        f32x16 S = f32x16{};
#pragma unroll
        for (int kh = 0; kh < 2; ++kh) {
            bf16x8 kf[8];
#pragma unroll
            for (int k8 = 0; k8 < 8; ++k8) kf[k8] = FRAG(mb * 16 + kh * 8 + k8);
#pragma unroll
            for (int k8 = 0; k8 < 8; ++k8) S = __builtin_amdgcn_mfma_f32_32x32x16_bf16(kf[k8], qf[kh * 8 + k8], S, 0, 0, 0);
        }
        float p[16];
#pragma unroll
        for (int r = 0; r < 16; ++r) { p[r] = __builtin_amdgcn_exp2f(S[r] * c); sum += p[r]; }
        asm volatile("" : "+v"(sum));
#pragma unroll
        for (int s2 = 0; s2 < 2; ++s2)
#pragma unroll
            for (int j = 0; j < 4; ++j) pk[mb][s2][j] = cvt_pk_bf16(p[8 * s2 + 2 * j], p[8 * s2 + 2 * j + 1]);
    }
    sum += __shfl_xor(sum, 32); const float inv = 1.0f / sum;
    __syncthreads();
#pragma unroll 1
    for (int i0 = 0; i0 < 16; i0 += 8) { u32x4 t[8];
#pragma unroll
      for (int i = 0; i < 8; ++i) t[i] = vG[(i0 + i) * 512 + tid];
#pragma unroll
      for (int i = 0; i < 8; ++i) *(LAS u32x4*)(ldsl + (size_t)((i0 + i) * 512 + tid) * 16) = t[i]; }
    __syncthreads();
    bf16_t* op = (bf16_t*)(C.ws + WS_OMEM) + (size_t)row * 1024 + h * 256 + 4 * hi;
#pragma unroll
    for (int db = 0; db < 8; ++db) {
        f32x16 O = f32x16{};
#pragma unroll
        for (int mh = 0; mh < 2; ++mh) {
            bf16x8 vf[8];
#pragma unroll
            for (int k8 = 0; k8 < 8; ++k8) vf[k8] = FRAG(db * 16 + mh * 8 + k8);
#pragma unroll
            for (int k8 = 0; k8 < 8; ++k8) { const int mb = mh * 4 + (k8 >> 1), s = k8 & 1;
                const u32x4 pw = (u32x4){pk[mb][s][0], pk[mb][s][1], pk[mb][s][2], pk[mb][s][3]};
                O = __builtin_amdgcn_mfma_f32_32x32x16_bf16(vf[k8], __builtin_bit_cast(bf16x8, pw), O, 0, 0, 0); }
        }
#pragma unroll
        for (int rq = 0; rq < 4; ++rq) {
            const unsigned w0 = cvt_pk_bf16(O[4 * rq] * inv, O[4 * rq + 1] * inv), w1 = cvt_pk_bf16(O[4 * rq + 2] * inv, O[4 * rq + 3] * inv);
            *(u64*)(op + 32 * db + 8 * rq) = (u64)w0 | ((u64)w1 << 32);
        }
    }
#undef FRAG
    __syncthreads();
}
__global__ void __launch_bounds__(NTHREADS, 2) fwd(Args args) {
    extern __shared__ __attribute__((aligned(16))) unsigned char lds[];
    Ctx C;
    C.x_p = (const float*)args.in[0]; C.x_s = (const float*)args.in[1]; C.cache_k = (const float*)args.in[2]; C.cache_v = (const float*)args.in[3]; C.cache_ik = (const float*)args.in[4];
    C.st_mix = (const float*)args.in[5]; C.st_ffn = (const float*)args.in[6]; C.cmem_k = (const float*)args.in[7]; C.cmem_v = (const float*)args.in[8]; C.page_table = (const int*)args.in[9];
    C.mem_p = (const float*)args.in[10]; C.g_mix = (const float*)args.in[11]; C.w_in = (const float*)args.in[12]; C.conv_mix_w = (const float*)args.in[13]; C.q_g = (const float*)args.in[14];
    C.k_g = (const float*)args.in[15]; C.w_out = (const float*)args.in[16]; C.g_mem = (const float*)args.in[17]; C.g_mem_src = (const float*)args.in[18]; C.w_q = (const float*)args.in[19];
    C.w_kv = (const float*)args.in[20]; C.mq_g = (const float*)args.in[21]; C.mk_g = (const float*)args.in[22]; C.w_o = (const float*)args.in[23]; C.g_ffn = (const float*)args.in[24];
    C.w_gu = (const float*)args.in[25]; C.conv_ffn_w = (const float*)args.in[26]; C.conv_ffn_b = (const float*)args.in[27]; C.w_down = (const float*)args.in[28];
    C.out = args.out; C.ws = args.ws;
    C.wave = __builtin_amdgcn_readfirstlane(threadIdx.x >> 6); C.lane = fresh_lane(); C.tid = C.wave * 64 + C.lane; C.G = gridDim.x; C.bid = blockIdx.x;
    unsigned char* ws = args.ws;
    LAS unsigned char* ldsl = (LAS unsigned char*)lds;
    volatile LAS unsigned* MISC = (volatile LAS unsigned*)(ldsl + MISC_OFF);
    for (int u = C.tid; u < (LDS_BYTES - RING_BYTES) / 4; u += NTHREADS) ((LAS unsigned*)(ldsl + RING_BYTES))[u] = 0u;
    __syncthreads();
    XcdBarrier bar; bar.bar = (unsigned*)(ws + WS_CTL) + CW_BAR; bar.x = 0; bar.st = nullptr;
    if (N_LAUNCHES == 1) bar = xcd_barrier_post((unsigned*)(ws + WS_CTL) + CW_BAR, MISC + 8);
    bar.wv = C.wave;
    const int lo = args.ph_lo, hi = args.ph_hi;
#ifndef PHMASK
#define PHMASK 0xFFFF
#endif
#define IN(k) (((PHMASK >> (k)) & 1) && lo <= (k) && (k) < hi)
#define DUP(k) (PROBE_DUP == (k))
#define SEAM(k) do { if (IN(k) && IN((k) + 1)) xcd_barrier(bar); C.lane = fresh_lane(); C.tid = C.wave * 64 + C.lane; } while (0)
    float* ss1 = (float*)(ws + ACC_SS1); float* ss2 = (float*)(ws + ACC_SS2); float* ssq = (float*)(ws + ACC_SSQ); float* ssk = (float*)(ws + ACC_SSK);
    float* rstd = (float*)(ws + WS_RSTD);

    if (IN(0)) { ph0_prologue(C, lds); if (DUP(0)) { __syncthreads(); ph0_prologue(C, lds); } } SEAM(0);
    if (IN(1)) {
        { pg8::Gemm g{(const bf16_t*)(ws + WS_XB), (const bf16_t*)(ws + WS_WIN), MT, DINP, DM, C.wave}; pg8::StaticOrder S; S.init(MT, DINP, C.G, C.bid);
          EpiIn E{rstd, (const float*)(ws + WS_COS), (const float*)(ws + WS_SIN), C.q_g, C.k_g, (bf16_t*)(ws + WS_CB), (bf16_t*)(ws + WS_U), (bf16_t*)(ws + WS_Q), (bf16_t*)(ws + WS_K), (bf16_t*)(ws + WS_V),
                  (bf16_t*)(ws + WS_QI), (bf16_t*)(ws + WS_KI), (float*)(ws + WS_IW), (float*)(ws + WS_QIF), C.out};
          pg8::gemm_phase<EpiIn, pg8::StaticOrder, true, true>(ldsl, g, S, E);
          if (DUP(1)) pg8::gemm_phase<EpiIn, pg8::StaticOrder, true, true>(ldsl, g, S, E); }
        { EpiKv E{rstd + MT, ssk, C.out};
          for (int t = C.bid; t < 256; t += C.G) gemm_small2_rc<DM, EpiKv>((const bf16_t*)(ws + WS_MEMB), (const bf16_t*)(ws + WS_WKV), (t >> 5) * 64, (t & 31) * 64, C.wave, fresh_lane(), E, lds); }
    } SEAM(1);
    if (IN(2)) { ph2_scores_select(C, lds, (unsigned*)(ws + WS_CTL) + CQ_PH2, MISC + 16); } SEAM(2);
    if (IN(4)) { ph4_attn_conv(C, lds); if (DUP(4)) { __syncthreads(); ph4_attn_conv(C, lds); } } SEAM(4);
    if (IN(5)) {
        pg8::Gemm g{(const bf16_t*)(ws + WS_AMIX), (const bf16_t*)(ws + WS_WOUT), MP, DM, DM, C.wave}; pg8::StaticOrder S; S.init(MP, DM, C.G, C.bid);
        EpiRes E{C.x_p, C.x_s, nullptr, nullptr, nullptr, (bf16_t*)(ws + WS_H1B), ss1};
        pg8::gemm_phase<EpiRes, pg8::StaticOrder, true, true>(ldsl, g, S, E);
        for (int t = C.bid; t < 256; t += C.G) gemm_small2<DM, EpiRes>(g.A, g.Bt, t, C.wave, fresh_lane(), E, lds);
        if (DUP(15)) { EpiRes E2{C.x_p, C.x_s, nullptr, nullptr, nullptr, (bf16_t*)(ws + WS_H1B), nullptr}; for (int t = C.bid; t < 256; t += C.G) gemm_small<EpiRes>(g.A, g.Bt, DM, t, C.wave, fresh_lane(), E2); }
        if (DUP(5)) { EpiRes E2{C.x_p, C.x_s, nullptr, nullptr, nullptr, (bf16_t*)(ws + WS_H1B), nullptr}; pg8::gemm_phase<EpiRes, pg8::StaticOrder, true, true>(ldsl, g, S, E2); }
    } SEAM(5);
    if (IN(6)) {
        pg8::Gemm g{(const bf16_t*)(ws + WS_H1B), (const bf16_t*)(ws + WS_WQ), MP, DM, DM, C.wave}; pg8::StaticOrder S; S.init(MP, DM, C.G, C.bid);
        EpiQm E{ss1, C.mq_g, (bf16_t*)(ws + WS_QMEM), ssq};
        pg8::gemm_phase<EpiQm, pg8::StaticOrder, true, true>(ldsl, g, S, E);
        const bool one = (MP / 256) * (DM / 256) <= C.G;
        if (one) {
            const int nM = MP / 256, nN = DM / 256, nwg = nM * nN; int wgid = C.bid;
            if (wgid < nwg) { const int q = nwg / 8, r = nwg % 8, xcd = wgid % 8, off = wgid / 8; wgid = (xcd < r ? xcd * (q + 1) : r * (q + 1) + (xcd - r) * q) + off;
                const int nig = 8 * nN, gid = wgid / nig, fm = gid * 8, gsz = (nM - fm) < 8 ? (nM - fm) : 8; const int pm = fm + ((wgid % nig) % gsz), pn = (wgid % nig) / gsz;
                asm volatile("s_waitcnt vmcnt(0)" ::: "memory");
                __syncthreads();
                memattn_tile_lds(C, pm, pn, lds); }
        }
        for (int t = C.bid; t < 256; t += C.G) gemm_small2<DM, EpiQm>(g.A, g.Bt, t, C.wave, fresh_lane(), E, lds);
        if (!one) { xcd_barrier(bar); for (int u = C.bid * NWAVES + C.wave; u < 2048; u += C.G * NWAVES) { const int uu = __builtin_amdgcn_readfirstlane(u); memattn_unit_mfma(C, uu >> 2, uu & 3, fresh_lane()); } }
    } SEAM(6);
    if (IN(7)) {
        const int wg0 = (C.G > DB) ? DB : 0;
        if (C.bid < wg0 || wg0 == 0) for (int u = C.bid; u < DB; u += (wg0 ? wg0 : C.G)) memattn_unit(C, MP + u * 8, C.cmem_k + (size_t)u * 262144, C.cmem_v + (size_t)u * 262144, lds, fresh_lane());
        if (C.bid >= wg0) {
            pg8::Gemm g{(const bf16_t*)(ws + WS_OMEM), (const bf16_t*)(ws + WS_WO), MP, DM, DM, C.wave}; pg8::StaticOrder S; S.init(MP, DM, C.G - wg0, C.bid - wg0);
            EpiRes E{nullptr, nullptr, (const bf16_t*)(ws + WS_H1B), nullptr, nullptr, (bf16_t*)(ws + WS_H2B), ss2};
            pg8::gemm_phase<EpiRes, pg8::StaticOrder, true, true>(ldsl, g, S, E);
        }
    } SEAM(7);
    if (IN(8)) {
        pg8::Gemm g{(const bf16_t*)(ws + WS_OMEM), (const bf16_t*)(ws + WS_WO), MP, DM, DM, C.wave};
        EpiRes E{nullptr, nullptr, (const bf16_t*)(ws + WS_H1B), nullptr, nullptr, (bf16_t*)(ws + WS_H2B), ss2};
        for (int t = C.bid; t < 256; t += C.G) gemm_small2<DM, EpiRes>(g.A, g.Bt, t, C.wave, fresh_lane(), E, lds);
    } SEAM(8);
    if (IN(9)) {
        pg8::Gemm g{(const bf16_t*)(ws + WS_H2B), (const bf16_t*)(ws + WS_WGU), MT, 2 * DFF, DM, C.wave}; pg8::StaticOrder S; S.init(MT, 2 * DFF, C.G, C.bid);
        EpiGu E{ss2, C.conv_ffn_w, C.conv_ffn_b, C.st_ffn, (bf16_t*)(ws + WS_AFF), (float*)(ws + WS_SIDEG), (float*)(ws + WS_SIDEU), (float*)(ws + WS_LASTG), C.out, (float*)(lds + HALO_OFF)};
        pg8::gemm_phase<EpiGu, pg8::StaticOrder, true, true>(ldsl, g, S, E);
        if (DUP(9)) pg8::gemm_phase<EpiGu, pg8::StaticOrder, true, true>(ldsl, g, S, E);
    } SEAM(9);
    if (IN(11)) {
        pg8::Gemm g{(const bf16_t*)(ws + WS_AFF), (const bf16_t*)(ws + WS_WDOWN), MP, DM, DFF, C.wave}; pg8::StaticOrder S; S.init(MP, DM, C.G, C.bid);
        { const int nM = MP / 256, nN = DM / 256, nwg = nM * nN; int wgid = C.bid;
          if (wgid < nwg) { const int q = nwg / 8, r = nwg % 8, xcd = wgid % 8, off = wgid / 8; wgid = (xcd < r ? xcd * (q + 1) : r * (q + 1) + (xcd - r) * q) + off;
            const int nig = 8 * nN, gid = wgid / nig, fm = gid * 8, gsz = (nM - fm) < 8 ? (nM - fm) : 8; ffn_fixup_rows(C, fm + ((wgid % nig) % gsz)); } }
        EpiRes E{nullptr, nullptr, (const bf16_t*)(ws + WS_H2B), C.out + OFF_Y_P, C.out + OFF_Y_S, nullptr, nullptr};
        pg8::gemm_phase<EpiRes, pg8::StaticOrder, true, true>(ldsl, g, S, E);
        for (int t = C.bid; t < 256; t += C.G) gemm_small2<DFF, EpiRes>(g.A, g.Bt, t, C.wave, fresh_lane(), E, lds);
        if (DUP(11)) pg8::gemm_phase<EpiRes, pg8::StaticOrder, true, true>(ldsl, g, S, E);
    }
#undef IN
#undef SEAM
}

extern "C" void kernel_launch(void* const* d_in, const int* in_sizes, int n_in, void* d_out, int out_size, void* d_ws, size_t ws_size, hipStream_t stream) {
    static int grid = 0;
    if (grid == 0) {
        if (n_in != 29 || (size_t)out_size != OUT_TOTAL || ws_size < WS_END) { fprintf(stderr, "kernel_launch: unexpected problem (n_in %d, out %d, ws %zu); nothing launched\n", n_in, out_size, ws_size); grid = -1; return; }
        int dev = 0, cus = 0;
        if (hipGetDevice(&dev) != hipSuccess || hipDeviceGetAttribute(&cus, hipDeviceAttributeMultiprocessorCount, dev) != hipSuccess) { grid = -1; return; }
        if (hipFuncSetAttribute((const void*)fwd, hipFuncAttributeMaxDynamicSharedMemorySize, LDS_BYTES) != hipSuccess) { fprintf(stderr, "kernel_launch: hipFuncSetAttribute failed\n"); grid = -1; return; }
        (void)hipGetLastError();
        grid = cus;
    }
    if (grid < 0) return;
    (void)hipMemsetAsync((char*)d_ws + WS_CTL, 0, CTL_ZERO_BYTES, stream);
    Args a{};
    for (int i = 0; i < 29; ++i) a.in[i] = d_in[i];
    a.out = (float*)d_out; a.ws = (unsigned char*)d_ws;
    if (N_LAUNCHES == 1) { a.ph_lo = 0; a.ph_hi = NPHASE; hipLaunchKernelGGL(fwd, dim3(grid), dim3(NTHREADS), LDS_BYTES, stream, a); }
    else for (int p = 0; p < NPHASE; ++p) { a.ph_lo = p; a.ph_hi = p + 1; hipLaunchKernelGGL(fwd, dim3(grid), dim3(NTHREADS), LDS_BYTES, stream, a); }
}
```
